# Optimizing an MI355X kernel written in HIP

```python
import math
import jax, jax.numpy as jnp
from jax import lax
import numpy as np

D_MODEL = 1024
BATCH = 16
SEQ = 4096
DEPTH = 2

CHUNK = 64
EPS = 1e-6
GN_EPS = 1e-5
RET_HEADS = 8
RET_DK = 64
RET_DV = 64
RET_W = RET_HEADS * RET_DV
ROPE_BASE = 10000.0
DSA_HEADS = 8
DSA_DH = 64
DSA_W = DSA_HEADS * DSA_DH
DSA_RQ = 256
DSA_RKV = 128
IDX_HEADS = 8
IDX_DIM = 32
TOPK_MAX = 256
Q_BLOCK = 128
MEM_LEN = 256
MEM_HEADS = 4
MEM_DH = 128
MEM_W = MEM_HEADS * MEM_DH
REL_BUCKETS = 32
REL_MAX_DIST = 128
D_FF = 4 * D_MODEL
N_BRANCH = 3
IN_SIZES = (RET_HEADS * RET_DK, RET_HEADS * RET_DK, RET_W, RET_W,
            DSA_RQ, DSA_RKV, IDX_DIM, IDX_HEADS, MEM_W, N_BRANCH * D_MODEL)
N_IN = sum(IN_SIZES)

kernel_name = "chunk_causal_hybrid_retention_dsa_memory"


def rmsnorm(x, g):
    xf = x.astype(jnp.float32)
    y = xf * lax.rsqrt(jnp.mean(xf * xf, axis=-1, keepdims=True) + EPS)
    return (y * g.astype(jnp.float32)).astype(x.dtype)


def rope(x, pos):
    half = x.shape[-1] // 2
    freqs = ROPE_BASE ** (-jnp.arange(half, dtype=jnp.float32) / half)
    ang = pos[:, None] * freqs[None, :]
    cos = jnp.cos(ang)[None, :, None, :]
    sin = jnp.sin(ang)[None, :, None, :]
    xf = x.astype(jnp.float32)
    x1, x2 = xf[..., :half], xf[..., half:]
    return jnp.concatenate([x1 * cos - x2 * sin, x2 * cos + x1 * sin], axis=-1)


def retention(q, k, v):
    B, S, H, dk = q.shape
    dv = v.shape[-1]
    nc = S // CHUNK
    log_g = jnp.log1p(-jnp.exp2(-5.0 - jnp.arange(H, dtype=jnp.float32)))
    i = jnp.arange(CHUNK, dtype=jnp.float32)
    intra_decay = jnp.exp(log_g[:, None, None] * jnp.abs(i[:, None] - i[None, :]))
    key_decay = jnp.exp(log_g[:, None] * (CHUNK - 1 - i)[None, :])
    query_decay = jnp.exp(log_g[:, None] * (i + 1)[None, :])
    chunk_decay = jnp.exp(log_g * CHUNK)
    qc = q.reshape(B, nc, CHUNK, H, dk)
    kc = k.reshape(B, nc, CHUNK, H, dk) * (RET_DK ** -0.5)
    vc = v.astype(jnp.float32).reshape(B, nc, CHUNK, H, dv)
    scores = jnp.einsum('bnihd,bnjhd->bnhij', qc, kc) * intra_decay
    intra = jnp.einsum('bnhij,bnjhe->bnihe', scores, vc)
    kv = jnp.einsum('bnjhd,hj,bnjhe->nbhde', kc, key_decay, vc)

    def step(state, kv_n):
        return chunk_decay[None, :, None, None] * state + kv_n, state

    _, prev = lax.scan(step, jnp.zeros((B, H, dk, dv), jnp.float32), kv)
    cross = jnp.einsum('bnihd,nbhde,hi->bnihe', qc, prev, query_decay)
    o = (intra + cross).reshape(B, S, H, dv)
    mu = jnp.mean(o, axis=-1, keepdims=True)
    var = jnp.mean(jnp.square(o - mu), axis=-1, keepdims=True)
    return (o - mu) * lax.rsqrt(var + GN_EPS)


def t5_bucket(rel):
    nb = REL_BUCKETS // 2
    max_exact = nb // 2
    base = jnp.where(rel > 0, nb, 0)
    n = jnp.abs(rel)
    nf = jnp.maximum(n, 1).astype(jnp.float32)
    large = max_exact + (jnp.log(nf / max_exact) / math.log(REL_MAX_DIST / max_exact)
                         * (nb - max_exact)).astype(jnp.int32)
    large = jnp.minimum(large, nb - 1)
    return base + jnp.where(n < max_exact, n, large)


def dsa_attention(c_q, c_kv, k_idx, w_idx, w_uq, w_iq, w_uk, w_uv, rel_bias):
    B, S, _ = c_q.shape
    k_sel = min(TOPK_MAX, S // 4)
    nblk = S // Q_BLOCK
    q = jnp.einsum('btr,rhd->bthd', c_q, w_uq)
    q_lat = jnp.einsum('bthd,rhd->bthr', q, w_uk) * (DSA_DH ** -0.5)
    q_idx = jnp.einsum('btr,rhd->bthd', c_q, w_iq)
    w = w_idx * ((IDX_HEADS ** -0.5) * (IDX_DIM ** -0.5))
    key_pos = jnp.arange(S, dtype=jnp.int32)
    k_idx_f = k_idx.astype(jnp.float32)
    c_kv_f = c_kv.astype(jnp.float32)

    def to_blocks(a):
        return jnp.moveaxis(a.reshape((B, nblk, Q_BLOCK) + a.shape[2:]), 1, 0)

    def block(args):
        ql, qi, wb, t0 = args
        t = t0 + jnp.arange(Q_BLOCK, dtype=jnp.int32)
        end = (t // CHUNK + 1) * CHUNK - 1
        admissible = key_pos[None, :] <= end[:, None]
        s_idx = jnp.einsum('bqhd,bsd->bqhs', qi.astype(jnp.float32), k_idx_f)
        score = jnp.einsum('bqhs,bqh->bqs', jax.nn.relu(s_idx), wb.astype(jnp.float32))
        score = jnp.where(admissible[None], score, -jnp.inf)
        _, sel = lax.top_k(score, k_sel)
        valid = sel <= end[None, :, None]
        c_sel = jax.vmap(lambda c, ix: c[ix])(c_kv_f, sel)
        logits = jnp.einsum('bqhr,bqkr->bqhk', ql.astype(jnp.float32), c_sel)
        bias = rel_bias.astype(jnp.float32)[t5_bucket(sel - t[None, :, None])]
        logits = logits + jnp.moveaxis(bias, -1, -2)
        logits = jnp.where(valid[:, :, None, :], logits, -jnp.inf)
        p = jax.nn.softmax(logits, axis=-1)
        return jnp.einsum('bqhk,bqkr->bqhr', p, c_sel)

    starts = jnp.arange(nblk, dtype=jnp.int32) * Q_BLOCK
    o_lat = lax.map(block, (to_blocks(q_lat), to_blocks(q_idx), to_blocks(w), starts))
    o_lat = jnp.moveaxis(o_lat, 0, 1).reshape(B, S, DSA_HEADS, DSA_RKV)
    o = jnp.einsum('bthr,rhd->bthd', o_lat, w_uv.astype(jnp.float32))
    return o.reshape(B, S, DSA_W)


def memory_attention(q, mem_n, w_mem_kv):
    B, S, _ = q.shape
    kv = mem_n @ w_mem_kv
    k, v = jnp.split(kv, 2, axis=-1)
    M = mem_n.shape[1]
    qh = q.reshape(B, S, MEM_HEADS, MEM_DH).astype(jnp.float32)
    kh = k.reshape(B, M, MEM_HEADS, MEM_DH).astype(jnp.float32)
    vh = v.reshape(B, M, MEM_HEADS, MEM_DH).astype(jnp.float32)
    logits = jnp.einsum('bthd,bmhd->bhtm', qh, kh) * (MEM_DH ** -0.5)
    p = jax.nn.softmax(logits, axis=-1)
    return jnp.einsum('bhtm,bmhd->bthd', p, vh).reshape(B, S, MEM_W)


def setup_inputs(seed: int = 0) -> dict:
    key = jax.random.key(seed)
    ks = jax.random.split(key, 24)
    f32 = jnp.float32

    def nrm(k, shape, fan_in):
        return jax.random.normal(k, shape, f32) * (fan_in ** -0.5)

    def gain(k, shape):
        return 1.0 + 0.01 * jax.random.normal(k, shape, f32)

    L = DEPTH
    return {
        "x": jax.random.normal(ks[0], (BATCH, SEQ, D_MODEL), f32),
        "mem": jax.random.normal(ks[1], (BATCH, MEM_LEN, D_MODEL), f32),
        "norm1": gain(ks[2], (L, D_MODEL)),
        "w_in": nrm(ks[3], (L, D_MODEL, N_IN), D_MODEL),
        "q_norm": gain(ks[4], (L, DSA_RQ)),
        "kv_norm": gain(ks[5], (L, DSA_RKV)),
        "w_uq": nrm(ks[6], (L, DSA_RQ, DSA_HEADS, DSA_DH), DSA_RQ),
        "w_iq": nrm(ks[7], (L, DSA_RQ, IDX_HEADS, IDX_DIM), DSA_RQ),
        "w_uk": nrm(ks[8], (L, DSA_RKV, DSA_HEADS, DSA_DH), DSA_RKV),
        "w_uv": nrm(ks[9], (L, DSA_RKV, DSA_HEADS, DSA_DH), DSA_RKV),
        "mem_norm": gain(ks[10], (L, D_MODEL)),
        "w_mem_kv": nrm(ks[11], (L, D_MODEL, 2 * MEM_W), D_MODEL),
        "w_ret_o": nrm(ks[12], (L, RET_W, D_MODEL), RET_W),
        "w_dsa_o": nrm(ks[13], (L, DSA_W, D_MODEL), DSA_W),
        "w_mem_o": nrm(ks[14], (L, MEM_W, D_MODEL), MEM_W),
        "w_out": nrm(ks[15], (L, D_MODEL, D_MODEL), D_MODEL),
        "norm2": gain(ks[16], (L, D_MODEL)),
        "w_ff1": nrm(ks[17], (L, D_MODEL, D_FF), D_MODEL),
        "w_ff2": nrm(ks[18], (L, D_FF, D_MODEL), D_FF),
        "rel_bias": 0.5 * jax.random.normal(ks[19], (REL_BUCKETS, DSA_HEADS), f32),
        "final_norm": gain(ks[20], (D_MODEL,)),
    }


def reference(x, mem, norm1, w_in, q_norm, kv_norm, w_uq, w_iq, w_uk, w_uv, mem_norm, w_mem_kv,
              w_ret_o, w_dsa_o, w_mem_o, w_out, norm2, w_ff1, w_ff2, rel_bias, final_norm):
    B, S, D = x.shape
    pos = jnp.arange(S, dtype=jnp.float32)
    split_at = list(np.cumsum(IN_SIZES)[:-1])
    for l in range(DEPTH):
        h = rmsnorm(x, norm1[l])
        z = h @ w_in[l]
        (r_q, r_k, r_v, r_g, c_q, c_kv, i_k, i_w, m_q, gates) = jnp.split(z, split_at, axis=-1)
        rq = rope(r_q.reshape(B, S, RET_HEADS, RET_DK), pos)
        rk = rope(r_k.reshape(B, S, RET_HEADS, RET_DK), pos)
        ret = retention(rq, rk, r_v.reshape(B, S, RET_HEADS, RET_DV)).reshape(B, S, RET_W)
        ret = (jax.nn.silu(r_g.astype(jnp.float32)) * ret).astype(x.dtype)
        ret_b = ret @ w_ret_o[l]
        dsa = dsa_attention(rmsnorm(c_q, q_norm[l]), rmsnorm(c_kv, kv_norm[l]), i_k, i_w,
                            w_uq[l], w_iq[l], w_uk[l], w_uv[l], rel_bias)
        dsa_b = dsa.astype(x.dtype) @ w_dsa_o[l]
        memo = memory_attention(m_q, rmsnorm(mem, mem_norm[l]), w_mem_kv[l])
        mem_b = memo.astype(x.dtype) @ w_mem_o[l]
        g = jax.nn.sigmoid(gates.astype(jnp.float32)).reshape(B, S, N_BRANCH, D)
        merged = (g[:, :, 0] * ret_b + g[:, :, 1] * dsa_b + g[:, :, 2] * mem_b).astype(x.dtype)
        x = x + merged @ w_out[l]
        h2 = rmsnorm(x, norm2[l])
        x = x + jnp.square(jax.nn.relu(h2 @ w_ff1[l])) @ w_ff2[l]
    return rmsnorm(x, final_norm)
```

```cpp
#include <hip/hip_runtime.h>
#include <cstdio>
#include <cstdint>

#ifndef MK_SPLIT
#define MK_SPLIT 1
#endif

#define GAS __attribute__((address_space(1)))
#define LAS __attribute__((address_space(3)))
typedef _Float16 f16;
typedef _Float16 h8 __attribute__((ext_vector_type(8)));
typedef _Float16 h4 __attribute__((ext_vector_type(4)));
typedef _Float16 h2 __attribute__((ext_vector_type(2)));
typedef float f32x2 __attribute__((ext_vector_type(2)));
typedef float f32x4 __attribute__((ext_vector_type(4)));
typedef float f32x8 __attribute__((ext_vector_type(8)));
typedef float f32x16 __attribute__((ext_vector_type(16)));
typedef unsigned u32x4 __attribute__((ext_vector_type(4)));
typedef unsigned u32x2 __attribute__((ext_vector_type(2)));

constexpr int BATCH = 16, SEQ = 4096, DM = 1024, T = BATCH * SEQ, DEPTH = 2;
constexpr int NIN = 6056, NZ = 6144, FF = 4096, MEMLEN = 256;
constexpr int NWAVES = 8, NTHREADS = 512;

constexpr size_t MiB = 1u << 20;
constexpr size_t WS_CTL = 0, CTL_ZERO_BYTES = 1 * MiB;
constexpr size_t WS_ROPE = 1 * MiB;
constexpr size_t WS_TB = 2 * MiB;
constexpr size_t WS_W = 3 * MiB, W_LAYER = 37 * MiB;
constexpr size_t W_IN = 0, W_DQ = 12 * MiB, W_MKV = 13 * MiB, W_RM = 15 * MiB, W_VO = 17 * MiB, W_OUT = 19 * MiB, W_FF1 = 21 * MiB, W_FF2 = 29 * MiB;
constexpr size_t WS_MEMN = 77 * MiB, WS_MKV = 85 * MiB;
constexpr size_t WS_H = 93 * MiB;
constexpr size_t WS_RQ = 221 * MiB;
constexpr size_t WS_RK = 285 * MiB;
constexpr size_t WS_RV = 349 * MiB;
constexpr size_t WS_GM = 413 * MiB;
constexpr size_t WS_CQ = 541 * MiB;
constexpr size_t WS_MISC = 573 * MiB;
constexpr size_t WS_GATES = 605 * MiB;
constexpr size_t WS_CKVN = 989 * MiB;
constexpr size_t WS_HID = 221 * MiB;
constexpr size_t WS_END = 1005 * MiB;
constexpr size_t WS_QIDX = WS_RQ, WS_MASK = WS_RQ + 32 * MiB, WS_MERGED = WS_RK;

constexpr int LDS_BYTES = 163840;
constexpr int LDSCTL_OFF = LDS_BYTES - 256;

#define XB_TMO      128
#define XB_XCNT(j)  (256  + 64 * (j))
#define XB_XSUB(j)  (1280 + 64 * (j))
#define XB_XGEN(j)  (2304 + 64 * (j))
#define XB_TOP      3328
#define XB_TOPGEN   3392
#define XCD_BAR_WORDS 3456
#define XB_SPIN_CAP (1u << 21)
constexpr int CW_BAR = 4096;

__device__ __forceinline__ unsigned xb_ld(unsigned* p)              { return __hip_atomic_load(p, __ATOMIC_RELAXED, __HIP_MEMORY_SCOPE_AGENT); }
__device__ __forceinline__ unsigned xb_add(unsigned* p, unsigned v) { return __hip_atomic_fetch_add(p, v, __ATOMIC_RELAXED, __HIP_MEMORY_SCOPE_AGENT); }
__device__ __forceinline__ unsigned xb_xcc_id() { return (unsigned)__builtin_amdgcn_s_getreg((3 << 11) | 20) & 0xFu; }
#define XB_SPIN(cond, bar) do { unsigned _sp = 0; while (cond) { __builtin_amdgcn_s_sleep(1); \
    if ((++_sp & 255u) == 0u) { if (xb_ld(&(bar)[XB_TMO])) break; if (_sp > XB_SPIN_CAP) { atomicAdd(&(bar)[XB_TMO], 1u); break; } } } } while (0)

struct XcdBarrier { unsigned* bar; unsigned x; volatile LAS unsigned* st; };

__device__ __forceinline__ XcdBarrier xcd_barrier_post(unsigned* bar, volatile LAS unsigned* st) {
    XcdBarrier b; b.bar = bar; b.x = xb_xcc_id(); b.st = st;
    if (threadIdx.x == 0) (void)xb_add(&bar[XB_XCNT(b.x)], 1u);
    return b;
}
__device__ __forceinline__ void xcd_barrier_complete(unsigned* bar, unsigned x, unsigned& nloc, unsigned& nx) {
    const unsigned G = gridDim.x * gridDim.y * gridDim.z;
    unsigned sum, cnt, mine, sp = 0u;
    for (;;) {
        sum = 0u; cnt = 0u; mine = 0u;
#pragma unroll
        for (unsigned j = 0; j < 16; ++j) { const unsigned c = xb_ld(&bar[XB_XCNT(j)]); sum += c; cnt += (c > 0u) ? 1u : 0u; mine = (j == x) ? c : mine; }
        if (sum == G) break;
        __builtin_amdgcn_s_sleep(1);
        if ((++sp & 255u) == 0u) { if (xb_ld(&bar[XB_TMO])) break; if (sp > XB_SPIN_CAP) { atomicAdd(&bar[XB_TMO], 1u); break; } }
    }
    nloc = mine > 0u ? mine : 1u; nx = cnt > 0u ? cnt : 1u;
}
__device__ __forceinline__ void xcd_barrier(const XcdBarrier& b) {
    asm volatile("s_waitcnt vmcnt(0)" ::: "memory");
    __syncthreads();
    if (threadIdx.x == 0) {
        unsigned* bar = b.bar;
        __builtin_amdgcn_s_waitcnt(0);
        unsigned nloc = b.st[0], nx = b.st[1];
        if (nloc == 0u) { xcd_barrier_complete(bar, b.x, nloc, nx); b.st[0] = nloc; b.st[1] = nx; }
        const unsigned old = xb_add(&bar[XB_XSUB(b.x)], 1u);
        const unsigned gen = old / nloc;
        if (old + 1u == (gen + 1u) * nloc) {
            __builtin_amdgcn_fence(__ATOMIC_RELEASE, "agent");
            asm volatile("s_waitcnt vmcnt(0)" ::: "memory");
            const unsigned og = xb_add(&bar[XB_TOP], 1u);
            const unsigned tg = og / nx;
            if (og + 1u == (tg + 1u) * nx) xb_add(&bar[XB_TOPGEN], 1u);
            else XB_SPIN(xb_ld(&bar[XB_TOPGEN]) == tg, bar);
            __builtin_amdgcn_fence(__ATOMIC_ACQUIRE, "agent");
            xb_add(&bar[XB_XGEN(b.x)], 1u);
            asm volatile("s_waitcnt vmcnt(0)" ::: "memory");
        } else {
            XB_SPIN(xb_ld(&bar[XB_XGEN(b.x)]) == gen, bar);
            __builtin_amdgcn_fence(__ATOMIC_ACQUIRE, "agent");
            asm volatile("s_waitcnt vmcnt(0)" ::: "memory");
        }
    }
    __syncthreads();
}

__device__ __forceinline__ unsigned pk2h(float lo, float hi) { const h2 p = __builtin_convertvector((f32x2){lo, hi}, h2); return __builtin_bit_cast(unsigned, p); }
__device__ __forceinline__ float wave_sum(float v) {
#pragma unroll
    for (int o = 1; o < 64; o <<= 1) v += __shfl_xor(v, o);
    return v;
}
#define LDS_WAIT() asm volatile("s_waitcnt lgkmcnt(0)" ::: "memory")

namespace pg8 {
constexpr int BM = 256, BK = 64, HALF = 128, HTB = HALF * BK * 2, STAGE_BYTES = 8 * HTB, NXCD = 8, WGM = 8;
__host__ __device__ __forceinline__ int lds_byte(int r, int c) { const int st = (r >> 4) * 2 + (c >> 5), rr = r & 15, cc = c & 31, ob = rr * 64 + cc * 2; return st * 1024 + (ob ^ (((ob >> 9) & 1) << 5)); }
__host__ __device__ __forceinline__ void stage_rc(int b, int& R, int& C) { const int st = b / 1024, sb = b % 1024, swz = sb ^ (((sb >> 9) & 1) << 5); R = (st >> 1) * 16 + swz / 64; C = (st & 1) * 32 + (swz % 64) / 2; }
__host__ __device__ __forceinline__ int perm32(int rho) { const int n = rho >> 4, i = rho & 15; return 8 * (i >> 2) + 4 * n + (i & 3); }

struct Unit { int pm, pn, seg; };

template <int NSEG> struct Order {
    int nM, nN, nwg, G, c;
    __device__ void init(int M, int N, int G_, int c_) { nM = M / BM; nN = N / BM; nwg = nM * nN; G = G_; c = c_; }
    __device__ bool next(int i, Unit& u) const {
        const int ti = i / NSEG; u.seg = i - ti * NSEG;
        const long L = (long)ti * G + c; if (L >= nwg) return false;
        int wgid = (int)L; { const int q = nwg / NXCD, r = nwg % NXCD, xcd = wgid % NXCD, off = wgid / NXCD; wgid = (xcd < r ? xcd * (q + 1) : r * (q + 1) + (xcd - r) * q) + off; }
        const int nig = WGM * nN, gid = wgid / nig, fm = gid * WGM, gsz = (nM - fm) < WGM ? (nM - fm) : WGM;
        u.pm = fm + ((wgid % nig) % gsz); u.pn = (wgid % nig) / gsz; return true;
    }
};
__device__ __forceinline__ unsigned long long pick3(int seg, unsigned long long v0, unsigned long long v1, unsigned long long v2) {
    const unsigned long long m1 = (unsigned long long)0 - (unsigned long long)(seg == 1), m2 = (unsigned long long)0 - (unsigned long long)(seg == 2);
    return v0 + ((v1 - v0) & m1) + ((v2 - v0) & m2);
}

template <int ACT  > struct EpiF16 {
    static constexpr bool PERM = true;
    f16* base[8]; int ld[8]; int lo[8]; int nd;
    __device__ __forceinline__ void operator()(f32x4 (&acc)[2][2][4][2], const Unit& u, int wr, int wc, int fr, int fq) const {
        f16* b = base[0]; int l = ld[0]; int t0 = lo[0];
#pragma unroll
        for (int i = 1; i < 8; ++i) if (i < nd && u.pn >= lo[i]) { b = base[i]; l = ld[i]; t0 = lo[i]; }
        const int row0 = u.pm * BM + wr * 64 + fr, col0 = (u.pn - t0) * BM + wc * 32 + 8 * fq;
#pragma unroll
        for (int ai = 0; ai < 2; ++ai)
#pragma unroll
            for (int m = 0; m < 4; ++m) { f16* rowp = b + (size_t)(row0 + ai * HALF + m * 16) * l + col0;
#pragma unroll
                for (int bj = 0; bj < 2; ++bj) { f32x4 v0 = acc[ai][bj][m][0], v1 = acc[ai][bj][m][1];
                    if (ACT == 1) {
#pragma unroll
                        for (int j = 0; j < 4; ++j) { const float a = fmaxf(v0[j], 0.f), c = fmaxf(v1[j], 0.f); v0[j] = a * a; v1[j] = c * c; } }
                    u32x4 w; w.x = pk2h(v0[0], v0[1]); w.y = pk2h(v0[2], v0[3]); w.z = pk2h(v1[0], v1[1]); w.w = pk2h(v1[2], v1[3]);
                    *(u32x4*)(rowp + bj * HALF) = w; } }
    }
};
struct EpiRes {
    static constexpr bool PERM = false;
    const float* base; float* out; int ldc;
    __device__ __forceinline__ void operator()(f32x4 (&acc)[2][2][4][2], const Unit& u, int wr, int wc, int fr, int fq) const {
        const int row0 = u.pm * BM + wr * 64 + fr, col0 = u.pn * BM + wc * 32 + 4 * fq;
#pragma unroll
        for (int ai = 0; ai < 2; ++ai)
#pragma unroll
            for (int m = 0; m < 4; ++m) { const size_t off = (size_t)(row0 + ai * HALF + m * 16) * ldc + col0;
#pragma unroll
                for (int bj = 0; bj < 2; ++bj)
#pragma unroll
                    for (int n = 0; n < 2; ++n) { const f32x4 bs = *(const f32x4*)(base + off + bj * HALF + n * 16); *(f32x4*)(out + off + bj * HALF + n * 16) = bs + acc[ai][bj][m][n]; }
                asm volatile("" ::: "memory"); }
    }
};
struct EpiMerge {
    static constexpr bool PERM = true;
    const f16* gates; f16* out;
    __device__ __forceinline__ void operator()(f32x4 (&acc)[2][2][4][2], const Unit& u, int wr, int wc, int fr, int fq) const {
        const int row0 = u.pm * BM + wr * 64 + fr, col0 = u.pn * BM + wc * 32 + 8 * fq;
        const int ga = (u.seg == 0 ? 0 : (u.seg == 1 ? 1024 : 2048)), gb = (u.seg == 0 ? 1024 : 2048);
#pragma unroll
        for (int ai = 0; ai < 2; ++ai)
#pragma unroll
            for (int m = 0; m < 4; ++m) { const int row = row0 + ai * HALF + m * 16; const f16* gp = gates + (size_t)row * 3072 + col0;
#pragma unroll
                for (int bj = 0; bj < 2; ++bj) {
                    const h8 xa = *(const h8*)(gp + ga + bj * HALF);
                    float f[8];
                    if (u.seg < 2) { const h8 xb = *(const h8*)(gp + gb + bj * HALF);
#pragma unroll
                        for (int j = 0; j < 8; ++j) { const float a = fminf(fmaxf((float)xa[j], -30.f), 30.f), b = fminf(fmaxf((float)xb[j], -30.f), 30.f);
                            f[j] = (1.f + __expf(-b)) * __builtin_amdgcn_rcpf(1.f + __expf(-a)); }
                    } else {
#pragma unroll
                        for (int j = 0; j < 8; ++j) { const float a = fminf(fmaxf((float)xa[j], -30.f), 30.f); f[j] = __builtin_amdgcn_rcpf(1.f + __expf(-a)); }
                    }
                    f32x4 v0 = acc[ai][bj][m][0], v1 = acc[ai][bj][m][1];
#pragma unroll
                    for (int j = 0; j < 4; ++j) { v0[j] *= f[j]; v1[j] *= f[4 + j]; }
                    if (u.seg < 2) { acc[ai][bj][m][0] = v0; acc[ai][bj][m][1] = v1; }
                    else { u32x4 w; w.x = pk2h(v0[0], v0[1]); w.y = pk2h(v0[2], v0[3]); w.z = pk2h(v1[0], v1[1]); w.w = pk2h(v1[2], v1[3]);
                        *(u32x4*)(out + (size_t)row * 1024 + col0 + bj * HALF) = w; } }
                asm volatile("" ::: "memory"); }
    }
};

template <class Epi, int NSEG, bool ALIGN_EPI, bool SP2>
__device__ __forceinline__ void gemm_phase(LAS unsigned char* lds, const f16* gA0, const f16* gA1, const f16* gA2, const f16* gB0, const f16* gB1, const f16* gB2,
                                           const int gK0, const int gK1, const int gK2, const int g_lda, const int g_ldb, const Order<NSEG>& S, const Epi& E) {
    const unsigned long long uA0 = (unsigned long long)gA0, uA1 = (unsigned long long)gA1, uA2 = (unsigned long long)gA2, uB0 = (unsigned long long)gB0, uB1 = (unsigned long long)gB1, uB2 = (unsigned long long)gB2;
#define SEG_A(u) ((const char*)(NSEG > 1 ? pick3((u).seg, uA0, uA1, uA2) : uA0) + (size_t)(u).pm * (size_t)(BM * 2) * g_lda)
#define SEG_B(u) ((const char*)(NSEG > 1 ? pick3((u).seg, uB0, uB1, uB2) : uB0) + (size_t)(u).pn * (size_t)(BM * 2) * g_ldb)
#define SEG_K(u) (NSEG > 1 ? (int)pick3((u).seg, (unsigned long long)gK0, (unsigned long long)gK1, (unsigned long long)gK2) : gK0)
    int tid_ = threadIdx.x; asm volatile("" : "+v"(tid_));
    const int tid = tid_, wid = __builtin_amdgcn_readfirstlane(tid >> 6), lane = tid & 63, wr = wid >> 2, wc = wid & 3, fr = lane & 15, fq = lane >> 4;
    unsigned voffA[2], voffB[2];
#pragma unroll
    for (int i = 0; i < 2; ++i) { int R, C; stage_rc(tid * 16 + i * 8192, R, C); const int Rb = Epi::PERM ? ((R & ~31) + perm32(R & 31)) : R;
        voffA[i] = (unsigned)(R * g_lda + C) * 2u; voffB[i] = (unsigned)(Rb * g_ldb + C) * 2u; }
    const size_t kstep = (size_t)(BK * 2);
    const size_t hstepA = (size_t)HALF * g_lda * 2, hstepB = (size_t)HALF * g_ldb * 2;
    const unsigned ldsw = (unsigned)wid * 1024u;
    const int aoff = lds_byte(wr * 64 + fr, fq * 8), boff = lds_byte(wc * 32 + fr, fq * 8);
#define PG8_SA(b, h) (((b) * 2 + (h)) * HTB)
#define PG8_SB(b, h) ((4 + (b) * 2 + (h)) * HTB)
#define PG8_STAGE(bufoff, gbase, voff) do { _Pragma("unroll") for (int _i = 0; _i < 2; ++_i) \
        __builtin_amdgcn_global_load_lds((const unsigned*)((const char*)(gbase) + (voff)[_i]), (LAS unsigned*)(lds + (bufoff) + ldsw + _i * 8192), 16, 0, 0); } while (0)
#define PG8_LDA(dst, b, h) do { _Pragma("unroll") for (int m = 0; m < 4; ++m) _Pragma("unroll") for (int k = 0; k < 2; ++k) dst[m][k] = *(const LAS h8*)(lds + PG8_SA(b, h) + aoff + m * 2048 + k * 1024); } while (0)
#define PG8_LDB(dst, b, h) do { _Pragma("unroll") for (int n = 0; n < 2; ++n) _Pragma("unroll") for (int k = 0; k < 2; ++k) dst[n][k] = *(const LAS h8*)(lds + PG8_SB(b, h) + boff + n * 2048 + k * 1024); } while (0)
#define PG8_MMA(ai, bj, At, Bt) do { __builtin_amdgcn_s_setprio(1); _Pragma("unroll") for (int m = 0; m < 4; ++m) _Pragma("unroll") for (int n = 0; n < 2; ++n) _Pragma("unroll") for (int k = 0; k < 2; ++k) \
        acc[ai][bj][m][n] = __builtin_amdgcn_mfma_f32_16x16x32_f16(Bt[n][k], At[m][k], acc[ai][bj][m][n], 0, 0, 0); __builtin_amdgcn_s_setprio(0); } while (0)
#define PG8_WAIT_V(n) asm volatile("s_waitcnt vmcnt(" #n ")" ::: "memory")
#define PG8_WAIT_L(n) asm volatile("s_waitcnt lgkmcnt(" #n ")" ::: "memory")
#define PG8_BAR __builtin_amdgcn_s_barrier()
#define PG8_SCHED __builtin_amdgcn_sched_barrier(0)
    Unit cur, nxt; int ui = 0;
    if (!S.next(0, cur)) return;
    f32x4 acc[2][2][4][2];
#pragma unroll
    for (int a = 0; a < 2; ++a)
#pragma unroll
        for (int b = 0; b < 2; ++b)
#pragma unroll
            for (int m = 0; m < 4; ++m)
#pragma unroll
                for (int n = 0; n < 2; ++n) acc[a][b][m][n] = (f32x4){0.f, 0.f, 0.f, 0.f};
    h8 At[4][2], B0[2][2], B1[2][2];
    const char* cA = SEG_A(cur); const char* cB = SEG_B(cur);
    if constexpr (SP2) {
        PG8_STAGE(PG8_SB(0, 0), cB, voffB); PG8_STAGE(PG8_SB(0, 1), cB + hstepB, voffB); PG8_STAGE(PG8_SA(0, 0), cA, voffA); PG8_STAGE(PG8_SA(0, 1), cA + hstepA, voffA);
        if (wr == 1) PG8_BAR;
        PG8_WAIT_V(2); PG8_BAR;
        PG8_STAGE(PG8_SB(1, 0), cB + kstep, voffB); PG8_STAGE(PG8_SA(1, 0), cA + kstep, voffA); PG8_STAGE(PG8_SB(1, 1), cB + hstepB + kstep, voffB);
        PG8_WAIT_V(6); PG8_BAR;
    } else {
        PG8_STAGE(PG8_SB(0, 0), cB, voffB); PG8_STAGE(PG8_SA(0, 0), cA, voffA); PG8_STAGE(PG8_SB(0, 1), cB + hstepB, voffB); PG8_STAGE(PG8_SA(0, 1), cA + hstepA, voffA);
        if (wr == 1) PG8_BAR;
        PG8_WAIT_V(4); PG8_BAR;
        PG8_STAGE(PG8_SB(1, 0), cB + kstep, voffB); PG8_STAGE(PG8_SA(1, 0), cA + kstep, voffA); PG8_STAGE(PG8_SB(1, 1), cB + hstepB + kstep, voffB);
        PG8_WAIT_V(6); PG8_BAR;
    }
    for (;;) {
        const bool has_next = S.next(ui + 1, nxt);
        const int nt = SEG_K(cur) / BK;
        const char* nA = has_next ? SEG_A(nxt) : cA; const char* nB = has_next ? SEG_B(nxt) : cB;
        for (int t = 0; t < nt; t += 2) {
            const bool last = (t == nt - 2);
            const char* a1 = cA + (size_t)(t + 1) * kstep;
            const char* a2 = last ? nA : cA + (size_t)(t + 2) * kstep; const char* b2 = last ? nB : cB + (size_t)(t + 2) * kstep;
            const char* a3 = a2 + kstep; const char* b3 = b2 + kstep;
            if constexpr (SP2) {
            PG8_LDB(B0, 0, 0); PG8_LDB(B1, 0, 1); PG8_SCHED; PG8_LDA(At, 0, 0); PG8_STAGE(PG8_SA(1, 1), a1 + hstepA, voffA);
            PG8_WAIT_V(8); PG8_WAIT_L(0); PG8_BAR; PG8_MMA(0, 0, At, B0); PG8_MMA(0, 1, At, B1); PG8_BAR; PG8_SCHED;
            PG8_LDA(At, 0, 1); PG8_STAGE(PG8_SB(0, 0), b2, voffB); PG8_STAGE(PG8_SB(0, 1), b2 + hstepB, voffB); PG8_STAGE(PG8_SA(0, 0), a2, voffA);
            PG8_WAIT_V(8); PG8_WAIT_L(0); PG8_BAR; PG8_MMA(1, 0, At, B0); PG8_MMA(1, 1, At, B1); PG8_BAR; PG8_SCHED;
            PG8_LDB(B0, 1, 0); PG8_LDB(B1, 1, 1); PG8_SCHED; PG8_LDA(At, 1, 0); PG8_STAGE(PG8_SA(0, 1), a2 + hstepA, voffA);
            PG8_WAIT_V(8); PG8_WAIT_L(0); PG8_BAR; PG8_MMA(0, 0, At, B0); PG8_MMA(0, 1, At, B1); PG8_BAR; PG8_SCHED;
            PG8_LDA(At, 1, 1); PG8_STAGE(PG8_SB(1, 0), b3, voffB); PG8_STAGE(PG8_SB(1, 1), b3 + hstepB, voffB); PG8_STAGE(PG8_SA(1, 0), a3, voffA);
            PG8_WAIT_V(8); PG8_WAIT_L(0); PG8_BAR; PG8_MMA(1, 0, At, B0); PG8_MMA(1, 1, At, B1); PG8_BAR; PG8_SCHED;
            } else {
            PG8_LDB(B0, 0, 0); PG8_SCHED; PG8_LDA(At, 0, 0); PG8_STAGE(PG8_SA(1, 1), a1 + hstepA, voffA);
            PG8_WAIT_L(8); PG8_BAR; PG8_WAIT_L(0); PG8_MMA(0, 0, At, B0); PG8_BAR; PG8_SCHED;
            PG8_LDB(B1, 0, 1); PG8_STAGE(PG8_SB(0, 0), b2, voffB);
            PG8_BAR; PG8_WAIT_L(0); PG8_MMA(0, 1, At, B1); PG8_BAR;
            PG8_LDA(At, 0, 1); PG8_STAGE(PG8_SA(0, 0), a2, voffA);
            PG8_BAR; PG8_WAIT_L(0); PG8_MMA(1, 0, At, B0); PG8_BAR; PG8_SCHED;
            PG8_STAGE(PG8_SB(0, 1), b2 + hstepB, voffB);
            PG8_WAIT_V(6); PG8_BAR; PG8_MMA(1, 1, At, B1); PG8_BAR;
            PG8_LDB(B0, 1, 0); PG8_SCHED; PG8_LDA(At, 1, 0); PG8_STAGE(PG8_SA(0, 1), a2 + hstepA, voffA);
            PG8_WAIT_L(8); PG8_BAR; PG8_WAIT_L(0); PG8_MMA(0, 0, At, B0); PG8_BAR; PG8_SCHED;
            PG8_LDB(B1, 1, 1); PG8_STAGE(PG8_SB(1, 0), b3, voffB);
            PG8_BAR; PG8_WAIT_L(0); PG8_MMA(0, 1, At, B1); PG8_BAR;
            PG8_LDA(At, 1, 1); PG8_STAGE(PG8_SA(1, 0), a3, voffA);
            PG8_BAR; PG8_WAIT_L(0); PG8_MMA(1, 0, At, B0); PG8_BAR; PG8_SCHED;
            PG8_STAGE(PG8_SB(1, 1), b3 + hstepB, voffB);
            PG8_WAIT_V(6); PG8_BAR; PG8_MMA(1, 1, At, B1); PG8_BAR;
            }
        }
        if constexpr (ALIGN_EPI) { if (wr == 0) PG8_BAR; }
        E(acc, cur, wr, wc, fr, fq);
        if (!has_next) break;
        if (NSEG == 1 || cur.seg == NSEG - 1) {
#pragma unroll
        for (int a = 0; a < 2; ++a)
#pragma unroll
            for (int b = 0; b < 2; ++b)
#pragma unroll
                for (int m = 0; m < 4; ++m)
#pragma unroll
                    for (int n = 0; n < 2; ++n) acc[a][b][m][n] = (f32x4){0.f, 0.f, 0.f, 0.f};
        }
        cur = nxt; cA = nA; cB = nB; ++ui;
        if constexpr (ALIGN_EPI) { if (wr == 1) PG8_BAR; }
    }
    PG8_WAIT_V(0);
    if constexpr (!ALIGN_EPI) { if (wr == 0) PG8_BAR; }
    PG8_BAR;
#undef SEG_A
#undef SEG_B
#undef SEG_K
#undef PG8_SA
#undef PG8_SB
#undef PG8_STAGE
#undef PG8_LDA
#undef PG8_LDB
#undef PG8_MMA
#undef PG8_WAIT_V
#undef PG8_WAIT_L
#undef PG8_BAR
#undef PG8_SCHED
}
}

namespace att {
constexpr int D = 128, NW = 8, QBLK = 32, KVBLK = 64;
constexpr float THR = 8.f;
constexpr size_t SHM_V = KVBLK * D * 2, SHM_K = KVBLK * D * 2, SHM_ATTN = 2 * SHM_V + 2 * SHM_K + NW * 64 * 4;
#define KSWZ(row, colB) ((row) * 256 + ((colB) ^ (((row) & 7) << 4)))
#define SBAR() __builtin_amdgcn_sched_barrier(0)
__device__ __forceinline__ int crow(int r, int hi) { return (r & 3) + 8 * (r >> 2) + 4 * hi; }
__device__ __forceinline__ unsigned cvtpk(float lo, float hi) { return pk2h(lo, hi); }

template <int SCALE_NUM> struct ScaleC { };
__device__ __forceinline__ void partialSM(f32x16& p0, f32x16& p1, float& m_reg, float& mn, float& alpha, const float SCALE) {
  const float C = SCALE * 1.4426950408889634f;
  float pmax = p0[0];
#pragma unroll
  for (int r = 1; r < 16; ++r) pmax = fmaxf(pmax, p0[r]);
#pragma unroll
  for (int r = 0; r < 16; ++r) pmax = fmaxf(pmax, p1[r]);
  { auto rr = __builtin_amdgcn_permlane32_swap(__float_as_uint(pmax), __float_as_uint(pmax), false, false);
    pmax = fmaxf(__uint_as_float(rr[0]), __uint_as_float(rr[1])); }
  if (__builtin_expect(__all(pmax - m_reg <= THR / SCALE), 1)) { mn = m_reg; alpha = 1.f; }
  else { mn = fmaxf(m_reg, pmax); alpha = __builtin_amdgcn_exp2f((m_reg - mn) * C); m_reg = mn; }
  float mnC = -mn * C;
#pragma unroll
  for (int r = 0; r < 16; ++r) p0[r] = fmaf(p0[r], C, mnC);
#pragma unroll
  for (int r = 0; r < 16; ++r) p1[r] = fmaf(p1[r], C, mnC);
#pragma unroll
  for (int r = 0; r < 16; ++r) p0[r] = __builtin_amdgcn_exp2f(p0[r]);
}
__device__ __forceinline__ void finishSM(f32x16& p0, f32x16& p1, float alpha, float& l_reg, h8& pa0, h8& pa1, h8& pa2, h8& pa3) {
#pragma unroll
  for (int r = 0; r < 16; ++r) p1[r] = __builtin_amdgcn_exp2f(p1[r]);
  float ps = 0;
#pragma unroll
  for (int r = 0; r < 16; ++r) ps += p0[r];
#pragma unroll
  for (int r = 0; r < 16; ++r) ps += p1[r];
  { auto rr = __builtin_amdgcn_permlane32_swap(__float_as_uint(ps), __float_as_uint(ps), false, false);
    ps = __uint_as_float(rr[0]) + __uint_as_float(rr[1]); }
  l_reg = l_reg * alpha + ps;
#define PK4(P, BASE, OUT) do { unsigned a0 = cvtpk(P[BASE + 0], P[BASE + 1]), a1 = cvtpk(P[BASE + 2], P[BASE + 3]);   \
    unsigned b0 = cvtpk(P[BASE + 4], P[BASE + 5]), b1 = cvtpk(P[BASE + 6], P[BASE + 7]);                              \
    auto r0 = __builtin_amdgcn_permlane32_swap(a0, b0, false, false); auto r1 = __builtin_amdgcn_permlane32_swap(a1, b1, false, false); \
    u32x4 w = {r0[0], r1[0], r0[1], r1[1]}; OUT = __builtin_bit_cast(h8, w); } while (0)
  PK4(p0, 0, pa0); PK4(p0, 8, pa1); PK4(p1, 0, pa2); PK4(p1, 8, pa3);
#undef PK4
}
__device__ __forceinline__ void qkt(f32x16& p0, f32x16& p1, const char* Ks, const h8* qr, int r32, int hi) {
  p0 = f32x16{}; p1 = f32x16{};
#pragma unroll
  for (int d0 = 0; d0 < 8; ++d0) { int cb = (d0 * 16 + hi * 8) * 2;
    h8 b0 = *reinterpret_cast<const h8*>(Ks + KSWZ(r32, cb));
    h8 b1 = *reinterpret_cast<const h8*>(Ks + KSWZ(32 + r32, cb));
    p0 = __builtin_amdgcn_mfma_f32_32x32x16_f16(b0, qr[d0], p0, 0, 0, 0);
    p1 = __builtin_amdgcn_mfma_f32_32x32x16_f16(b1, qr[d0], p1, 0, 0, 0); }
}
__device__ __forceinline__ int v_st(int k, int c) { const int kk = (k & ~0xC) | ((k & 4) << 1) | ((k & 8) >> 1); return ((kk >> 3) * 4 + (c >> 5)) * 512 + ((kk & 7) * 32 + (c & 31)) * 2; }
__device__ __forceinline__ int v_rd_base(int lane) { return ((lane & 3) << 3) | (((lane >> 2) & 3) << 6) | (((lane >> 4) & 1) << 5) | (((lane >> 5) & 1) << 8); }
constexpr int v_rd_off(int d0, int ks, int half) { return d0 * 512 + ks * 4096 + half * 2048; }
template <int OFF> __device__ __forceinline__ h4 tr_read(int vb) {
  h4 r; asm volatile("ds_read_b64_tr_b16 %0, %1 offset:%2" : "=&v"(r) : "v"(vb), "i"(OFF) : "memory"); return r;
}
template <int D0> __device__ __forceinline__ void pv_one(f32x16& od, int vb, h8 pa0, h8 pa1, h8 pa2, h8 pa3) {
  const h4 l0 = tr_read<v_rd_off(D0, 0, 0)>(vb), h0 = tr_read<v_rd_off(D0, 0, 1)>(vb), l1 = tr_read<v_rd_off(D0, 1, 0)>(vb), h1 = tr_read<v_rd_off(D0, 1, 1)>(vb);
  const h4 l2 = tr_read<v_rd_off(D0, 2, 0)>(vb), h2_ = tr_read<v_rd_off(D0, 2, 1)>(vb), l3 = tr_read<v_rd_off(D0, 3, 0)>(vb), h3 = tr_read<v_rd_off(D0, 3, 1)>(vb);
  asm volatile("s_waitcnt lgkmcnt(0)" ::: "memory"); SBAR();
#define PK(L, H) (h8){L[0], L[1], L[2], L[3], H[0], H[1], H[2], H[3]}
  od = __builtin_amdgcn_mfma_f32_32x32x16_f16(pa0, PK(l0, h0), od, 0, 0, 0);
  od = __builtin_amdgcn_mfma_f32_32x32x16_f16(pa1, PK(l1, h1), od, 0, 0, 0);
  od = __builtin_amdgcn_mfma_f32_32x32x16_f16(pa2, PK(l2, h2_), od, 0, 0, 0);
  od = __builtin_amdgcn_mfma_f32_32x32x16_f16(pa3, PK(l3, h3), od, 0, 0, 0);
#undef PK
}
__device__ __forceinline__ void pv_d0(f32x16* o, int vb, h8 pa0, h8 pa1, h8 pa2, h8 pa3) {
  pv_one<0>(o[0], vb, pa0, pa1, pa2, pa3); pv_one<1>(o[1], vb, pa0, pa1, pa2, pa3); pv_one<2>(o[2], vb, pa0, pa1, pa2, pa3); pv_one<3>(o[3], vb, pa0, pa1, pa2, pa3);
}
template <int LDQ, int LDK, int LDO>
__device__ __forceinline__ void attn_dense_body(const f16* __restrict__ Qb, const f16* __restrict__ Kh, const f16* __restrict__ Vh, f16* Ob, int seq, char* lds, const float SCALE) {
  int tid_ = threadIdx.x; asm volatile("" : "+v"(tid_));
  const int tid = tid_, wid = tid >> 6, lane = tid & 63, r32 = lane & 31, hi = lane >> 5;
  char* V_lds = lds; char* K_lds = lds + 2 * SHM_V;
  float* ws = (float*)(lds + 2 * SHM_V + 2 * SHM_K) + wid * 64; float* li_l = ws; float* al_l = ws + 32;
  float m_reg = -1e30f, l_reg = 0; f32x16 o[4] = {}; h8 qr[8];
  const f16* Qw = Qb + (long)(wid * QBLK + r32) * LDQ + hi * 8;
#pragma unroll
  for (int d0 = 0; d0 < 8; ++d0) qr[d0] = *reinterpret_cast<const h8*>(Qw + d0 * 16);
  const int sr = tid >> 4, sc = (tid & 15) * 8, vst0 = v_st(sr, sc), vst1 = v_st(32 + sr, sc);
  const int vb0 = (int)(uintptr_t)V_lds + v_rd_base(lane);
  struct { h8 vs0, vs1, ks0, ks1; } sr_[2];
#define SLOAD(i, k0) do { sr_[i].vs0 = *(const h8*)(&Vh[(long)((k0) + sr) * LDK + sc]); sr_[i].vs1 = *(const h8*)(&Vh[(long)((k0) + 32 + sr) * LDK + sc]); \
    sr_[i].ks0 = *(const h8*)(&Kh[(long)((k0) + sr) * LDK + sc]); sr_[i].ks1 = *(const h8*)(&Kh[(long)((k0) + 32 + sr) * LDK + sc]); } while (0)
#define SWRITE(b, i) do { *(h8*)(V_lds + (b) * SHM_V + vst0) = sr_[i].vs0;          \
    *(h8*)(V_lds + (b) * SHM_V + vst1) = sr_[i].vs1; int kc = sc * 2;               \
    *(h8*)(K_lds + (b) * SHM_K + KSWZ(sr, kc)) = sr_[i].ks0;                       \
    *(h8*)(K_lds + (b) * SHM_K + KSWZ(32 + sr, kc)) = sr_[i].ks1; } while (0)
#define SWAIT() asm volatile("s_waitcnt vmcnt(4)" ::: "memory")
#define RESC(a) do { if (__any((a) < 1.f)) { if (hi == 0) al_l[r32] = (a); asm volatile("s_waitcnt lgkmcnt(0)" ::: "memory"); \
    _Pragma("unroll") for (int d = 0; d < 4; ++d) _Pragma("unroll") for (int r = 0; r < 16; ++r) o[d][r] *= al_l[crow(r, hi)]; } } while (0)
  f32x16 pA0, pA1, pB0, pB1; float mnA, mnB, alA, alB; h8 pa0, pa1, pa2, pa3; const int NT = seq / KVBLK;
  constexpr int SE = 0, SO = 1;
  SLOAD(SE, 0); asm volatile("s_waitcnt vmcnt(0)" ::: "memory"); SWRITE(0, SE); __syncthreads();
  qkt(pA0, pA1, K_lds, qr, r32, hi); partialSM(pA0, pA1, m_reg, mnA, alA, SCALE);
  SLOAD(SO, KVBLK); if (2 < NT) SLOAD(SE, 2 * KVBLK);
  SWAIT(); SWRITE(1, SO); __syncthreads();
  for (int j = 1; j + 1 < NT; j += 2) {
    SBAR(); qkt(pB0, pB1, K_lds + SHM_K, qr, r32, hi);
    finishSM(pA0, pA1, alA, l_reg, pa0, pa1, pa2, pa3); SBAR();
    SLOAD(SO, (j + 2) * KVBLK); SBAR();
    pv_d0(o, vb0, pa0, pa1, pa2, pa3); partialSM(pB0, pB1, m_reg, mnB, alB, SCALE);
    __syncthreads(); SWAIT(); SWRITE(0, SE);
    RESC(alB); __syncthreads();
    SBAR(); qkt(pA0, pA1, K_lds, qr, r32, hi);
    finishSM(pB0, pB1, alB, l_reg, pa0, pa1, pa2, pa3); SBAR();
    if (j + 3 < NT) SLOAD(SE, (j + 3) * KVBLK); SBAR();
    pv_d0(o, vb0 + (int)SHM_V, pa0, pa1, pa2, pa3); partialSM(pA0, pA1, m_reg, mnA, alA, SCALE);
    __syncthreads(); SWAIT(); SWRITE(1, SO);
    RESC(alA); __syncthreads();
  }
  SBAR(); qkt(pB0, pB1, K_lds + SHM_K, qr, r32, hi);
  finishSM(pA0, pA1, alA, l_reg, pa0, pa1, pa2, pa3); SBAR();
  pv_d0(o, vb0, pa0, pa1, pa2, pa3); partialSM(pB0, pB1, m_reg, mnB, alB, SCALE);
  __syncthreads(); RESC(alB);
  finishSM(pB0, pB1, alB, l_reg, pa0, pa1, pa2, pa3); SBAR();
  pv_d0(o, vb0 + (int)SHM_V, pa0, pa1, pa2, pa3);
  if (hi == 0) li_l[r32] = l_reg; asm volatile("s_waitcnt lgkmcnt(0)" ::: "memory");
  float rli[16];
#pragma unroll
  for (int r = 0; r < 16; ++r) rli[r] = __builtin_amdgcn_rcpf(li_l[crow(r, hi)]);
  f16* Ow = Ob + (long)(wid * QBLK) * LDO;
#pragma unroll
  for (int r = 0; r < 16; ++r) { int orow = crow(r, hi);
#pragma unroll
    for (int d0 = 0; d0 < 4; ++d0) Ow[(long)orow * LDO + d0 * 32 + r32] = (f16)(o[d0][r] * rli[r]); }
#undef SLOAD
#undef SWRITE
#undef SWAIT
#undef RESC
}
}

struct Args { const float* in[21]; float* out; unsigned char* ws; int ph_lo, ph_hi; };
enum { I_X = 0, I_MEM, I_NORM1, I_WIN, I_QNORM, I_KVNORM, I_WUQ, I_WIQ, I_WUK, I_WUV, I_MEMNORM, I_WMEMKV, I_WRETO, I_WDSAO, I_WMEMO, I_WOUT, I_NORM2, I_WFF1, I_WFF2, I_RELBIAS, I_FINALNORM };

typedef const __attribute__((address_space(4))) Args* KArgs;
#define INP(a, i) ((const float*)(const GAS float*)((a)->in[i]))
struct Frame {
    LAS unsigned char* lds; char* ldsg;
    unsigned char* ws;
    int tid, lane, wave, G;
};

__device__ __forceinline__ Frame relaunder(const Frame& F0) { Frame F = F0; int t = F0.tid; asm volatile("" : "+v"(t)); { GAS unsigned char* w = (GAS unsigned char*)F0.ws; asm volatile("" : "+s"(w)); F.ws = (unsigned char*)w; } F.tid = t; F.lane = t & 63; F.wave = __builtin_amdgcn_readfirstlane(t >> 6); return F; }
__device__ __forceinline__ void norm_rows_f16(const Frame& F0, const float* src, const float* gain, f16* dst, int rows, int w0, int wstride) {
    const Frame F = relaunder(F0);
    f32x4 g[4];
#pragma unroll
    for (int j = 0; j < 4; ++j) g[j] = ((const f32x4*)gain)[F.lane + 64 * j];
    for (int m = w0; m < rows; m += wstride) {
        const f32x4* xr = (const f32x4*)(src + (size_t)m * DM) + F.lane;
        f32x4 v[4]; float s = 0.f;
#pragma unroll
        for (int j = 0; j < 4; ++j) { v[j] = xr[64 * j]; s += (v[j].x * v[j].x + v[j].y * v[j].y) + (v[j].z * v[j].z + v[j].w * v[j].w); }
        const float rstd = 1.f / sqrtf(wave_sum(s) * (1.f / DM) + 1e-6f);
        u32x2* o8 = (u32x2*)(dst + (size_t)m * DM) + F.lane;
#pragma unroll
        for (int j = 0; j < 4; ++j) { u32x2 w; w.x = pk2h(v[j].x * rstd * g[j].x, v[j].y * rstd * g[j].y); w.y = pk2h(v[j].z * rstd * g[j].z, v[j].w * rstd * g[j].w); o8[64 * j] = w; }
    }
}
__device__ __forceinline__ void norm_rows_f32_inplace(const Frame& F0, float* x, const float* gain, int rows, int w0, int wstride) {
    const Frame F = relaunder(F0);
    f32x4 g[4];
#pragma unroll
    for (int j = 0; j < 4; ++j) g[j] = ((const f32x4*)gain)[F.lane + 64 * j];
    for (int m = w0; m < rows; m += wstride) {
        f32x4* xr = (f32x4*)(x + (size_t)m * DM) + F.lane;
        f32x4 v[4]; float s = 0.f;
#pragma unroll
        for (int j = 0; j < 4; ++j) { v[j] = xr[64 * j]; s += (v[j].x * v[j].x + v[j].y * v[j].y) + (v[j].z * v[j].z + v[j].w * v[j].w); }
        const float rstd = 1.f / sqrtf(wave_sum(s) * (1.f / DM) + 1e-6f);
#pragma unroll
        for (int j = 0; j < 4; ++j) xr[64 * j] = v[j] * rstd * g[j];
    }
}

__device__ __forceinline__ void transpose_item(const float* src, int ldsrc, int nvalid, int k0, f16* WT, int ldk, int lane, LAS float* scr) {
#pragma unroll 8
    for (int i = 0; i < 32; ++i) { const int kk = 2 * i + (lane >> 5), n = lane & 31; scr[kk * 33 + n] = (n < nvalid) ? src[(size_t)(k0 + kk) * ldsrc + n] : 0.f; }
    LDS_WAIT(); asm volatile("" ::: "memory");
    const int c = lane & 7;
#pragma unroll
    for (int j = 0; j < 4; ++j) { const int n = (lane >> 3) + 8 * j; const LAS float* s = scr + (8 * c) * 33 + n;
        u32x4 o; o.x = pk2h(s[0 * 33], s[1 * 33]); o.y = pk2h(s[2 * 33], s[3 * 33]); o.z = pk2h(s[4 * 33], s[5 * 33]); o.w = pk2h(s[6 * 33], s[7 * 33]);
        *(u32x4*)(WT + (size_t)n * ldk + k0 + 8 * c) = o; }
    LDS_WAIT(); asm volatile("" ::: "memory");
}
struct TJob { const float* src; int ldsrc, K, ncols; f16* dst; int ldk; };
__device__ __forceinline__ TJob tjob(KArgs a, unsigned char* ws, int l, int j) {
    unsigned char* wl = ws + WS_W + (size_t)l * W_LAYER; TJob t;
    const float* w_in = INP(a, I_WIN) + (size_t)l * DM * NIN;
    switch (j) {
    case 0:  t = TJob{w_in, NIN, DM, 2464, (f16*)(wl + W_IN), DM}; break;
    case 1:  t = TJob{w_in + 2464, NIN, DM, 8, (f16*)(wl + W_IN) + (size_t)2464 * DM, DM}; break;
    case 2:  t = TJob{w_in, NIN, DM, 0, (f16*)(wl + W_IN) + (size_t)2496 * DM, DM}; break;
    case 3:  t = TJob{w_in, NIN, DM, 0, (f16*)(wl + W_IN) + (size_t)2528 * DM, DM}; break;
    case 4:  t = TJob{w_in + 2472, NIN, DM, 3584, (f16*)(wl + W_IN) + (size_t)2560 * DM, DM}; break;
    case 5:  t = TJob{INP(a, I_WIQ) + (size_t)l * 256 * 256, 256, 256, 256, (f16*)(wl + W_DQ) + (size_t)1024 * 256, 256}; break;
    case 6:  t = TJob{INP(a, I_WMEMKV) + (size_t)l * DM * 1024, 1024, DM, 1024, (f16*)(wl + W_MKV), DM}; break;
    case 7:  t = TJob{INP(a, I_WRETO) + (size_t)l * 512 * DM, DM, 512, 1024, (f16*)(wl + W_RM), 1024}; break;
    case 8:  t = TJob{INP(a, I_WMEMO) + (size_t)l * 512 * DM, DM, 512, 1024, (f16*)(wl + W_RM) + 512, 1024}; break;
    case 9:  t = TJob{INP(a, I_WOUT) + (size_t)l * DM * DM, DM, DM, 1024, (f16*)(wl + W_OUT), DM}; break;
    case 10: t = TJob{INP(a, I_WFF1) + (size_t)l * DM * FF, FF, DM, FF, (f16*)(wl + W_FF1), DM}; break;
    default: t = TJob{INP(a, I_WFF2) + (size_t)l * FF * DM, DM, FF, 1024, (f16*)(wl + W_FF2), FF}; break;
    }
    return t;
}
constexpr int NTJOBS = 12;

__device__ __forceinline__ int t5_bucket(int rel) {
    const int base = rel > 0 ? 16 : 0; const int n = rel < 0 ? -rel : rel;
    if (n < 8) return base + n;
    int lg = 8 + (n >= 12) + (n >= 16) + (n >= 23) + (n >= 32) + (n >= 46) + (n >= 64) + (n >= 91); if (lg > 15) lg = 15;
    return base + lg;
}

__device__ __forceinline__ void p_prologue(const Frame& F0, KArgs a) {
    const Frame F = relaunder(F0);
    LAS float* scr = (LAS float*)(F.lds + F.wave * 16384);
    const int gw = blockIdx.x * NWAVES + F.wave, NGW = F.G * NWAVES;
    for (int l = 0; l < DEPTH; ++l)
        for (int j = 0; j < NTJOBS; ++j) {
            const TJob t = tjob(a, F.ws, l, j);
            const int nblk = (t.ncols + 31) / 32 > 0 ? (t.ncols + 31) / 32 : 1, items = (t.K / 64) * nblk;
            for (int it = gw; it < items; it += NGW) { const int kb = it / nblk, nb = it % nblk; int nv = t.ncols - 32 * nb; nv = nv > 32 ? 32 : (nv < 0 ? 0 : nv);
                transpose_item(t.src + 32 * nb, t.ldsrc, nv, 64 * kb, t.dst + (size_t)(32 * nb) * t.ldk, t.ldk, F.lane, scr); }
        }
    const int gt = blockIdx.x * NTHREADS + F.tid, NGT = F.G * NTHREADS;
    for (int l = 0; l < DEPTH; ++l) {
        unsigned char* wl = F.ws + WS_W + (size_t)l * W_LAYER;
        const float* wuq = INP(a, I_WUQ) + (size_t)l * 256 * 512; const float* wuk = INP(a, I_WUK) + (size_t)l * 128 * 512;
        f16* wdq = (f16*)(wl + W_DQ);
        for (int e = gt; e < 1024 * 256; e += NGT) {
            const int n = e >> 8, k = e & 255, h = n >> 7, r = n & 127;
            const float* pa = wuq + ((size_t)k * 8 + h) * 64; const float* pb = wuk + ((size_t)r * 8 + h) * 64; float s = 0.f;
            for (int d = 0; d < 64; ++d) s += pa[d] * pb[d];
            wdq[e] = (f16)(s * 0.125f);
        }
        const float* wuv = INP(a, I_WUV) + (size_t)l * 128 * 512; const float* wdo = INP(a, I_WDSAO) + (size_t)l * 512 * DM;
        f16* wvo = (f16*)(wl + W_VO);
        for (int e = gt; e < 1024 * 1024; e += NGT) {
            const int n = e & 1023, kk = e >> 10, h = kk >> 7, r = kk & 127;
            const float* pa = wuv + ((size_t)r * 8 + h) * 64; const float* pb = wdo + (size_t)(h * 64) * DM + n; float s = 0.f;
            for (int d = 0; d < 64; ++d) s += pa[d] * pb[(size_t)d * DM];
            wvo[(size_t)n * 1024 + kk] = (f16)s;
        }
    }
    float* rc = (float*)(F.ws + WS_ROPE); float* rs = rc + 4096 * 32;
    for (int e = gt; e < 4096 * 32; e += NGT) { const int pos = e >> 5, i = e & 31; const float fr = exp2f(-(float)i * (13.287712379549449f / 32.f)), ang = (float)pos * fr; rc[e] = cosf(ang); rs[e] = sinf(ang); }
    float* tb = (float*)(F.ws + WS_TB);
    for (int e = gt; e < 256 * 8; e += NGT) { const int ri = e >> 3, h = e & 7; tb[e] = INP(a, I_RELBIAS)[t5_bucket(ri - 192) * 8 + h]; }
}

__device__ __forceinline__ void p_dsa_norms(const Frame& F0, KArgs a, int l, int w0, int wstride) {
    const Frame F = relaunder(F0);
    f16* CQ = (f16*)(F.ws + WS_CQ); const f16* MISC = (const f16*)(F.ws + WS_MISC); f16* CKVN = (f16*)(F.ws + WS_CKVN);
    const float* qn = INP(a, I_QNORM) + l * 256; const float* kn = INP(a, I_KVNORM) + l * 128;
    const f32x4 gq = ((const f32x4*)qn)[F.lane]; const f32x2 gk = ((const f32x2*)kn)[F.lane];
    for (int m = w0; m < T; m += wstride) {
        h4* cq = (h4*)(CQ + (size_t)m * 256) + F.lane; const h4 v = *cq;
        const h2 kv = *((const h2*)(MISC + (size_t)m * 256) + F.lane);
        const float q0 = v[0], q1 = v[1], q2 = v[2], q3 = v[3], k0 = kv[0], k1 = kv[1];
        const float sq = wave_sum(q0 * q0 + q1 * q1 + q2 * q2 + q3 * q3), sk = wave_sum(k0 * k0 + k1 * k1);
        const float rq = 1.f / sqrtf(sq * (1.f / 256.f) + 1e-6f), rk = 1.f / sqrtf(sk * (1.f / 128.f) + 1e-6f);
        u32x2 w; w.x = pk2h(q0 * rq * gq.x, q1 * rq * gq.y); w.y = pk2h(q2 * rq * gq.z, q3 * rq * gq.w); *(u32x2*)cq = w;
        *((unsigned*)(CKVN + (size_t)m * 128) + F.lane) = pk2h(k0 * rk * gk.x, k1 * rk * gk.y);
    }
}
__device__ __forceinline__ void p_retention_simple(const Frame& F0, int unit) {
    const Frame F = relaunder(F0);
    const int b = unit >> 3, h = unit & 7;
    LAS float* Qf = (LAS float*)F.lds; LAS float* Kf = Qf + 64 * 65; LAS float* Vf = Kf + 64 * 65; LAS float* Sf = Vf + 64 * 65; LAS float* St = Sf + 64 * 65; LAS float* Of = St + 64 * 65; LAS float* Kd = Of + 64 * 65;
    const f16* RQ = (const f16*)(F.ws + WS_RQ); const f16* RK = (const f16*)(F.ws + WS_RK); const f16* RV = (const f16*)(F.ws + WS_RV); f16* GM = (f16*)(F.ws + WS_GM);
    const float* rc = (const float*)(F.ws + WS_ROPE); const float* rs = rc + 4096 * 32;
    const float lg = log2f(1.f - exp2f(-5.f - (float)h));
    const int tid = F.tid, i = tid >> 3, cg = tid & 7;
    for (int e = tid; e < 64 * 65; e += NTHREADS) St[e] = 0.f;
    if (tid < 64) Kd[tid] = exp2f(lg * (float)(63 - tid));
    const float g64 = exp2f(lg * 64.f);
    for (int n = 0; n < 64; ++n) {
        const size_t row = (size_t)b * SEQ + 64 * n + i; const int pos = 64 * n + i;
        const h8 qv = *(const h8*)(RQ + row * 512 + h * 64 + 8 * cg), kv = *(const h8*)(RK + row * 512 + h * 64 + 8 * cg), vv = *(const h8*)(RV + row * 512 + h * 64 + 8 * cg);
        const h8 gv = *(const h8*)(GM + row * 1024 + h * 64 + 8 * cg);
        const float* cp = rc + pos * 32 + 8 * (cg & 3); const float* sp = rs + pos * 32 + 8 * (cg & 3);
#pragma unroll
        for (int j = 0; j < 8; ++j) {
            const float q = (float)qv[j], k = (float)kv[j]; const float pq = __shfl_xor(q, 4), pk = __shfl_xor(k, 4); const float c = cp[j], s = sp[j];
            const float qo = (cg < 4) ? (q * c - pq * s) : (q * c + pq * s), ko = (cg < 4) ? (k * c - pk * s) : (k * c + pk * s);
            Qf[i * 65 + 8 * cg + j] = qo; Kf[i * 65 + 8 * cg + j] = ko * 0.125f; Vf[i * 65 + 8 * cg + j] = (float)vv[j];
        }
        __syncthreads();
#pragma unroll 1
        for (int jj = 0; jj < 8; ++jj) { const int j = cg + 8 * jj; float s = 0.f;
            for (int d = 0; d < 64; ++d) s += Qf[i * 65 + d] * Kf[j * 65 + d];
            const int dd = i > j ? i - j : j - i; Sf[i * 65 + j] = s * exp2f(lg * (float)dd); }
        __syncthreads();
        float ns[8];
        const float qd = exp2f(lg * (float)(i + 1));
#pragma unroll 1
        for (int ee = 0; ee < 8; ++ee) { const int e = cg + 8 * ee; float s1 = 0.f, s2 = 0.f, s3 = 0.f;
            for (int j = 0; j < 64; ++j) s1 += Sf[i * 65 + j] * Vf[j * 65 + e];
            for (int d = 0; d < 64; ++d) s2 += Qf[i * 65 + d] * St[d * 65 + e];
            Of[i * 65 + e] = s1 + qd * s2;
            for (int j = 0; j < 64; ++j) s3 += Kf[j * 65 + i] * Kd[j] * Vf[j * 65 + e];
            ns[ee] = g64 * St[i * 65 + e] + s3; }
        __syncthreads();
#pragma unroll
        for (int ee = 0; ee < 8; ++ee) St[i * 65 + cg + 8 * ee] = ns[ee];
        float ov[8]; float s = 0.f;
#pragma unroll
        for (int j = 0; j < 8; ++j) { ov[j] = Of[i * 65 + 8 * cg + j]; s += ov[j]; }
        s += __shfl_xor(s, 1); s += __shfl_xor(s, 2); s += __shfl_xor(s, 4);
        const float mu = s * (1.f / 64.f); float q = 0.f;
#pragma unroll
        for (int j = 0; j < 8; ++j) { ov[j] -= mu; q += ov[j] * ov[j]; }
        q += __shfl_xor(q, 1); q += __shfl_xor(q, 2); q += __shfl_xor(q, 4);
        const float rstd = 1.f / sqrtf(q * (1.f / 64.f) + 1e-5f);
        float ro[8];
#pragma unroll
        for (int j = 0; j < 8; ++j) { const float g = (float)gv[j]; ro[j] = ov[j] * rstd * (g / (1.f + __expf(-g))); }
        u32x4 w; w.x = pk2h(ro[0], ro[1]); w.y = pk2h(ro[2], ro[3]); w.z = pk2h(ro[4], ro[5]); w.w = pk2h(ro[6], ro[7]);
        *(u32x4*)(GM + row * 1024 + h * 64 + 8 * cg) = w;
        __syncthreads();
    }
}

__device__ __forceinline__ unsigned fkey(float v) { const unsigned b = __float_as_uint(v); return b ^ ((unsigned)((int)b >> 31) | 0x80000000u); }
__device__ __forceinline__ void p_topk(const Frame& F0) {
    const Frame F = relaunder(F0);
    LAS float* sc = (LAS float*)F.lds;
    LAS float* qi = (LAS float*)(F.lds + 131072);
    LAS float* wq = (LAS float*)(F.lds + 131072 + 8192);
    LAS unsigned* hist = (LAS unsigned*)(F.lds + 131072 + 8192 + 256) + F.wave * 256;
    const f16* QIDX = (const f16*)(F.ws + WS_QIDX); const f16* MISC = (const f16*)(F.ws + WS_MISC); unsigned* MASK = (unsigned*)(F.ws + WS_MASK);
    const int tid = F.tid, lane = F.lane, wave = F.wave;
    for (int idx = blockIdx.x; idx < 8192; idx += F.G) {
        const int kq = idx & 255, r = idx >> 8, b = kq & 15, j = kq >> 4, sel = r >> 3, sub = r & 7;
        const int c = sel == 0 ? j : (sel == 1 ? 31 - j : (sel == 2 ? 32 + j : 63 - j));
        const int N = 64 * (c + 1), t0 = b * SEQ + 64 * c + 8 * sub, NTe = (c + 2) & ~1;
        unsigned long long* mrow = (unsigned long long*)(MASK + (size_t)(t0 + wave) * 128);
        if (c < 4) { if (lane < NTe) mrow[lane] = lane < (c + 1) ? ~0ull : 0ull; continue; }
        for (int e = tid; e < 2048; e += NTHREADS) qi[e] = (float)QIDX[(size_t)(t0 + (e >> 8)) * 256 + (e & 255)];
        if (tid < 64) wq[tid] = (float)MISC[(size_t)(t0 + (tid >> 3)) * 256 + 160 + (tid & 7)];
        __syncthreads();
        for (int key = tid; key < N; key += NTHREADS) {
            const h8* kp = (const h8*)(MISC + (size_t)(b * SEQ + key) * 256 + 128);
            const h8 k0 = kp[0], k1 = kp[1], k2 = kp[2], k3 = kp[3];
            float kf[32];
#pragma unroll
            for (int d = 0; d < 8; ++d) { kf[d] = (float)k0[d]; kf[8 + d] = (float)k1[d]; kf[16 + d] = (float)k2[d]; kf[24 + d] = (float)k3[d]; }
#pragma unroll 1
            for (int q = 0; q < 8; ++q) { float s = 0.f;
#pragma unroll 1
                for (int h = 0; h < 8; ++h) { float dot = 0.f; const LAS f32x4* qp = (const LAS f32x4*)(qi + q * 256 + h * 32);
#pragma unroll
                    for (int d = 0; d < 8; ++d) { const f32x4 qv = qp[d]; dot += qv.x * kf[4 * d] + qv.y * kf[4 * d + 1] + qv.z * kf[4 * d + 2] + qv.w * kf[4 * d + 3]; }
                    s += wq[q * 8 + h] * fmaxf(dot, 0.f); }
                sc[q * 4096 + key] = s + 0.f; }
        }
        __syncthreads();
        {
            const LAS float* s = sc + wave * 4096; const int ni = N >> 6;
            unsigned prefix = 0; int krem = 256;
#pragma unroll 1
            for (int pass = 0; pass < 4; ++pass) {
                const int shift = 24 - 8 * pass;
                hist[lane] = 0u; hist[lane + 64] = 0u; hist[lane + 128] = 0u; hist[lane + 192] = 0u;
                for (int i = 0; i < ni; ++i) { const unsigned u = fkey(s[i * 64 + lane]); const bool in = (pass == 0) || ((u >> (shift + 8)) == prefix);
                    if (in) atomicAdd((unsigned*)&hist[(u >> shift) & 255u], 1u); }
                LDS_WAIT();
                const int c0 = (int)hist[4 * lane], c1 = (int)hist[4 * lane + 1], c2 = (int)hist[4 * lane + 2], c3 = (int)hist[4 * lane + 3];
                const int tl = c0 + c1 + c2 + c3; int x = tl;
#pragma unroll
                for (int off = 1; off < 64; off <<= 1) { const int y = __shfl_down(x, off); if (lane + off < 64) x += y; }
                const int Sx = x - tl;
                const bool mine = (Sx < krem) && (krem <= Sx + tl);
                const unsigned long long bm = __ballot(mine);
                const int src = bm ? (__ffsll((long long)bm) - 1) : 0;
                int dd, gt; { int acc = Sx; if (acc + c3 >= krem) { dd = 3; gt = acc; } else { acc += c3; if (acc + c2 >= krem) { dd = 2; gt = acc; } else { acc += c2; if (acc + c1 >= krem) { dd = 1; gt = acc; } else { acc += c1; dd = 0; gt = acc; } } } }
                dd += 4 * lane;
                dd = __shfl(dd, src); gt = __shfl(gt, src);
                prefix = (prefix << 8) | (unsigned)dd; krem -= gt;
            }
            int tbf = 0; unsigned long long myword = 0ull;
            for (int i = 0; i < ni; ++i) { const unsigned u = fkey(s[i * 64 + lane]); const bool gtb = u > prefix, eq = u == prefix;
                const unsigned long long beq = __ballot(eq); const int rank = tbf + __popcll(beq & ((1ull << lane) - 1ull));
                const unsigned long long bs = __ballot(gtb || (eq && rank < krem)); if (lane == i) myword = bs; tbf += __popcll(beq); }
            if (lane < NTe) mrow[lane] = myword;
        }
        __syncthreads();
    }
}

__device__ __forceinline__ void p_dsa_attn_simple(const Frame& F0) {
    const Frame F = relaunder(F0);
    f16* OLAT = (f16*)(F.ws + WS_H); const f16* CKVN = (const f16*)(F.ws + WS_CKVN); const unsigned* MASK = (const unsigned*)(F.ws + WS_MASK); const float* tb = (const float*)(F.ws + WS_TB);
    const int gw = blockIdx.x * NWAVES + F.wave, NGW = F.G * NWAVES, lane = F.lane;
    for (int task = gw; task < T * 8; task += NGW) {
        const int t = task >> 3, h = task & 7, b = t >> 12, tp = t & 4095, c = tp >> 6, N = 64 * (c + 1);
        h2* qp = (h2*)(OLAT + (size_t)t * 1024 + h * 128) + lane; const h2 qv = *qp; const float q0 = qv[0], q1 = qv[1];
        const unsigned* mrow = MASK + (size_t)t * 128;
        float m = -1e30f, ls = 0.f, o0 = 0.f, o1 = 0.f;
        for (int w = 0; w < N / 32; ++w) {
            unsigned bits = __builtin_amdgcn_readfirstlane(mrow[w]);
            while (bits) { const int bit = __builtin_ctz(bits); bits &= bits - 1u; const int s = 32 * w + bit;
                const h2 cv = *((const h2*)(CKVN + (size_t)(b * SEQ + s) * 128) + lane); const float c0 = cv[0], c1 = cv[1];
                const float part = wave_sum(q0 * c0 + q1 * c1);
                const int rel = s - tp, ri = rel < -192 ? 0 : rel + 192;
                const float logit = part + tb[ri * 8 + h];
                const float mn = fmaxf(m, logit), al = __expf(m - mn), p = __expf(logit - mn);
                ls = ls * al + p; o0 = o0 * al + p * c0; o1 = o1 * al + p * c1; m = mn; }
        }
        const float inv = 1.f / ls;
        *(unsigned*)qp = pk2h(o0 * inv, o1 * inv);
    }
}

constexpr int PH_PRO = 0, PH_PER_LAYER = 11, PH_FINAL = 1 + DEPTH * PH_PER_LAYER, NPHASES = PH_FINAL + 1;
#ifndef PG8_SP2
#define PG8_SP2 true
#endif
#ifndef PG8_ALIGN
#define PG8_ALIGN true
#endif

__global__ void __launch_bounds__(NTHREADS, 2) mega_fwd(Args args) {
    extern __shared__ __attribute__((aligned(16))) unsigned char lds[];
    KArgs kp = (KArgs)__builtin_amdgcn_kernarg_segment_ptr();
    asm volatile("" : "+s"(kp));
    Frame F;
    F.lds = (LAS unsigned char*)lds; F.ldsg = (char*)lds; F.ws = args.ws;
    F.tid = threadIdx.x; F.lane = F.tid & 63; F.wave = __builtin_amdgcn_readfirstlane(F.tid >> 6); F.G = gridDim.x;
    volatile LAS unsigned* MISCW = (volatile LAS unsigned*)(F.lds + LDSCTL_OFF);
    if (F.tid < 64) MISCW[F.tid] = 0u;
    __syncthreads();
    unsigned* ctl = (unsigned*)(args.ws + WS_CTL);
    XcdBarrier bar; bar.bar = ctl + CW_BAR; bar.x = 0; bar.st = MISCW + 8;
    const int lo = args.ph_lo, hi = args.ph_hi;
    if (hi - lo > 1) bar = xcd_barrier_post(ctl + CW_BAR, MISCW + 8);
#ifndef PHMASK
#define PHMASK 0xFFFF
#endif
#define HAS(p) ((PHMASK >> (p)) & 1)
#define IN(k) (lo <= (k) && (k) < hi)
#define SEAM(k) do { if (IN(k) && IN((k) + 1)) xcd_barrier(bar); } while (0)
    const int gw = blockIdx.x * NWAVES + F.wave, NGW = F.G * NWAVES;
    unsigned char* ws0 = args.ws;
    float* xout0 = args.out;
#define PHASE_PTRS GAS unsigned char* wsg_ = (GAS unsigned char*)ws0; GAS float* xog_ = (GAS float*)xout0; asm volatile("" : "+s"(wsg_), "+s"(xog_)); unsigned char* ws = (unsigned char*)wsg_; float* xout = (float*)xog_; unsigned char* wl = ws + WS_W + (size_t)l * W_LAYER; (void)wl; (void)xout;

    if (HAS(11) && IN(PH_PRO)) { p_prologue(F, kp); }
    SEAM(PH_PRO);

    for (int l = 0; l < DEPTH; ++l) {
        const int P0 = 1 + l * PH_PER_LAYER;

        if (HAS(0) && IN(P0 + 0)) { PHASE_PTRS
            norm_rows_f16(F, (l == 0) ? INP(kp, I_X) : (const float*)xout, INP(kp, I_NORM1) + l * DM, (f16*)(ws + WS_H), T, gw, NGW);
            norm_rows_f16(F, INP(kp, I_MEM), INP(kp, I_MEMNORM) + l * DM, (f16*)(ws + WS_MEMN), BATCH * MEMLEN, gw, NGW);
        }
        SEAM(P0 + 0);
        if (HAS(1) && IN(P0 + 1)) { PHASE_PTRS
            {
              pg8::Order<1> S; S.init(T, NZ, F.G, (int)blockIdx.x);
              pg8::EpiF16<0> E{};
              E.base[0] = (f16*)(ws + WS_RQ); E.ld[0] = 512; E.lo[0] = 0;
              E.base[1] = (f16*)(ws + WS_RK); E.ld[1] = 512; E.lo[1] = 2;
              E.base[2] = (f16*)(ws + WS_RV); E.ld[2] = 512; E.lo[2] = 4;
              E.base[3] = (f16*)(ws + WS_GM); E.ld[3] = 1024; E.lo[3] = 6;
              E.base[4] = (f16*)(ws + WS_CQ); E.ld[4] = 256; E.lo[4] = 8;
              E.base[5] = (f16*)(ws + WS_MISC); E.ld[5] = 256; E.lo[5] = 9;
              E.base[6] = (f16*)(ws + WS_GM) + 512; E.ld[6] = 1024; E.lo[6] = 10;
              E.base[7] = (f16*)(ws + WS_GATES); E.ld[7] = 3072; E.lo[7] = 12; E.nd = 8;
              pg8::gemm_phase<pg8::EpiF16<0>, 1, PG8_ALIGN, PG8_SP2>(F.lds, (const f16*)(ws + WS_H), nullptr, nullptr, (const f16*)(wl + W_IN), nullptr, nullptr, DM, 0, 0, DM, DM, S, E); }
            {
              pg8::Order<1> S; S.init(BATCH * MEMLEN, 1024, F.G, (int)blockIdx.x);
              pg8::EpiF16<0> E{}; E.base[0] = (f16*)(ws + WS_MKV); E.ld[0] = 1024; E.lo[0] = 0; E.nd = 1;
              pg8::gemm_phase<pg8::EpiF16<0>, 1, PG8_ALIGN, PG8_SP2>(F.lds, (const f16*)(ws + WS_MEMN), nullptr, nullptr, (const f16*)(wl + W_MKV), nullptr, nullptr, DM, 0, 0, DM, DM, S, E); }
        }
        SEAM(P0 + 1);
        if (HAS(2) && IN(P0 + 2)) { PHASE_PTRS
            if (F.G >= 256) { if (blockIdx.x >= 128) p_dsa_norms(F, kp, l, (blockIdx.x - 128) * NWAVES + F.wave, (F.G - 128) * NWAVES); }
            else p_dsa_norms(F, kp, l, gw, NGW);
            for (int u = blockIdx.x; u < 128; u += F.G) p_retention_simple(F, u);
        }
        SEAM(P0 + 2);
        if (HAS(3) && IN(P0 + 3)) { PHASE_PTRS

            pg8::Order<1> S; S.init(T, 1280, F.G, (int)blockIdx.x);
            pg8::EpiF16<0> E{}; E.base[0] = (f16*)(ws + WS_H); E.ld[0] = 1024; E.lo[0] = 0; E.base[1] = (f16*)(ws + WS_QIDX); E.ld[1] = 256; E.lo[1] = 4; E.nd = 2;
            pg8::gemm_phase<pg8::EpiF16<0>, 1, PG8_ALIGN, PG8_SP2>(F.lds, (const f16*)(ws + WS_CQ), nullptr, nullptr, (const f16*)(wl + W_DQ), nullptr, nullptr, 256, 0, 0, 256, 256, S, E);
        }
        SEAM(P0 + 3);
        if (HAS(4) && IN(P0 + 4)) { p_topk(F); }
        SEAM(P0 + 4);
        if (HAS(5) && IN(P0 + 5)) { PHASE_PTRS
            p_dsa_attn_simple(F);
            f16* GM = (f16*)(ws + WS_GM); const f16* MKV = (const f16*)(ws + WS_MKV);
            for (int u = blockIdx.x; u < BATCH * 4 * 16; u += F.G) {
                const int b = u >> 6, h = (u >> 4) & 3, qb = u & 15;
                f16* q = GM + (size_t)(b * SEQ + qb * 256) * 1024 + 512 + h * 128; const f16* k = MKV + (size_t)(b * MEMLEN) * 1024 + h * 128;
                __syncthreads();
                att::attn_dense_body<1024, 1024, 1024>(q, k, k + 512, q, MEMLEN, F.ldsg, 0.088388347648318440f);
            }
        }
        SEAM(P0 + 5);
        if (HAS(6) && IN(P0 + 6)) { PHASE_PTRS
            const f16* GM = (const f16*)(ws + WS_GM); const f16* WRM = (const f16*)(wl + W_RM);

            pg8::Order<3> S; S.init(T, 1024, F.G, (int)blockIdx.x);
            pg8::EpiMerge E{(const f16*)(ws + WS_GATES), (f16*)(ws + WS_MERGED)};
            pg8::gemm_phase<pg8::EpiMerge, 3, PG8_ALIGN, PG8_SP2>(F.lds, GM, (const f16*)(ws + WS_H), GM + 512, WRM, (const f16*)(wl + W_VO), WRM + 512, 512, 1024, 512, 1024, 1024, S, E);
        }
        SEAM(P0 + 6);
        if (HAS(7) && IN(P0 + 7)) { PHASE_PTRS

            pg8::Order<1> S; S.init(T, DM, F.G, (int)blockIdx.x);
            pg8::EpiRes E{(l == 0) ? INP(kp, I_X) : (const float*)xout, xout, DM};
            pg8::gemm_phase<pg8::EpiRes, 1, PG8_ALIGN, PG8_SP2>(F.lds, (const f16*)(ws + WS_MERGED), nullptr, nullptr, (const f16*)(wl + W_OUT), nullptr, nullptr, DM, 0, 0, DM, DM, S, E);
        }
        SEAM(P0 + 7);
        if (HAS(8) && IN(P0 + 8)) { PHASE_PTRS norm_rows_f16(F, xout, INP(kp, I_NORM2) + l * DM, (f16*)(ws + WS_H), T, gw, NGW); }
        SEAM(P0 + 8);
        if (HAS(9) && IN(P0 + 9)) { PHASE_PTRS

            pg8::Order<1> S; S.init(T, FF, F.G, (int)blockIdx.x);
            pg8::EpiF16<1> E{}; E.base[0] = (f16*)(ws + WS_HID); E.ld[0] = FF; E.lo[0] = 0; E.nd = 1;
            pg8::gemm_phase<pg8::EpiF16<1>, 1, PG8_ALIGN, PG8_SP2>(F.lds, (const f16*)(ws + WS_H), nullptr, nullptr, (const f16*)(wl + W_FF1), nullptr, nullptr, DM, 0, 0, DM, DM, S, E);
        }
        SEAM(P0 + 9);
        if (HAS(10) && IN(P0 + 10)) { PHASE_PTRS

            pg8::Order<1> S; S.init(T, DM, F.G, (int)blockIdx.x);
            pg8::EpiRes E{xout, xout, DM};
            pg8::gemm_phase<pg8::EpiRes, 1, PG8_ALIGN, PG8_SP2>(F.lds, (const f16*)(ws + WS_HID), nullptr, nullptr, (const f16*)(wl + W_FF2), nullptr, nullptr, FF, 0, 0, FF, FF, S, E);
        }
        SEAM(P0 + 10);
    }
    if (HAS(12) && IN(PH_FINAL)) { const int l = 0; PHASE_PTRS norm_rows_f32_inplace(F, xout, INP(kp, I_FINALNORM), T, gw, NGW); }
#undef IN
#undef SEAM
}

extern "C" void kernel_launch(void* const* d_in, const int* in_sizes, int n_in, void* d_out, int out_size, void* d_ws, size_t ws_size, hipStream_t stream) {
    static int grid = 0;
    if (grid == 0) {
        if (n_in != 21 || in_sizes[0] != T * DM || out_size != T * DM || ws_size < WS_END) {
            fprintf(stderr, "kernel_launch: shape mismatch (n_in %d, in0 %d, out %d, ws %zu < %zu); nothing launched\n", n_in, n_in > 0 ? in_sizes[0] : -1, out_size, ws_size, (size_t)WS_END); grid = -1; return; }
        int dev = 0, cus = 0;
        if (hipGetDevice(&dev) != hipSuccess || hipDeviceGetAttribute(&cus, hipDeviceAttributeMultiprocessorCount, dev) != hipSuccess) { grid = -1; return; }
        if (hipFuncSetAttribute((const void*)mega_fwd, hipFuncAttributeMaxDynamicSharedMemorySize, LDS_BYTES) != hipSuccess) { fprintf(stderr, "kernel_launch: hipFuncSetAttribute failed\n"); grid = -1; return; }
        int per_cu = 0;
        if (hipOccupancyMaxActiveBlocksPerMultiprocessor(&per_cu, (const void*)mega_fwd, NTHREADS, LDS_BYTES) != hipSuccess || per_cu < 1)
            fprintf(stderr, "kernel_launch: note: occupancy query reports %d workgroups per CU\n", per_cu);
        (void)hipGetLastError();
        grid = cus;
    }
    if (grid < 0) return;
    (void)hipMemsetAsync((char*)d_ws + WS_CTL, 0, CTL_ZERO_BYTES, stream);
    Args a{};
    for (int i = 0; i < 21; ++i) a.in[i] = (const float*)d_in[i];
    a.out = (float*)d_out; a.ws = (unsigned char*)d_ws;
#if MK_SPLIT
    for (int p = 0; p < NPHASES; ++p) { a.ph_lo = p; a.ph_hi = p + 1; hipLaunchKernelGGL(mega_fwd, dim3(grid), dim3(NTHREADS), LDS_BYTES, stream, a); }
#else
    a.ph_lo = 0; a.ph_hi = NPHASES; hipLaunchKernelGGL(mega_fwd, dim3(grid), dim3(NTHREADS), LDS_BYTES, stream, a);
#endif
    const hipError_t le = hipPeekAtLastError();
    if (le != hipSuccess) fprintf(stderr, "kernel_launch: launch failed: %s\n", hipGetErrorName(le));
}
```

```cpp
#include <hip/hip_runtime.h>
#include <cstdio>
#include <cstdint>

#ifndef MK_SPLIT
#define MK_SPLIT 0
#endif

#define GAS __attribute__((address_space(1)))
#define LAS __attribute__((address_space(3)))
typedef _Float16 f16;
typedef _Float16 h8 __attribute__((ext_vector_type(8)));
typedef _Float16 h4 __attribute__((ext_vector_type(4)));
typedef _Float16 h2 __attribute__((ext_vector_type(2)));
typedef float f32x2 __attribute__((ext_vector_type(2)));
typedef float f32x4 __attribute__((ext_vector_type(4)));
typedef float f32x8 __attribute__((ext_vector_type(8)));
typedef float f32x16 __attribute__((ext_vector_type(16)));
typedef unsigned u32x4 __attribute__((ext_vector_type(4)));
typedef unsigned u32x2 __attribute__((ext_vector_type(2)));

constexpr int BATCH = 16, SEQ = 4096, DM = 1024, T = BATCH * SEQ, DEPTH = 2;
constexpr int NIN = 6056, NZ = 6144, FF = 4096, MEMLEN = 256;
constexpr int NWAVES = 8, NTHREADS = 512;

constexpr size_t MiB = 1u << 20;
constexpr size_t WS_CTL = 0, CTL_ZERO_BYTES = 1 * MiB;
constexpr size_t WS_ROPE = 1 * MiB;
constexpr size_t WS_TB = 2 * MiB;
constexpr size_t WS_W = 3 * MiB, W_LAYER = 37 * MiB;
constexpr size_t W_IN = 0, W_DQ = 12 * MiB, W_MKV = 13 * MiB, W_RM = 15 * MiB, W_VO = 17 * MiB, W_OUT = 19 * MiB, W_FF1 = 21 * MiB, W_FF2 = 29 * MiB;
constexpr size_t WS_MEMN = 77 * MiB, WS_MKV = 85 * MiB;
constexpr size_t WS_H = 93 * MiB;
constexpr size_t WS_RQ = 221 * MiB;
constexpr size_t WS_RK = 285 * MiB;
constexpr size_t WS_RV = 349 * MiB;
constexpr size_t WS_GM = 413 * MiB;
constexpr size_t WS_CQ = 541 * MiB;
constexpr size_t WS_MISC = 573 * MiB;
constexpr size_t WS_GATES = 605 * MiB;
constexpr size_t WS_CKVN = 989 * MiB;
constexpr size_t WS_HID = 221 * MiB;
constexpr size_t WS_END = 1005 * MiB;
constexpr size_t WS_QIDX = WS_RQ, WS_MASK = WS_RQ + 32 * MiB, WS_MERGED = WS_RK;

constexpr int LDS_BYTES = 163840;
constexpr int LDSCTL_OFF = LDS_BYTES - 256;

#define XB_TMO      128
#define XB_XCNT(j)  (256  + 64 * (j))
#define XB_XSUB(j)  (1280 + 64 * (j))
#define XB_XGEN(j)  (2304 + 64 * (j))
#define XB_TOP      3328
#define XB_TOPGEN   3392
#define XCD_BAR_WORDS 3456
#define XB_SPIN_CAP (1u << 21)
constexpr int CW_BAR = 4096;

__device__ __forceinline__ unsigned xb_ld(unsigned* p)              { return __hip_atomic_load(p, __ATOMIC_RELAXED, __HIP_MEMORY_SCOPE_AGENT); }
__device__ __forceinline__ unsigned xb_add(unsigned* p, unsigned v) { return __hip_atomic_fetch_add(p, v, __ATOMIC_RELAXED, __HIP_MEMORY_SCOPE_AGENT); }
__device__ __forceinline__ unsigned xb_xcc_id() { return (unsigned)__builtin_amdgcn_s_getreg((3 << 11) | 20) & 0xFu; }
#define XB_SPIN(cond, bar) do { unsigned _sp = 0; while (cond) { __builtin_amdgcn_s_sleep(1); \
    if ((++_sp & 255u) == 0u) { if (xb_ld(&(bar)[XB_TMO])) break; if (_sp > XB_SPIN_CAP) { atomicAdd(&(bar)[XB_TMO], 1u); break; } } } } while (0)

struct XcdBarrier { unsigned* bar; unsigned x; volatile LAS unsigned* st; };

__device__ __forceinline__ XcdBarrier xcd_barrier_post(unsigned* bar, volatile LAS unsigned* st) {
    XcdBarrier b; b.bar = bar; b.x = xb_xcc_id(); b.st = st;
    if (threadIdx.x == 0) (void)xb_add(&bar[XB_XCNT(b.x)], 1u);
    return b;
}
__device__ __forceinline__ void xcd_barrier_complete(unsigned* bar, unsigned x, unsigned& nloc, unsigned& nx) {
    const unsigned G = gridDim.x * gridDim.y * gridDim.z;
    unsigned sum, cnt, mine, sp = 0u;
    for (;;) {
        sum = 0u; cnt = 0u; mine = 0u;
#pragma unroll
        for (unsigned j = 0; j < 16; ++j) { const unsigned c = xb_ld(&bar[XB_XCNT(j)]); sum += c; cnt += (c > 0u) ? 1u : 0u; mine = (j == x) ? c : mine; }
        if (sum == G) break;
        __builtin_amdgcn_s_sleep(1);
        if ((++sp & 255u) == 0u) { if (xb_ld(&bar[XB_TMO])) break; if (sp > XB_SPIN_CAP) { atomicAdd(&bar[XB_TMO], 1u); break; } }
    }
    nloc = mine > 0u ? mine : 1u; nx = cnt > 0u ? cnt : 1u;
}
__device__ __forceinline__ void xcd_barrier(const XcdBarrier& b) {
    asm volatile("s_waitcnt vmcnt(0)" ::: "memory");
    __syncthreads();
    if (threadIdx.x == 0) {
        unsigned* bar = b.bar;
        __builtin_amdgcn_s_waitcnt(0);
        unsigned nloc = b.st[0], nx = b.st[1];
        if (nloc == 0u) { xcd_barrier_complete(bar, b.x, nloc, nx); b.st[0] = nloc; b.st[1] = nx; }
        const unsigned old = xb_add(&bar[XB_XSUB(b.x)], 1u);
        const unsigned gen = old / nloc;
        if (old + 1u == (gen + 1u) * nloc) {
            __builtin_amdgcn_fence(__ATOMIC_RELEASE, "agent");
            asm volatile("s_waitcnt vmcnt(0)" ::: "memory");
            const unsigned og = xb_add(&bar[XB_TOP], 1u);
            const unsigned tg = og / nx;
            if (og + 1u == (tg + 1u) * nx) xb_add(&bar[XB_TOPGEN], 1u);
            else XB_SPIN(xb_ld(&bar[XB_TOPGEN]) == tg, bar);
            __builtin_amdgcn_fence(__ATOMIC_ACQUIRE, "agent");
            xb_add(&bar[XB_XGEN(b.x)], 1u);
            asm volatile("s_waitcnt vmcnt(0)" ::: "memory");
        } else {
            XB_SPIN(xb_ld(&bar[XB_XGEN(b.x)]) == gen, bar);
            __builtin_amdgcn_fence(__ATOMIC_ACQUIRE, "agent");
            asm volatile("s_waitcnt vmcnt(0)" ::: "memory");
        }
    }
    __syncthreads();
}

__device__ __forceinline__ unsigned pk2h(float lo, float hi) { const h2 p = __builtin_convertvector((f32x2){lo, hi}, h2); return __builtin_bit_cast(unsigned, p); }
__device__ __forceinline__ float wave_sum(float v) {
#pragma unroll
    for (int o = 1; o < 64; o <<= 1) v += __shfl_xor(v, o);
    return v;
}
#define LDS_WAIT() asm volatile("s_waitcnt lgkmcnt(0)" ::: "memory")

namespace pg8 {
constexpr int BM = 256, BK = 64, HALF = 128, HTB = HALF * BK * 2, STAGE_BYTES = 8 * HTB, NXCD = 8, WGM = 8;
__host__ __device__ __forceinline__ int lds_byte(int r, int c) { const int st = (r >> 4) * 2 + (c >> 5), rr = r & 15, cc = c & 31, ob = rr * 64 + cc * 2; return st * 1024 + (ob ^ (((ob >> 9) & 1) << 5)); }
__host__ __device__ __forceinline__ void stage_rc(int b, int& R, int& C) { const int st = b / 1024, sb = b % 1024, swz = sb ^ (((sb >> 9) & 1) << 5); R = (st >> 1) * 16 + swz / 64; C = (st & 1) * 32 + (swz % 64) / 2; }
__host__ __device__ __forceinline__ int perm32(int rho) { const int n = rho >> 4, i = rho & 15; return 8 * (i >> 2) + 4 * n + (i & 3); }

struct Unit { int pm, pn, seg; };

template <int NSEG> struct Order {
    int nM, nN, nwg, G, c;
    __device__ void init(int M, int N, int G_, int c_) { nM = M / BM; nN = N / BM; nwg = nM * nN; G = G_; c = c_; }
    __device__ bool next(int i, Unit& u) const {
        const int ti = i / NSEG; u.seg = i - ti * NSEG;
        const long L = (long)ti * G + c; if (L >= nwg) return false;
        int wgid = (int)L; { const int q = nwg / NXCD, r = nwg % NXCD, xcd = wgid % NXCD, off = wgid / NXCD; wgid = (xcd < r ? xcd * (q + 1) : r * (q + 1) + (xcd - r) * q) + off; }
        const int nig = WGM * nN, gid = wgid / nig, fm = gid * WGM, gsz = (nM - fm) < WGM ? (nM - fm) : WGM;
        u.pm = fm + ((wgid % nig) % gsz); u.pn = (wgid % nig) / gsz; return true;
    }
};
__device__ __forceinline__ unsigned long long pick3(int seg, unsigned long long v0, unsigned long long v1, unsigned long long v2) {
    const unsigned long long m1 = (unsigned long long)0 - (unsigned long long)(seg == 1), m2 = (unsigned long long)0 - (unsigned long long)(seg == 2);
    return v0 + ((v1 - v0) & m1) + ((v2 - v0) & m2);
}

template <int ACT  > struct EpiF16 {
    static constexpr bool PERM = true;
    f16* base[8]; int ld[8]; int lo[8]; int nd;
    __device__ __forceinline__ void operator()(f32x4 (&acc)[2][2][4][2], const Unit& u, int wr, int wc, int fr, int fq) const {
        f16* b = base[0]; int l = ld[0]; int t0 = lo[0];
#pragma unroll
        for (int i = 1; i < 8; ++i) if (i < nd && u.pn >= lo[i]) { b = base[i]; l = ld[i]; t0 = lo[i]; }
        const int row0 = u.pm * BM + wr * 64 + fr, col0 = (u.pn - t0) * BM + wc * 32 + 8 * fq;
#pragma unroll
        for (int ai = 0; ai < 2; ++ai)
#pragma unroll
            for (int m = 0; m < 4; ++m) { f16* rowp = b + (size_t)(row0 + ai * HALF + m * 16) * l + col0;
#pragma unroll
                for (int bj = 0; bj < 2; ++bj) { f32x4 v0 = acc[ai][bj][m][0], v1 = acc[ai][bj][m][1];
                    if (ACT == 1) {
#pragma unroll
                        for (int j = 0; j < 4; ++j) { const float a = fmaxf(v0[j], 0.f), c = fmaxf(v1[j], 0.f); v0[j] = a * a; v1[j] = c * c; } }
                    u32x4 w; w.x = pk2h(v0[0], v0[1]); w.y = pk2h(v0[2], v0[3]); w.z = pk2h(v1[0], v1[1]); w.w = pk2h(v1[2], v1[3]);
                    *(u32x4*)(rowp + bj * HALF) = w; } }
    }
};
struct EpiRes {
    static constexpr bool PERM = false;
    const float* base; float* out; int ldc;
    __device__ __forceinline__ void operator()(f32x4 (&acc)[2][2][4][2], const Unit& u, int wr, int wc, int fr, int fq) const {
        const int row0 = u.pm * BM + wr * 64 + fr, col0 = u.pn * BM + wc * 32 + 4 * fq;
#pragma unroll
        for (int ai = 0; ai < 2; ++ai)
#pragma unroll
            for (int m = 0; m < 4; ++m) { const size_t off = (size_t)(row0 + ai * HALF + m * 16) * ldc + col0;
#pragma unroll
                for (int bj = 0; bj < 2; ++bj)
#pragma unroll
                    for (int n = 0; n < 2; ++n) { const f32x4 bs = *(const f32x4*)(base + off + bj * HALF + n * 16); *(f32x4*)(out + off + bj * HALF + n * 16) = bs + acc[ai][bj][m][n]; }
                asm volatile("" ::: "memory"); }
    }
};
struct EpiMerge {
    static constexpr bool PERM = true;
    const f16* gates; f16* out;
    __device__ __forceinline__ void operator()(f32x4 (&acc)[2][2][4][2], const Unit& u, int wr, int wc, int fr, int fq) const {
        const int row0 = u.pm * BM + wr * 64 + fr, col0 = u.pn * BM + wc * 32 + 8 * fq;
        const int ga = (u.seg == 0 ? 0 : (u.seg == 1 ? 1024 : 2048)), gb = (u.seg == 0 ? 1024 : 2048);
#pragma unroll
        for (int ai = 0; ai < 2; ++ai)
#pragma unroll
            for (int m = 0; m < 4; ++m) { const int row = row0 + ai * HALF + m * 16; const f16* gp = gates + (size_t)row * 3072 + col0;
#pragma unroll
                for (int bj = 0; bj < 2; ++bj) {
                    const h8 xa = *(const h8*)(gp + ga + bj * HALF);
                    float f[8];
                    if (u.seg < 2) { const h8 xb = *(const h8*)(gp + gb + bj * HALF);
#pragma unroll
                        for (int j = 0; j < 8; ++j) { const float a = fminf(fmaxf((float)xa[j], -30.f), 30.f), b = fminf(fmaxf((float)xb[j], -30.f), 30.f);
                            f[j] = (1.f + __expf(-b)) * __builtin_amdgcn_rcpf(1.f + __expf(-a)); }
                    } else {
#pragma unroll
                        for (int j = 0; j < 8; ++j) { const float a = fminf(fmaxf((float)xa[j], -30.f), 30.f); f[j] = __builtin_amdgcn_rcpf(1.f + __expf(-a)); }
                    }
                    f32x4 v0 = acc[ai][bj][m][0], v1 = acc[ai][bj][m][1];
#pragma unroll
                    for (int j = 0; j < 4; ++j) { v0[j] *= f[j]; v1[j] *= f[4 + j]; }
                    if (u.seg < 2) { acc[ai][bj][m][0] = v0; acc[ai][bj][m][1] = v1; }
                    else { u32x4 w; w.x = pk2h(v0[0], v0[1]); w.y = pk2h(v0[2], v0[3]); w.z = pk2h(v1[0], v1[1]); w.w = pk2h(v1[2], v1[3]);
                        *(u32x4*)(out + (size_t)row * 1024 + col0 + bj * HALF) = w; } }
                asm volatile("" ::: "memory"); }
    }
};

template <class Epi, int NSEG, bool ALIGN_EPI, bool SP2>
__device__ __forceinline__ void gemm_phase(LAS unsigned char* lds, const f16* gA0, const f16* gA1, const f16* gA2, const f16* gB0, const f16* gB1, const f16* gB2,
                                           const int gK0, const int gK1, const int gK2, const int g_lda, const int g_ldb, const Order<NSEG>& S, const Epi& E) {
    const unsigned long long uA0 = (unsigned long long)gA0, uA1 = (unsigned long long)gA1, uA2 = (unsigned long long)gA2, uB0 = (unsigned long long)gB0, uB1 = (unsigned long long)gB1, uB2 = (unsigned long long)gB2;
#define SEG_A(u) ((const char*)(NSEG > 1 ? pick3((u).seg, uA0, uA1, uA2) : uA0) + (size_t)(u).pm * (size_t)(BM * 2) * g_lda)
#define SEG_B(u) ((const char*)(NSEG > 1 ? pick3((u).seg, uB0, uB1, uB2) : uB0) + (size_t)(u).pn * (size_t)(BM * 2) * g_ldb)
#define SEG_K(u) (NSEG > 1 ? (int)pick3((u).seg, (unsigned long long)gK0, (unsigned long long)gK1, (unsigned long long)gK2) : gK0)
    int tid_ = threadIdx.x; asm volatile("" : "+v"(tid_));
    const int tid = tid_, wid = __builtin_amdgcn_readfirstlane(tid >> 6), lane = tid & 63, wr = wid >> 2, wc = wid & 3, fr = lane & 15, fq = lane >> 4;
    unsigned voffA[2], voffB[2];
#pragma unroll
    for (int i = 0; i < 2; ++i) { int R, C; stage_rc(tid * 16 + i * 8192, R, C); const int Rb = Epi::PERM ? ((R & ~31) + perm32(R & 31)) : R;
        voffA[i] = (unsigned)(R * g_lda + C) * 2u; voffB[i] = (unsigned)(Rb * g_ldb + C) * 2u; }
    const size_t kstep = (size_t)(BK * 2);
    const size_t hstepA = (size_t)HALF * g_lda * 2, hstepB = (size_t)HALF * g_ldb * 2;
    const unsigned ldsw = (unsigned)wid * 1024u;
    const int aoff = lds_byte(wr * 64 + fr, fq * 8), boff = lds_byte(wc * 32 + fr, fq * 8);
#define PG8_SA(b, h) (((b) * 2 + (h)) * HTB)
#define PG8_SB(b, h) ((4 + (b) * 2 + (h)) * HTB)
#define PG8_STAGE(bufoff, gbase, voff) do { _Pragma("unroll") for (int _i = 0; _i < 2; ++_i) \
        __builtin_amdgcn_global_load_lds((const unsigned*)((const char*)(gbase) + (voff)[_i]), (LAS unsigned*)(lds + (bufoff) + ldsw + _i * 8192), 16, 0, 0); } while (0)
#define PG8_LDA(dst, b, h) do { _Pragma("unroll") for (int m = 0; m < 4; ++m) _Pragma("unroll") for (int k = 0; k < 2; ++k) dst[m][k] = *(const LAS h8*)(lds + PG8_SA(b, h) + aoff + m * 2048 + k * 1024); } while (0)
#define PG8_LDB(dst, b, h) do { _Pragma("unroll") for (int n = 0; n < 2; ++n) _Pragma("unroll") for (int k = 0; k < 2; ++k) dst[n][k] = *(const LAS h8*)(lds + PG8_SB(b, h) + boff + n * 2048 + k * 1024); } while (0)
#define PG8_MMA(ai, bj, At, Bt) do { __builtin_amdgcn_s_setprio(1); _Pragma("unroll") for (int m = 0; m < 4; ++m) _Pragma("unroll") for (int n = 0; n < 2; ++n) _Pragma("unroll") for (int k = 0; k < 2; ++k) \
        acc[ai][bj][m][n] = __builtin_amdgcn_mfma_f32_16x16x32_f16(Bt[n][k], At[m][k], acc[ai][bj][m][n], 0, 0, 0); __builtin_amdgcn_s_setprio(0); } while (0)
#define PG8_WAIT_V(n) asm volatile("s_waitcnt vmcnt(" #n ")" ::: "memory")
#define PG8_WAIT_L(n) asm volatile("s_waitcnt lgkmcnt(" #n ")" ::: "memory")
#define PG8_BAR __builtin_amdgcn_s_barrier()
#define PG8_SCHED __builtin_amdgcn_sched_barrier(0)
    Unit cur, nxt; int ui = 0;
    if (!S.next(0, cur)) return;
    f32x4 acc[2][2][4][2];
#pragma unroll
    for (int a = 0; a < 2; ++a)
#pragma unroll
        for (int b = 0; b < 2; ++b)
#pragma unroll
            for (int m = 0; m < 4; ++m)
#pragma unroll
                for (int n = 0; n < 2; ++n) acc[a][b][m][n] = (f32x4){0.f, 0.f, 0.f, 0.f};
    h8 At[4][2], B0[2][2], B1[2][2];
    const char* cA = SEG_A(cur); const char* cB = SEG_B(cur);
    if constexpr (SP2) {
        PG8_STAGE(PG8_SB(0, 0), cB, voffB); PG8_STAGE(PG8_SB(0, 1), cB + hstepB, voffB); PG8_STAGE(PG8_SA(0, 0), cA, voffA); PG8_STAGE(PG8_SA(0, 1), cA + hstepA, voffA);
        if (wr == 1) PG8_BAR;
        PG8_WAIT_V(2); PG8_BAR;
        PG8_STAGE(PG8_SB(1, 0), cB + kstep, voffB); PG8_STAGE(PG8_SA(1, 0), cA + kstep, voffA); PG8_STAGE(PG8_SB(1, 1), cB + hstepB + kstep, voffB);
        PG8_WAIT_V(6); PG8_BAR;
    } else {
        PG8_STAGE(PG8_SB(0, 0), cB, voffB); PG8_STAGE(PG8_SA(0, 0), cA, voffA); PG8_STAGE(PG8_SB(0, 1), cB + hstepB, voffB); PG8_STAGE(PG8_SA(0, 1), cA + hstepA, voffA);
        if (wr == 1) PG8_BAR;
        PG8_WAIT_V(4); PG8_BAR;
        PG8_STAGE(PG8_SB(1, 0), cB + kstep, voffB); PG8_STAGE(PG8_SA(1, 0), cA + kstep, voffA); PG8_STAGE(PG8_SB(1, 1), cB + hstepB + kstep, voffB);
        PG8_WAIT_V(6); PG8_BAR;
    }
    for (;;) {
        const bool has_next = S.next(ui + 1, nxt);
        const int nt = SEG_K(cur) / BK;
        const char* nA = has_next ? SEG_A(nxt) : cA; const char* nB = has_next ? SEG_B(nxt) : cB;
        for (int t = 0; t < nt; t += 2) {
            const bool last = (t == nt - 2);
            const char* a1 = cA + (size_t)(t + 1) * kstep;
            const char* a2 = last ? nA : cA + (size_t)(t + 2) * kstep; const char* b2 = last ? nB : cB + (size_t)(t + 2) * kstep;
            const char* a3 = a2 + kstep; const char* b3 = b2 + kstep;
            if constexpr (SP2) {
            PG8_LDB(B0, 0, 0); PG8_LDB(B1, 0, 1); PG8_SCHED; PG8_LDA(At, 0, 0); PG8_STAGE(PG8_SA(1, 1), a1 + hstepA, voffA);
            PG8_WAIT_V(8); PG8_WAIT_L(0); PG8_BAR; PG8_MMA(0, 0, At, B0); PG8_MMA(0, 1, At, B1); PG8_BAR; PG8_SCHED;
            PG8_LDA(At, 0, 1); PG8_STAGE(PG8_SB(0, 0), b2, voffB); PG8_STAGE(PG8_SB(0, 1), b2 + hstepB, voffB); PG8_STAGE(PG8_SA(0, 0), a2, voffA);
            PG8_WAIT_V(8); PG8_WAIT_L(0); PG8_BAR; PG8_MMA(1, 0, At, B0); PG8_MMA(1, 1, At, B1); PG8_BAR; PG8_SCHED;
            PG8_LDB(B0, 1, 0); PG8_LDB(B1, 1, 1); PG8_SCHED; PG8_LDA(At, 1, 0); PG8_STAGE(PG8_SA(0, 1), a2 + hstepA, voffA);
            PG8_WAIT_V(8); PG8_WAIT_L(0); PG8_BAR; PG8_MMA(0, 0, At, B0); PG8_MMA(0, 1, At, B1); PG8_BAR; PG8_SCHED;
            PG8_LDA(At, 1, 1); PG8_STAGE(PG8_SB(1, 0), b3, voffB); PG8_STAGE(PG8_SB(1, 1), b3 + hstepB, voffB); PG8_STAGE(PG8_SA(1, 0), a3, voffA);
            PG8_WAIT_V(8); PG8_WAIT_L(0); PG8_BAR; PG8_MMA(1, 0, At, B0); PG8_MMA(1, 1, At, B1); PG8_BAR; PG8_SCHED;
            } else {
            PG8_LDB(B0, 0, 0); PG8_SCHED; PG8_LDA(At, 0, 0); PG8_STAGE(PG8_SA(1, 1), a1 + hstepA, voffA);
            PG8_WAIT_L(8); PG8_BAR; PG8_WAIT_L(0); PG8_MMA(0, 0, At, B0); PG8_BAR; PG8_SCHED;
            PG8_LDB(B1, 0, 1); PG8_STAGE(PG8_SB(0, 0), b2, voffB);
            PG8_BAR; PG8_WAIT_L(0); PG8_MMA(0, 1, At, B1); PG8_BAR;
            PG8_LDA(At, 0, 1); PG8_STAGE(PG8_SA(0, 0), a2, voffA);
            PG8_BAR; PG8_WAIT_L(0); PG8_MMA(1, 0, At, B0); PG8_BAR; PG8_SCHED;
            PG8_STAGE(PG8_SB(0, 1), b2 + hstepB, voffB);
            PG8_WAIT_V(6); PG8_BAR; PG8_MMA(1, 1, At, B1); PG8_BAR;
            PG8_LDB(B0, 1, 0); PG8_SCHED; PG8_LDA(At, 1, 0); PG8_STAGE(PG8_SA(0, 1), a2 + hstepA, voffA);
            PG8_WAIT_L(8); PG8_BAR; PG8_WAIT_L(0); PG8_MMA(0, 0, At, B0); PG8_BAR; PG8_SCHED;
            PG8_LDB(B1, 1, 1); PG8_STAGE(PG8_SB(1, 0), b3, voffB);
            PG8_BAR; PG8_WAIT_L(0); PG8_MMA(0, 1, At, B1); PG8_BAR;
            PG8_LDA(At, 1, 1); PG8_STAGE(PG8_SA(1, 0), a3, voffA);
            PG8_BAR; PG8_WAIT_L(0); PG8_MMA(1, 0, At, B0); PG8_BAR; PG8_SCHED;
            PG8_STAGE(PG8_SB(1, 1), b3 + hstepB, voffB);
            PG8_WAIT_V(6); PG8_BAR; PG8_MMA(1, 1, At, B1); PG8_BAR;
            }
        }
        if constexpr (ALIGN_EPI) { if (wr == 0) PG8_BAR; }
        E(acc, cur, wr, wc, fr, fq);
        if (!has_next) break;
        if (NSEG == 1 || cur.seg == NSEG - 1) {
#pragma unroll
        for (int a = 0; a < 2; ++a)
#pragma unroll
            for (int b = 0; b < 2; ++b)
#pragma unroll
                for (int m = 0; m < 4; ++m)
#pragma unroll
                    for (int n = 0; n < 2; ++n) acc[a][b][m][n] = (f32x4){0.f, 0.f, 0.f, 0.f};
        }
        cur = nxt; cA = nA; cB = nB; ++ui;
        if constexpr (ALIGN_EPI) { if (wr == 1) PG8_BAR; }
    }
    PG8_WAIT_V(0);
    if constexpr (!ALIGN_EPI) { if (wr == 0) PG8_BAR; }
    PG8_BAR;
#undef SEG_A
#undef SEG_B
#undef SEG_K
#undef PG8_SA
#undef PG8_SB
#undef PG8_STAGE
#undef PG8_LDA
#undef PG8_LDB
#undef PG8_MMA
#undef PG8_WAIT_V
#undef PG8_WAIT_L
#undef PG8_BAR
#undef PG8_SCHED
}
}

namespace att {
constexpr int D = 128, NW = 8, QBLK = 32, KVBLK = 64;
constexpr float THR = 8.f;
constexpr size_t SHM_V = KVBLK * D * 2, SHM_K = KVBLK * D * 2, SHM_ATTN = 2 * SHM_V + 2 * SHM_K + NW * 64 * 4;
#define KSWZ(row, colB) ((row) * 256 + ((colB) ^ (((row) & 7) << 4)))
#define SBAR() __builtin_amdgcn_sched_barrier(0)
__device__ __forceinline__ int crow(int r, int hi) { return (r & 3) + 8 * (r >> 2) + 4 * hi; }
__device__ __forceinline__ unsigned cvtpk(float lo, float hi) { return pk2h(lo, hi); }

template <int SCALE_NUM> struct ScaleC { };
__device__ __forceinline__ void partialSM(f32x16& p0, f32x16& p1, float& m_reg, float& mn, float& alpha, const float SCALE) {
  const float C = SCALE * 1.4426950408889634f;
  float pmax = p0[0];
#pragma unroll
  for (int r = 1; r < 16; ++r) pmax = fmaxf(pmax, p0[r]);
#pragma unroll
  for (int r = 0; r < 16; ++r) pmax = fmaxf(pmax, p1[r]);
  { auto rr = __builtin_amdgcn_permlane32_swap(__float_as_uint(pmax), __float_as_uint(pmax), false, false);
    pmax = fmaxf(__uint_as_float(rr[0]), __uint_as_float(rr[1])); }
  if (__builtin_expect(__all(pmax - m_reg <= THR / SCALE), 1)) { mn = m_reg; alpha = 1.f; }
  else { mn = fmaxf(m_reg, pmax); alpha = __builtin_amdgcn_exp2f((m_reg - mn) * C); m_reg = mn; }
  float mnC = -mn * C;
#pragma unroll
  for (int r = 0; r < 16; ++r) p0[r] = fmaf(p0[r], C, mnC);
#pragma unroll
  for (int r = 0; r < 16; ++r) p1[r] = fmaf(p1[r], C, mnC);
#pragma unroll
  for (int r = 0; r < 16; ++r) p0[r] = __builtin_amdgcn_exp2f(p0[r]);
}
__device__ __forceinline__ void finishSM(f32x16& p0, f32x16& p1, float alpha, float& l_reg, h8& pa0, h8& pa1, h8& pa2, h8& pa3) {
#pragma unroll
  for (int r = 0; r < 16; ++r) p1[r] = __builtin_amdgcn_exp2f(p1[r]);
  float ps = 0;
#pragma unroll
  for (int r = 0; r < 16; ++r) ps += p0[r];
#pragma unroll
  for (int r = 0; r < 16; ++r) ps += p1[r];
  { auto rr = __builtin_amdgcn_permlane32_swap(__float_as_uint(ps), __float_as_uint(ps), false, false);
    ps = __uint_as_float(rr[0]) + __uint_as_float(rr[1]); }
  l_reg = l_reg * alpha + ps;
#define PK4(P, BASE, OUT) do { unsigned a0 = cvtpk(P[BASE + 0], P[BASE + 1]), a1 = cvtpk(P[BASE + 2], P[BASE + 3]);   \
    unsigned b0 = cvtpk(P[BASE + 4], P[BASE + 5]), b1 = cvtpk(P[BASE + 6], P[BASE + 7]);                              \
    auto r0 = __builtin_amdgcn_permlane32_swap(a0, b0, false, false); auto r1 = __builtin_amdgcn_permlane32_swap(a1, b1, false, false); \
    u32x4 w = {r0[0], r1[0], r0[1], r1[1]}; OUT = __builtin_bit_cast(h8, w); } while (0)
  PK4(p0, 0, pa0); PK4(p0, 8, pa1); PK4(p1, 0, pa2); PK4(p1, 8, pa3);
#undef PK4
}
__device__ __forceinline__ void qkt(f32x16& p0, f32x16& p1, const char* Ks, const h8* qr, int r32, int hi) {
  p0 = f32x16{}; p1 = f32x16{};
#pragma unroll
  for (int d0 = 0; d0 < 8; ++d0) { int cb = (d0 * 16 + hi * 8) * 2;
    h8 b0 = *reinterpret_cast<const h8*>(Ks + KSWZ(r32, cb));
    h8 b1 = *reinterpret_cast<const h8*>(Ks + KSWZ(32 + r32, cb));
    p0 = __builtin_amdgcn_mfma_f32_32x32x16_f16(b0, qr[d0], p0, 0, 0, 0);
    p1 = __builtin_amdgcn_mfma_f32_32x32x16_f16(b1, qr[d0], p1, 0, 0, 0); }
}
__device__ __forceinline__ int v_st(int k, int c) { const int kk = (k & ~0xC) | ((k & 4) << 1) | ((k & 8) >> 1); return ((kk >> 3) * 4 + (c >> 5)) * 512 + ((kk & 7) * 32 + (c & 31)) * 2; }
__device__ __forceinline__ int v_rd_base(int lane) { return ((lane & 3) << 3) | (((lane >> 2) & 3) << 6) | (((lane >> 4) & 1) << 5) | (((lane >> 5) & 1) << 8); }
constexpr int v_rd_off(int d0, int ks, int half) { return d0 * 512 + ks * 4096 + half * 2048; }
template <int OFF> __device__ __forceinline__ h4 tr_read(int vb) {
  h4 r; asm volatile("ds_read_b64_tr_b16 %0, %1 offset:%2" : "=&v"(r) : "v"(vb), "i"(OFF) : "memory"); return r;
}
template <int D0> __device__ __forceinline__ void pv_one(f32x16& od, int vb, h8 pa0, h8 pa1, h8 pa2, h8 pa3) {
  const h4 l0 = tr_read<v_rd_off(D0, 0, 0)>(vb), h0 = tr_read<v_rd_off(D0, 0, 1)>(vb), l1 = tr_read<v_rd_off(D0, 1, 0)>(vb), h1 = tr_read<v_rd_off(D0, 1, 1)>(vb);
  const h4 l2 = tr_read<v_rd_off(D0, 2, 0)>(vb), h2_ = tr_read<v_rd_off(D0, 2, 1)>(vb), l3 = tr_read<v_rd_off(D0, 3, 0)>(vb), h3 = tr_read<v_rd_off(D0, 3, 1)>(vb);
  asm volatile("s_waitcnt lgkmcnt(0)" ::: "memory"); SBAR();
#define PK(L, H) (h8){L[0], L[1], L[2], L[3], H[0], H[1], H[2], H[3]}
  od = __builtin_amdgcn_mfma_f32_32x32x16_f16(pa0, PK(l0, h0), od, 0, 0, 0);
  od = __builtin_amdgcn_mfma_f32_32x32x16_f16(pa1, PK(l1, h1), od, 0, 0, 0);
  od = __builtin_amdgcn_mfma_f32_32x32x16_f16(pa2, PK(l2, h2_), od, 0, 0, 0);
  od = __builtin_amdgcn_mfma_f32_32x32x16_f16(pa3, PK(l3, h3), od, 0, 0, 0);
#undef PK
}
__device__ __forceinline__ void pv_d0(f32x16* o, int vb, h8 pa0, h8 pa1, h8 pa2, h8 pa3) {
  pv_one<0>(o[0], vb, pa0, pa1, pa2, pa3); pv_one<1>(o[1], vb, pa0, pa1, pa2, pa3); pv_one<2>(o[2], vb, pa0, pa1, pa2, pa3); pv_one<3>(o[3], vb, pa0, pa1, pa2, pa3);
}
template <int LDQ, int LDK, int LDO>
__device__ __forceinline__ void attn_dense_body(const f16* __restrict__ Qb, const f16* __restrict__ Kh, const f16* __restrict__ Vh, f16* Ob, int seq, char* lds, const float SCALE) {
  int tid_ = threadIdx.x; asm volatile("" : "+v"(tid_));
  const int tid = tid_, wid = tid >> 6, lane = tid & 63, r32 = lane & 31, hi = lane >> 5;
  char* V_lds = lds; char* K_lds = lds + 2 * SHM_V;
  float* ws = (float*)(lds + 2 * SHM_V + 2 * SHM_K) + wid * 64; float* li_l = ws; float* al_l = ws + 32;
  float m_reg = -1e30f, l_reg = 0; f32x16 o[4] = {}; h8 qr[8];
  const f16* Qw = Qb + (long)(wid * QBLK + r32) * LDQ + hi * 8;
#pragma unroll
  for (int d0 = 0; d0 < 8; ++d0) qr[d0] = *reinterpret_cast<const h8*>(Qw + d0 * 16);
  const int sr = tid >> 4, sc = (tid & 15) * 8, vst0 = v_st(sr, sc), vst1 = v_st(32 + sr, sc);
  const int vb0 = (int)(uintptr_t)V_lds + v_rd_base(lane);
  struct { h8 vs0, vs1, ks0, ks1; } sr_[2];
#define SLOAD(i, k0) do { sr_[i].vs0 = *(const h8*)(&Vh[(long)((k0) + sr) * LDK + sc]); sr_[i].vs1 = *(const h8*)(&Vh[(long)((k0) + 32 + sr) * LDK + sc]); \
    sr_[i].ks0 = *(const h8*)(&Kh[(long)((k0) + sr) * LDK + sc]); sr_[i].ks1 = *(const h8*)(&Kh[(long)((k0) + 32 + sr) * LDK + sc]); } while (0)
#define SWRITE(b, i) do { *(h8*)(V_lds + (b) * SHM_V + vst0) = sr_[i].vs0;          \
    *(h8*)(V_lds + (b) * SHM_V + vst1) = sr_[i].vs1; int kc = sc * 2;               \
    *(h8*)(K_lds + (b) * SHM_K + KSWZ(sr, kc)) = sr_[i].ks0;                       \
    *(h8*)(K_lds + (b) * SHM_K + KSWZ(32 + sr, kc)) = sr_[i].ks1; } while (0)
#define SWAIT() asm volatile("s_waitcnt vmcnt(4)" ::: "memory")
#define RESC(a) do { if (__any((a) < 1.f)) { if (hi == 0) al_l[r32] = (a); asm volatile("s_waitcnt lgkmcnt(0)" ::: "memory"); \
    _Pragma("unroll") for (int d = 0; d < 4; ++d) _Pragma("unroll") for (int r = 0; r < 16; ++r) o[d][r] *= al_l[crow(r, hi)]; } } while (0)
  f32x16 pA0, pA1, pB0, pB1; float mnA, mnB, alA, alB; h8 pa0, pa1, pa2, pa3; const int NT = seq / KVBLK;
  constexpr int SE = 0, SO = 1;
  SLOAD(SE, 0); asm volatile("s_waitcnt vmcnt(0)" ::: "memory"); SWRITE(0, SE); __syncthreads();
  qkt(pA0, pA1, K_lds, qr, r32, hi); partialSM(pA0, pA1, m_reg, mnA, alA, SCALE);
  SLOAD(SO, KVBLK); if (2 < NT) SLOAD(SE, 2 * KVBLK);
  SWAIT(); SWRITE(1, SO); __syncthreads();
  for (int j = 1; j + 1 < NT; j += 2) {
    SBAR(); qkt(pB0, pB1, K_lds + SHM_K, qr, r32, hi);
    finishSM(pA0, pA1, alA, l_reg, pa0, pa1, pa2, pa3); SBAR();
    SLOAD(SO, (j + 2) * KVBLK); SBAR();
    pv_d0(o, vb0, pa0, pa1, pa2, pa3); partialSM(pB0, pB1, m_reg, mnB, alB, SCALE);
    __syncthreads(); SWAIT(); SWRITE(0, SE);
    RESC(alB); __syncthreads();
    SBAR(); qkt(pA0, pA1, K_lds, qr, r32, hi);
    finishSM(pB0, pB1, alB, l_reg, pa0, pa1, pa2, pa3); SBAR();
    if (j + 3 < NT) SLOAD(SE, (j + 3) * KVBLK); SBAR();
    pv_d0(o, vb0 + (int)SHM_V, pa0, pa1, pa2, pa3); partialSM(pA0, pA1, m_reg, mnA, alA, SCALE);
    __syncthreads(); SWAIT(); SWRITE(1, SO);
    RESC(alA); __syncthreads();
  }
  SBAR(); qkt(pB0, pB1, K_lds + SHM_K, qr, r32, hi);
  finishSM(pA0, pA1, alA, l_reg, pa0, pa1, pa2, pa3); SBAR();
  pv_d0(o, vb0, pa0, pa1, pa2, pa3); partialSM(pB0, pB1, m_reg, mnB, alB, SCALE);
  __syncthreads(); RESC(alB);
  finishSM(pB0, pB1, alB, l_reg, pa0, pa1, pa2, pa3); SBAR();
  pv_d0(o, vb0 + (int)SHM_V, pa0, pa1, pa2, pa3);
  if (hi == 0) li_l[r32] = l_reg; asm volatile("s_waitcnt lgkmcnt(0)" ::: "memory");
  float rli[16];
#pragma unroll
  for (int r = 0; r < 16; ++r) rli[r] = __builtin_amdgcn_rcpf(li_l[crow(r, hi)]);
  f16* Ow = Ob + (long)(wid * QBLK) * LDO;
#pragma unroll
  for (int r = 0; r < 16; ++r) { int orow = crow(r, hi);
#pragma unroll
    for (int d0 = 0; d0 < 4; ++d0) Ow[(long)orow * LDO + d0 * 32 + r32] = (f16)(o[d0][r] * rli[r]); }
#undef SLOAD
#undef SWRITE
#undef SWAIT
#undef RESC
}
}

struct Args { const float* in[21]; float* out; unsigned char* ws; int ph_lo, ph_hi; };
enum { I_X = 0, I_MEM, I_NORM1, I_WIN, I_QNORM, I_KVNORM, I_WUQ, I_WIQ, I_WUK, I_WUV, I_MEMNORM, I_WMEMKV, I_WRETO, I_WDSAO, I_WMEMO, I_WOUT, I_NORM2, I_WFF1, I_WFF2, I_RELBIAS, I_FINALNORM };

typedef const __attribute__((address_space(4))) Args* KArgs;
#define INP(a, i) ((const float*)(const GAS float*)((a)->in[i]))
struct Frame {
    LAS unsigned char* lds; char* ldsg;
    unsigned char* ws;
    int tid, lane, wave, G;
};

__device__ __forceinline__ Frame relaunder(const Frame& F0) { Frame F = F0; int t = F0.tid; asm volatile("" : "+v"(t)); { GAS unsigned char* w = (GAS unsigned char*)F0.ws; asm volatile("" : "+s"(w)); F.ws = (unsigned char*)w; } F.tid = t; F.lane = t & 63; F.wave = __builtin_amdgcn_readfirstlane(t >> 6); return F; }
__device__ __forceinline__ void norm_rows_f16(const Frame& F0, const float* src, const float* gain, f16* dst, int rows, int w0, int wstride) {
    const Frame F = relaunder(F0);
    f32x4 g[4];
#pragma unroll
    for (int j = 0; j < 4; ++j) g[j] = ((const f32x4*)gain)[F.lane + 64 * j];
    for (int m = w0; m < rows; m += wstride) {
        const f32x4* xr = (const f32x4*)(src + (size_t)m * DM) + F.lane;
        f32x4 v[4]; float s = 0.f;
#pragma unroll
        for (int j = 0; j < 4; ++j) { v[j] = xr[64 * j]; s += (v[j].x * v[j].x + v[j].y * v[j].y) + (v[j].z * v[j].z + v[j].w * v[j].w); }
        const float rstd = 1.f / sqrtf(wave_sum(s) * (1.f / DM) + 1e-6f);
        u32x2* o8 = (u32x2*)(dst + (size_t)m * DM) + F.lane;
#pragma unroll
        for (int j = 0; j < 4; ++j) { u32x2 w; w.x = pk2h(v[j].x * rstd * g[j].x, v[j].y * rstd * g[j].y); w.y = pk2h(v[j].z * rstd * g[j].z, v[j].w * rstd * g[j].w); o8[64 * j] = w; }
    }
}
__device__ __forceinline__ void norm_rows_f32_inplace(const Frame& F0, float* x, const float* gain, int rows, int w0, int wstride) {
    const Frame F = relaunder(F0);
    f32x4 g[4];
#pragma unroll
    for (int j = 0; j < 4; ++j) g[j] = ((const f32x4*)gain)[F.lane + 64 * j];
    for (int m = w0; m < rows; m += wstride) {
        f32x4* xr = (f32x4*)(x + (size_t)m * DM) + F.lane;
        f32x4 v[4]; float s = 0.f;
#pragma unroll
        for (int j = 0; j < 4; ++j) { v[j] = xr[64 * j]; s += (v[j].x * v[j].x + v[j].y * v[j].y) + (v[j].z * v[j].z + v[j].w * v[j].w); }
        const float rstd = 1.f / sqrtf(wave_sum(s) * (1.f / DM) + 1e-6f);
#pragma unroll
        for (int j = 0; j < 4; ++j) xr[64 * j] = v[j] * rstd * g[j];
    }
}

__device__ __forceinline__ void transpose_item(const float* src, int ldsrc, int nvalid, int k0, f16* WT, int ldk, int lane, LAS float* scr) {
#pragma unroll 8
    for (int i = 0; i < 32; ++i) { const int kk = 2 * i + (lane >> 5), n = lane & 31; scr[kk * 33 + n] = (n < nvalid) ? src[(size_t)(k0 + kk) * ldsrc + n] : 0.f; }
    LDS_WAIT(); asm volatile("" ::: "memory");
    const int c = lane & 7;
#pragma unroll
    for (int j = 0; j < 4; ++j) { const int n = (lane >> 3) + 8 * j; const LAS float* s = scr + (8 * c) * 33 + n;
        u32x4 o; o.x = pk2h(s[0 * 33], s[1 * 33]); o.y = pk2h(s[2 * 33], s[3 * 33]); o.z = pk2h(s[4 * 33], s[5 * 33]); o.w = pk2h(s[6 * 33], s[7 * 33]);
        *(u32x4*)(WT + (size_t)n * ldk + k0 + 8 * c) = o; }
    LDS_WAIT(); asm volatile("" ::: "memory");
}
struct TJob { const float* src; int ldsrc, K, ncols; f16* dst; int ldk; };
__device__ __forceinline__ TJob tjob(KArgs a, unsigned char* ws, int l, int j) {
    unsigned char* wl = ws + WS_W + (size_t)l * W_LAYER; TJob t;
    const float* w_in = INP(a, I_WIN) + (size_t)l * DM * NIN;
    switch (j) {
    case 0:  t = TJob{w_in, NIN, DM, 2464, (f16*)(wl + W_IN), DM}; break;
    case 1:  t = TJob{w_in + 2464, NIN, DM, 8, (f16*)(wl + W_IN) + (size_t)2464 * DM, DM}; break;
    case 2:  t = TJob{w_in, NIN, DM, 0, (f16*)(wl + W_IN) + (size_t)2496 * DM, DM}; break;
    case 3:  t = TJob{w_in, NIN, DM, 0, (f16*)(wl + W_IN) + (size_t)2528 * DM, DM}; break;
    case 4:  t = TJob{w_in + 2472, NIN, DM, 3584, (f16*)(wl + W_IN) + (size_t)2560 * DM, DM}; break;
    case 5:  t = TJob{INP(a, I_WIQ) + (size_t)l * 256 * 256, 256, 256, 256, (f16*)(wl + W_DQ) + (size_t)1024 * 256, 256}; break;
    case 6:  t = TJob{INP(a, I_WMEMKV) + (size_t)l * DM * 1024, 1024, DM, 1024, (f16*)(wl + W_MKV), DM}; break;
    case 7:  t = TJob{INP(a, I_WRETO) + (size_t)l * 512 * DM, DM, 512, 1024, (f16*)(wl + W_RM), 1024}; break;
    case 8:  t = TJob{INP(a, I_WMEMO) + (size_t)l * 512 * DM, DM, 512, 1024, (f16*)(wl + W_RM) + 512, 1024}; break;
    case 9:  t = TJob{INP(a, I_WOUT) + (size_t)l * DM * DM, DM, DM, 1024, (f16*)(wl + W_OUT), DM}; break;
    case 10: t = TJob{INP(a, I_WFF1) + (size_t)l * DM * FF, FF, DM, FF, (f16*)(wl + W_FF1), DM}; break;
    default: t = TJob{INP(a, I_WFF2) + (size_t)l * FF * DM, DM, FF, 1024, (f16*)(wl + W_FF2), FF}; break;
    }
    return t;
}
constexpr int NTJOBS = 12;

__device__ __forceinline__ int t5_bucket(int rel) {
    const int base = rel > 0 ? 16 : 0; const int n = rel < 0 ? -rel : rel;
    if (n < 8) return base + n;
    int lg = 8 + (n >= 12) + (n >= 16) + (n >= 23) + (n >= 32) + (n >= 46) + (n >= 64) + (n >= 91); if (lg > 15) lg = 15;
    return base + lg;
}

__device__ __forceinline__ void p_prologue(const Frame& F0, KArgs a) {
    const Frame F = relaunder(F0);
    LAS float* scr = (LAS float*)(F.lds + F.wave * 16384);
    const int gw = blockIdx.x * NWAVES + F.wave, NGW = F.G * NWAVES;
    for (int l = 0; l < DEPTH; ++l)
        for (int j = 0; j < NTJOBS; ++j) {
            const TJob t = tjob(a, F.ws, l, j);
            const int nblk = (t.ncols + 31) / 32 > 0 ? (t.ncols + 31) / 32 : 1, items = (t.K / 64) * nblk;
            for (int it = gw; it < items; it += NGW) { const int kb = it / nblk, nb = it % nblk; int nv = t.ncols - 32 * nb; nv = nv > 32 ? 32 : (nv < 0 ? 0 : nv);
                transpose_item(t.src + 32 * nb, t.ldsrc, nv, 64 * kb, t.dst + (size_t)(32 * nb) * t.ldk, t.ldk, F.lane, scr); }
        }
    const int gt = blockIdx.x * NTHREADS + F.tid, NGT = F.G * NTHREADS;
    for (int l = 0; l < DEPTH; ++l) {
        unsigned char* wl = F.ws + WS_W + (size_t)l * W_LAYER;
        const float* wuq = INP(a, I_WUQ) + (size_t)l * 256 * 512; const float* wuk = INP(a, I_WUK) + (size_t)l * 128 * 512;
        f16* wdq = (f16*)(wl + W_DQ);
        for (int e = gt; e < 1024 * 256; e += NGT) {
            const int n = e >> 8, k = e & 255, h = n >> 7, r = n & 127;
            const float* pa = wuq + ((size_t)k * 8 + h) * 64; const float* pb = wuk + ((size_t)r * 8 + h) * 64; float s = 0.f;
            for (int d = 0; d < 64; ++d) s += pa[d] * pb[d];
            wdq[e] = (f16)(s * 0.125f);
        }
        const float* wuv = INP(a, I_WUV) + (size_t)l * 128 * 512; const float* wdo = INP(a, I_WDSAO) + (size_t)l * 512 * DM;
        f16* wvo = (f16*)(wl + W_VO);
        for (int e = gt; e < 1024 * 1024; e += NGT) {
            const int n = e & 1023, kk = e >> 10, h = kk >> 7, r = kk & 127;
            const float* pa = wuv + ((size_t)r * 8 + h) * 64; const float* pb = wdo + (size_t)(h * 64) * DM + n; float s = 0.f;
            for (int d = 0; d < 64; ++d) s += pa[d] * pb[(size_t)d * DM];
            wvo[(size_t)n * 1024 + kk] = (f16)s;
        }
    }
    float* rc = (float*)(F.ws + WS_ROPE); float* rs = rc + 4096 * 32;
    for (int e = gt; e < 4096 * 32; e += NGT) { const int pos = e >> 5, i = e & 31; const float fr = exp2f(-(float)i * (13.287712379549449f / 32.f)), ang = (float)pos * fr; rc[e] = cosf(ang); rs[e] = sinf(ang); }
    float* tb = (float*)(F.ws + WS_TB);
    for (int e = gt; e < 256 * 8; e += NGT) { const int ri = e >> 3, h = e & 7; tb[e] = INP(a, I_RELBIAS)[t5_bucket(ri - 192) * 8 + h]; }
}

__device__ __forceinline__ void p_dsa_norms(const Frame& F0, KArgs a, int l, int w0, int wstride) {
    const Frame F = relaunder(F0);
    f16* CQ = (f16*)(F.ws + WS_CQ); const f16* MISC = (const f16*)(F.ws + WS_MISC); f16* CKVN = (f16*)(F.ws + WS_CKVN);
    const float* qn = INP(a, I_QNORM) + l * 256; const float* kn = INP(a, I_KVNORM) + l * 128;
    const f32x4 gq = ((const f32x4*)qn)[F.lane]; const f32x2 gk = ((const f32x2*)kn)[F.lane];
    for (int m = w0; m < T; m += wstride) {
        h4* cq = (h4*)(CQ + (size_t)m * 256) + F.lane; const h4 v = *cq;
        const h2 kv = *((const h2*)(MISC + (size_t)m * 256) + F.lane);
        const float q0 = v[0], q1 = v[1], q2 = v[2], q3 = v[3], k0 = kv[0], k1 = kv[1];
        const float sq = wave_sum(q0 * q0 + q1 * q1 + q2 * q2 + q3 * q3), sk = wave_sum(k0 * k0 + k1 * k1);
        const float rq = 1.f / sqrtf(sq * (1.f / 256.f) + 1e-6f), rk = 1.f / sqrtf(sk * (1.f / 128.f) + 1e-6f);
        u32x2 w; w.x = pk2h(q0 * rq * gq.x, q1 * rq * gq.y); w.y = pk2h(q2 * rq * gq.z, q3 * rq * gq.w); *(u32x2*)cq = w;
        *((unsigned*)(CKVN + (size_t)m * 128) + F.lane) = pk2h(k0 * rk * gk.x, k1 * rk * gk.y);
    }
}
__device__ __forceinline__ void p_retention_simple(const Frame& F0, int unit) {
    const Frame F = relaunder(F0);
    const int b = unit >> 3, h = unit & 7;
    LAS float* Qf = (LAS float*)F.lds; LAS float* Kf = Qf + 64 * 65; LAS float* Vf = Kf + 64 * 65; LAS float* Sf = Vf + 64 * 65; LAS float* St = Sf + 64 * 65; LAS float* Of = St + 64 * 65; LAS float* Kd = Of + 64 * 65;
    const f16* RQ = (const f16*)(F.ws + WS_RQ); const f16* RK = (const f16*)(F.ws + WS_RK); const f16* RV = (const f16*)(F.ws + WS_RV); f16* GM = (f16*)(F.ws + WS_GM);
    const float* rc = (const float*)(F.ws + WS_ROPE); const float* rs = rc + 4096 * 32;
    const float lg = log2f(1.f - exp2f(-5.f - (float)h));
    const int tid = F.tid, i = tid >> 3, cg = tid & 7;
    for (int e = tid; e < 64 * 65; e += NTHREADS) St[e] = 0.f;
    if (tid < 64) Kd[tid] = exp2f(lg * (float)(63 - tid));
    const float g64 = exp2f(lg * 64.f);
    for (int n = 0; n < 64; ++n) {
        const size_t row = (size_t)b * SEQ + 64 * n + i; const int pos = 64 * n + i;
        const h8 qv = *(const h8*)(RQ + row * 512 + h * 64 + 8 * cg), kv = *(const h8*)(RK + row * 512 + h * 64 + 8 * cg), vv = *(const h8*)(RV + row * 512 + h * 64 + 8 * cg);
        const h8 gv = *(const h8*)(GM + row * 1024 + h * 64 + 8 * cg);
        const float* cp = rc + pos * 32 + 8 * (cg & 3); const float* sp = rs + pos * 32 + 8 * (cg & 3);
#pragma unroll
        for (int j = 0; j < 8; ++j) {
            const float q = (float)qv[j], k = (float)kv[j]; const float pq = __shfl_xor(q, 4), pk = __shfl_xor(k, 4); const float c = cp[j], s = sp[j];
            const float qo = (cg < 4) ? (q * c - pq * s) : (q * c + pq * s), ko = (cg < 4) ? (k * c - pk * s) : (k * c + pk * s);
            Qf[i * 65 + 8 * cg + j] = qo; Kf[i * 65 + 8 * cg + j] = ko * 0.125f; Vf[i * 65 + 8 * cg + j] = (float)vv[j];
        }
        __syncthreads();
#pragma unroll 1
        for (int jj = 0; jj < 8; ++jj) { const int j = cg + 8 * jj; float s = 0.f;
            for (int d = 0; d < 64; ++d) s += Qf[i * 65 + d] * Kf[j * 65 + d];
            const int dd = i > j ? i - j : j - i; Sf[i * 65 + j] = s * exp2f(lg * (float)dd); }
        __syncthreads();
        float ns[8];
        const float qd = exp2f(lg * (float)(i + 1));
#pragma unroll 1
        for (int ee = 0; ee < 8; ++ee) { const int e = cg + 8 * ee; float s1 = 0.f, s2 = 0.f, s3 = 0.f;
            for (int j = 0; j < 64; ++j) s1 += Sf[i * 65 + j] * Vf[j * 65 + e];
            for (int d = 0; d < 64; ++d) s2 += Qf[i * 65 + d] * St[d * 65 + e];
            Of[i * 65 + e] = s1 + qd * s2;
            for (int j = 0; j < 64; ++j) s3 += Kf[j * 65 + i] * Kd[j] * Vf[j * 65 + e];
            ns[ee] = g64 * St[i * 65 + e] + s3; }
        __syncthreads();
#pragma unroll
        for (int ee = 0; ee < 8; ++ee) St[i * 65 + cg + 8 * ee] = ns[ee];
        float ov[8]; float s = 0.f;
#pragma unroll
        for (int j = 0; j < 8; ++j) { ov[j] = Of[i * 65 + 8 * cg + j]; s += ov[j]; }
        s += __shfl_xor(s, 1); s += __shfl_xor(s, 2); s += __shfl_xor(s, 4);
        const float mu = s * (1.f / 64.f); float q = 0.f;
#pragma unroll
        for (int j = 0; j < 8; ++j) { ov[j] -= mu; q += ov[j] * ov[j]; }
        q += __shfl_xor(q, 1); q += __shfl_xor(q, 2); q += __shfl_xor(q, 4);
        const float rstd = 1.f / sqrtf(q * (1.f / 64.f) + 1e-5f);
        float ro[8];
#pragma unroll
        for (int j = 0; j < 8; ++j) { const float g = (float)gv[j]; ro[j] = ov[j] * rstd * (g / (1.f + __expf(-g))); }
        u32x4 w; w.x = pk2h(ro[0], ro[1]); w.y = pk2h(ro[2], ro[3]); w.z = pk2h(ro[4], ro[5]); w.w = pk2h(ro[6], ro[7]);
        *(u32x4*)(GM + row * 1024 + h * 64 + 8 * cg) = w;
        __syncthreads();
    }
}

__device__ __forceinline__ unsigned fkey(float v) { const unsigned b = __float_as_uint(v); return b ^ ((unsigned)((int)b >> 31) | 0x80000000u); }
__device__ __forceinline__ void p_topk(const Frame& F0) {
    const Frame F = relaunder(F0);
    LAS float* sc = (LAS float*)F.lds;
    LAS float* qi = (LAS float*)(F.lds + 131072);
    LAS float* wq = (LAS float*)(F.lds + 131072 + 8192);
    LAS unsigned* hist = (LAS unsigned*)(F.lds + 131072 + 8192 + 256) + F.wave * 256;
    const f16* QIDX = (const f16*)(F.ws + WS_QIDX); const f16* MISC = (const f16*)(F.ws + WS_MISC); unsigned* MASK = (unsigned*)(F.ws + WS_MASK);
    const int tid = F.tid, lane = F.lane, wave = F.wave;
    for (int idx = blockIdx.x; idx < 8192; idx += F.G) {
        const int kq = idx & 255, r = idx >> 8, b = kq & 15, j = kq >> 4, sel = r >> 3, sub = r & 7;
        const int c = sel == 0 ? j : (sel == 1 ? 31 - j : (sel == 2 ? 32 + j : 63 - j));
        const int N = 64 * (c + 1), t0 = b * SEQ + 64 * c + 8 * sub, NTe = (c + 2) & ~1;
        unsigned long long* mrow = (unsigned long long*)(MASK + (size_t)(t0 + wave) * 128);
        if (c < 4) { if (lane < NTe) mrow[lane] = lane < (c + 1) ? ~0ull : 0ull; continue; }
        for (int e = tid; e < 2048; e += NTHREADS) qi[e] = (float)QIDX[(size_t)(t0 + (e >> 8)) * 256 + (e & 255)];
        if (tid < 64) wq[tid] = (float)MISC[(size_t)(t0 + (tid >> 3)) * 256 + 160 + (tid & 7)];
        __syncthreads();
        for (int key = tid; key < N; key += NTHREADS) {
            const h8* kp = (const h8*)(MISC + (size_t)(b * SEQ + key) * 256 + 128);
            const h8 k0 = kp[0], k1 = kp[1], k2 = kp[2], k3 = kp[3];
            float kf[32];
#pragma unroll
            for (int d = 0; d < 8; ++d) { kf[d] = (float)k0[d]; kf[8 + d] = (float)k1[d]; kf[16 + d] = (float)k2[d]; kf[24 + d] = (float)k3[d]; }
#pragma unroll 1
            for (int q = 0; q < 8; ++q) { float s = 0.f;
#pragma unroll 1
                for (int h = 0; h < 8; ++h) { float dot = 0.f; const LAS f32x4* qp = (const LAS f32x4*)(qi + q * 256 + h * 32);
#pragma unroll
                    for (int d = 0; d < 8; ++d) { const f32x4 qv = qp[d]; dot += qv.x * kf[4 * d] + qv.y * kf[4 * d + 1] + qv.z * kf[4 * d + 2] + qv.w * kf[4 * d + 3]; }
                    s += wq[q * 8 + h] * fmaxf(dot, 0.f); }
                sc[q * 4096 + key] = s + 0.f; }
        }
        __syncthreads();
        {
            const LAS float* s = sc + wave * 4096; const int ni = N >> 6;
            unsigned prefix = 0; int krem = 256;
#pragma unroll 1
            for (int pass = 0; pass < 4; ++pass) {
                const int shift = 24 - 8 * pass;
                hist[lane] = 0u; hist[lane + 64] = 0u; hist[lane + 128] = 0u; hist[lane + 192] = 0u;
                for (int i = 0; i < ni; ++i) { const unsigned u = fkey(s[i * 64 + lane]); const bool in = (pass == 0) || ((u >> (shift + 8)) == prefix);
                    if (in) atomicAdd((unsigned*)&hist[(u >> shift) & 255u], 1u); }
                LDS_WAIT();
                const int c0 = (int)hist[4 * lane], c1 = (int)hist[4 * lane + 1], c2 = (int)hist[4 * lane + 2], c3 = (int)hist[4 * lane + 3];
                const int tl = c0 + c1 + c2 + c3; int x = tl;
#pragma unroll
                for (int off = 1; off < 64; off <<= 1) { const int y = __shfl_down(x, off); if (lane + off < 64) x += y; }
                const int Sx = x - tl;
                const bool mine = (Sx < krem) && (krem <= Sx + tl);
                const unsigned long long bm = __ballot(mine);
                const int src = bm ? (__ffsll((long long)bm) - 1) : 0;
                int dd, gt; { int acc = Sx; if (acc + c3 >= krem) { dd = 3; gt = acc; } else { acc += c3; if (acc + c2 >= krem) { dd = 2; gt = acc; } else { acc += c2; if (acc + c1 >= krem) { dd = 1; gt = acc; } else { acc += c1; dd = 0; gt = acc; } } } }
                dd += 4 * lane;
                dd = __shfl(dd, src); gt = __shfl(gt, src);
                prefix = (prefix << 8) | (unsigned)dd; krem -= gt;
            }
            int tbf = 0; unsigned long long myword = 0ull;
            for (int i = 0; i < ni; ++i) { const unsigned u = fkey(s[i * 64 + lane]); const bool gtb = u > prefix, eq = u == prefix;
                const unsigned long long beq = __ballot(eq); const int rank = tbf + __popcll(beq & ((1ull << lane) - 1ull));
                const unsigned long long bs = __ballot(gtb || (eq && rank < krem)); if (lane == i) myword = bs; tbf += __popcll(beq); }
            if (lane < NTe) mrow[lane] = myword;
        }
        __syncthreads();
    }
}

__device__ __forceinline__ void p_dsa_attn_simple(const Frame& F0) {
    const Frame F = relaunder(F0);
    f16* OLAT = (f16*)(F.ws + WS_H); const f16* CKVN = (const f16*)(F.ws + WS_CKVN); const unsigned* MASK = (const unsigned*)(F.ws + WS_MASK); const float* tb = (const float*)(F.ws + WS_TB);
    const int gw = blockIdx.x * NWAVES + F.wave, NGW = F.G * NWAVES, lane = F.lane;
    for (int task = gw; task < T * 8; task += NGW) {
        const int t = task >> 3, h = task & 7, b = t >> 12, tp = t & 4095, c = tp >> 6, N = 64 * (c + 1);
        h2* qp = (h2*)(OLAT + (size_t)t * 1024 + h * 128) + lane; const h2 qv = *qp; const float q0 = qv[0], q1 = qv[1];
        const unsigned* mrow = MASK + (size_t)t * 128;
        float m = -1e30f, ls = 0.f, o0 = 0.f, o1 = 0.f;
        for (int w = 0; w < N / 32; ++w) {
            unsigned bits = __builtin_amdgcn_readfirstlane(mrow[w]);
            while (bits) { const int bit = __builtin_ctz(bits); bits &= bits - 1u; const int s = 32 * w + bit;
                const h2 cv = *((const h2*)(CKVN + (size_t)(b * SEQ + s) * 128) + lane); const float c0 = cv[0], c1 = cv[1];
                const float part = wave_sum(q0 * c0 + q1 * c1);
                const int rel = s - tp, ri = rel < -192 ? 0 : rel + 192;
                const float logit = part + tb[ri * 8 + h];
                const float mn = fmaxf(m, logit), al = __expf(m - mn), p = __expf(logit - mn);
                ls = ls * al + p; o0 = o0 * al + p * c0; o1 = o1 * al + p * c1; m = mn; }
        }
        const float inv = 1.f / ls;
        *(unsigned*)qp = pk2h(o0 * inv, o1 * inv);
    }
}

constexpr int PH_PRO = 0, PH_PER_LAYER = 11, PH_FINAL = 1 + DEPTH * PH_PER_LAYER, NPHASES = PH_FINAL + 1;
#ifndef PG8_SP2
#define PG8_SP2 true
#endif
#ifndef PG8_ALIGN
#define PG8_ALIGN true
#endif

__global__ void __launch_bounds__(NTHREADS, 2) mega_fwd(Args args) {
    extern __shared__ __attribute__((aligned(16))) unsigned char lds[];
    KArgs kp = (KArgs)__builtin_amdgcn_kernarg_segment_ptr();
    asm volatile("" : "+s"(kp));
    Frame F;
    F.lds = (LAS unsigned char*)lds; F.ldsg = (char*)lds; F.ws = args.ws;
    F.tid = threadIdx.x; F.lane = F.tid & 63; F.wave = __builtin_amdgcn_readfirstlane(F.tid >> 6); F.G = gridDim.x;
    volatile LAS unsigned* MISCW = (volatile LAS unsigned*)(F.lds + LDSCTL_OFF);
    if (F.tid < 64) MISCW[F.tid] = 0u;
    __syncthreads();
    unsigned* ctl = (unsigned*)(args.ws + WS_CTL);
    XcdBarrier bar; bar.bar = ctl + CW_BAR; bar.x = 0; bar.st = MISCW + 8;
    const int lo = args.ph_lo, hi = args.ph_hi;
    if (hi - lo > 1) bar = xcd_barrier_post(ctl + CW_BAR, MISCW + 8);
#ifndef PHMASK
#define PHMASK 0xFFFF
#endif
#define HAS(p) ((PHMASK >> (p)) & 1)
#define IN(k) (lo <= (k) && (k) < hi)
#define SEAM(k) do { if (IN(k) && IN((k) + 1)) xcd_barrier(bar); } while (0)
    const int gw = blockIdx.x * NWAVES + F.wave, NGW = F.G * NWAVES;
    unsigned char* ws0 = args.ws;
    float* xout0 = args.out;
#define PHASE_PTRS GAS unsigned char* wsg_ = (GAS unsigned char*)ws0; GAS float* xog_ = (GAS float*)xout0; asm volatile("" : "+s"(wsg_), "+s"(xog_)); unsigned char* ws = (unsigned char*)wsg_; float* xout = (float*)xog_; unsigned char* wl = ws + WS_W + (size_t)l * W_LAYER; (void)wl; (void)xout;

    if (HAS(11) && IN(PH_PRO)) { p_prologue(F, kp); }
    SEAM(PH_PRO);

    for (int l = 0; l < DEPTH; ++l) {
        const int P0 = 1 + l * PH_PER_LAYER;

        if (HAS(0) && IN(P0 + 0)) { PHASE_PTRS
            norm_rows_f16(F, (l == 0) ? INP(kp, I_X) : (const float*)xout, INP(kp, I_NORM1) + l * DM, (f16*)(ws + WS_H), T, gw, NGW);
            norm_rows_f16(F, INP(kp, I_MEM), INP(kp, I_MEMNORM) + l * DM, (f16*)(ws + WS_MEMN), BATCH * MEMLEN, gw, NGW);
        }
        SEAM(P0 + 0);
        if (HAS(1) && IN(P0 + 1)) { PHASE_PTRS
            {
              pg8::Order<1> S; S.init(T, NZ, F.G, (int)blockIdx.x);
              pg8::EpiF16<0> E{};
              E.base[0] = (f16*)(ws + WS_RQ); E.ld[0] = 512; E.lo[0] = 0;
              E.base[1] = (f16*)(ws + WS_RK); E.ld[1] = 512; E.lo[1] = 2;
              E.base[2] = (f16*)(ws + WS_RV); E.ld[2] = 512; E.lo[2] = 4;
              E.base[3] = (f16*)(ws + WS_GM); E.ld[3] = 1024; E.lo[3] = 6;
              E.base[4] = (f16*)(ws + WS_CQ); E.ld[4] = 256; E.lo[4] = 8;
              E.base[5] = (f16*)(ws + WS_MISC); E.ld[5] = 256; E.lo[5] = 9;
              E.base[6] = (f16*)(ws + WS_GM) + 512; E.ld[6] = 1024; E.lo[6] = 10;
              E.base[7] = (f16*)(ws + WS_GATES); E.ld[7] = 3072; E.lo[7] = 12; E.nd = 8;
              pg8::gemm_phase<pg8::EpiF16<0>, 1, PG8_ALIGN, PG8_SP2>(F.lds, (const f16*)(ws + WS_H), nullptr, nullptr, (const f16*)(wl + W_IN), nullptr, nullptr, DM, 0, 0, DM, DM, S, E); }
            {
              pg8::Order<1> S; S.init(BATCH * MEMLEN, 1024, F.G, (int)blockIdx.x);
              pg8::EpiF16<0> E{}; E.base[0] = (f16*)(ws + WS_MKV); E.ld[0] = 1024; E.lo[0] = 0; E.nd = 1;
              pg8::gemm_phase<pg8::EpiF16<0>, 1, PG8_ALIGN, PG8_SP2>(F.lds, (const f16*)(ws + WS_MEMN), nullptr, nullptr, (const f16*)(wl + W_MKV), nullptr, nullptr, DM, 0, 0, DM, DM, S, E); }
        }
        SEAM(P0 + 1);
        if (HAS(2) && IN(P0 + 2)) { PHASE_PTRS
            if (F.G >= 256) { if (blockIdx.x >= 128) p_dsa_norms(F, kp, l, (blockIdx.x - 128) * NWAVES + F.wave, (F.G - 128) * NWAVES); }
            else p_dsa_norms(F, kp, l, gw, NGW);
            for (int u = blockIdx.x; u < 128; u += F.G) p_retention_simple(F, u);
        }
        SEAM(P0 + 2);
        if (HAS(3) && IN(P0 + 3)) { PHASE_PTRS

            pg8::Order<1> S; S.init(T, 1280, F.G, (int)blockIdx.x);
            pg8::EpiF16<0> E{}; E.base[0] = (f16*)(ws + WS_H); E.ld[0] = 1024; E.lo[0] = 0; E.base[1] = (f16*)(ws + WS_QIDX); E.ld[1] = 256; E.lo[1] = 4; E.nd = 2;
            pg8::gemm_phase<pg8::EpiF16<0>, 1, PG8_ALIGN, PG8_SP2>(F.lds, (const f16*)(ws + WS_CQ), nullptr, nullptr, (const f16*)(wl + W_DQ), nullptr, nullptr, 256, 0, 0, 256, 256, S, E);
        }
        SEAM(P0 + 3);
        if (HAS(4) && IN(P0 + 4)) { p_topk(F); }
        SEAM(P0 + 4);
        if (HAS(5) && IN(P0 + 5)) { PHASE_PTRS
            p_dsa_attn_simple(F);
            f16* GM = (f16*)(ws + WS_GM); const f16* MKV = (const f16*)(ws + WS_MKV);
            for (int u = blockIdx.x; u < BATCH * 4 * 16; u += F.G) {
                const int b = u >> 6, h = (u >> 4) & 3, qb = u & 15;
                f16* q = GM + (size_t)(b * SEQ + qb * 256) * 1024 + 512 + h * 128; const f16* k = MKV + (size_t)(b * MEMLEN) * 1024 + h * 128;
                __syncthreads();
                att::attn_dense_body<1024, 1024, 1024>(q, k, k + 512, q, MEMLEN, F.ldsg, 0.088388347648318440f);
            }
        }
        SEAM(P0 + 5);
        if (HAS(6) && IN(P0 + 6)) { PHASE_PTRS
            const f16* GM = (const f16*)(ws + WS_GM); const f16* WRM = (const f16*)(wl + W_RM);

            pg8::Order<3> S; S.init(T, 1024, F.G, (int)blockIdx.x);
            pg8::EpiMerge E{(const f16*)(ws + WS_GATES), (f16*)(ws + WS_MERGED)};
            pg8::gemm_phase<pg8::EpiMerge, 3, PG8_ALIGN, PG8_SP2>(F.lds, GM, (const f16*)(ws + WS_H), GM + 512, WRM, (const f16*)(wl + W_VO), WRM + 512, 512, 1024, 512, 1024, 1024, S, E);
        }
        SEAM(P0 + 6);
        if (HAS(7) && IN(P0 + 7)) { PHASE_PTRS

            pg8::Order<1> S; S.init(T, DM, F.G, (int)blockIdx.x);
            pg8::EpiRes E{(l == 0) ? INP(kp, I_X) : (const float*)xout, xout, DM};
            pg8::gemm_phase<pg8::EpiRes, 1, PG8_ALIGN, PG8_SP2>(F.lds, (const f16*)(ws + WS_MERGED), nullptr, nullptr, (const f16*)(wl + W_OUT), nullptr, nullptr, DM, 0, 0, DM, DM, S, E);
        }
        SEAM(P0 + 7);
        if (HAS(8) && IN(P0 + 8)) { PHASE_PTRS norm_rows_f16(F, xout, INP(kp, I_NORM2) + l * DM, (f16*)(ws + WS_H), T, gw, NGW); }
        SEAM(P0 + 8);
        if (HAS(9) && IN(P0 + 9)) { PHASE_PTRS

            pg8::Order<1> S; S.init(T, FF, F.G, (int)blockIdx.x);
            pg8::EpiF16<1> E{}; E.base[0] = (f16*)(ws + WS_HID); E.ld[0] = FF; E.lo[0] = 0; E.nd = 1;
            pg8::gemm_phase<pg8::EpiF16<1>, 1, PG8_ALIGN, PG8_SP2>(F.lds, (const f16*)(ws + WS_H), nullptr, nullptr, (const f16*)(wl + W_FF1), nullptr, nullptr, DM, 0, 0, DM, DM, S, E);
        }
        SEAM(P0 + 9);
        if (HAS(10) && IN(P0 + 10)) { PHASE_PTRS

            pg8::Order<1> S; S.init(T, DM, F.G, (int)blockIdx.x);
            pg8::EpiRes E{xout, xout, DM};
            pg8::gemm_phase<pg8::EpiRes, 1, PG8_ALIGN, PG8_SP2>(F.lds, (const f16*)(ws + WS_HID), nullptr, nullptr, (const f16*)(wl + W_FF2), nullptr, nullptr, FF, 0, 0, FF, FF, S, E);
        }
        SEAM(P0 + 10);
    }
    if (HAS(12) && IN(PH_FINAL)) { const int l = 0; PHASE_PTRS norm_rows_f32_inplace(F, xout, INP(kp, I_FINALNORM), T, gw, NGW); }
#undef IN
#undef SEAM
}

extern "C" void kernel_launch(void* const* d_in, const int* in_sizes, int n_in, void* d_out, int out_size, void* d_ws, size_t ws_size, hipStream_t stream) {
    static int grid = 0;
    if (grid == 0) {
        if (n_in != 21 || in_sizes[0] != T * DM || out_size != T * DM || ws_size < WS_END) {
            fprintf(stderr, "kernel_launch: shape mismatch (n_in %d, in0 %d, out %d, ws %zu < %zu); nothing launched\n", n_in, n_in > 0 ? in_sizes[0] : -1, out_size, ws_size, (size_t)WS_END); grid = -1; return; }
        int dev = 0, cus = 0;
        if (hipGetDevice(&dev) != hipSuccess || hipDeviceGetAttribute(&cus, hipDeviceAttributeMultiprocessorCount, dev) != hipSuccess) { grid = -1; return; }
        if (hipFuncSetAttribute((const void*)mega_fwd, hipFuncAttributeMaxDynamicSharedMemorySize, LDS_BYTES) != hipSuccess) { fprintf(stderr, "kernel_launch: hipFuncSetAttribute failed\n"); grid = -1; return; }
        int per_cu = 0;
        if (hipOccupancyMaxActiveBlocksPerMultiprocessor(&per_cu, (const void*)mega_fwd, NTHREADS, LDS_BYTES) != hipSuccess || per_cu < 1)
            fprintf(stderr, "kernel_launch: note: occupancy query reports %d workgroups per CU\n", per_cu);
        (void)hipGetLastError();
        grid = cus;
    }
    if (grid < 0) return;
    (void)hipMemsetAsync((char*)d_ws + WS_CTL, 0, CTL_ZERO_BYTES, stream);
    Args a{};
    for (int i = 0; i < 21; ++i) a.in[i] = (const float*)d_in[i];
    a.out = (float*)d_out; a.ws = (unsigned char*)d_ws;
#if MK_SPLIT
    for (int p = 0; p < NPHASES; ++p) { a.ph_lo = p; a.ph_hi = p + 1; hipLaunchKernelGGL(mega_fwd, dim3(grid), dim3(NTHREADS), LDS_BYTES, stream, a); }
#else
    a.ph_lo = 0; a.ph_hi = NPHASES; hipLaunchKernelGGL(mega_fwd, dim3(grid), dim3(NTHREADS), LDS_BYTES, stream, a);
#endif
    const hipError_t le = hipPeekAtLastError();
    if (le != hipSuccess) fprintf(stderr, "kernel_launch: launch failed: %s\n", hipGetErrorName(le));
}
```

```cpp
#include <hip/hip_runtime.h>
#include <cstdio>
#include <cstdint>

#ifndef DSA_SIMPLE
#define DSA_SIMPLE 0
#endif
#ifndef MK_SPLIT
#define MK_SPLIT 0
#endif

#define GAS __attribute__((address_space(1)))
#define LAS __attribute__((address_space(3)))
typedef _Float16 f16;
typedef _Float16 h8 __attribute__((ext_vector_type(8)));
typedef _Float16 h4 __attribute__((ext_vector_type(4)));
typedef _Float16 h2 __attribute__((ext_vector_type(2)));
typedef float f32x2 __attribute__((ext_vector_type(2)));
typedef float f32x4 __attribute__((ext_vector_type(4)));
typedef float f32x8 __attribute__((ext_vector_type(8)));
typedef float f32x16 __attribute__((ext_vector_type(16)));
typedef unsigned u32x4 __attribute__((ext_vector_type(4)));
typedef unsigned u32x2 __attribute__((ext_vector_type(2)));

constexpr int BATCH = 16, SEQ = 4096, DM = 1024, T = BATCH * SEQ, DEPTH = 2;
constexpr int NIN = 6056, NZ = 6144, FF = 4096, MEMLEN = 256;
constexpr int NWAVES = 8, NTHREADS = 512;

constexpr size_t MiB = 1u << 20;
constexpr size_t WS_CTL = 0, CTL_ZERO_BYTES = 1 * MiB;
constexpr size_t WS_ROPE = 1 * MiB;
constexpr size_t WS_TB = 2 * MiB;
constexpr size_t WS_W = 3 * MiB, W_LAYER = 37 * MiB;
constexpr size_t W_IN = 0, W_DQ = 12 * MiB, W_MKV = 13 * MiB, W_RM = 15 * MiB, W_VO = 17 * MiB, W_OUT = 19 * MiB, W_FF1 = 21 * MiB, W_FF2 = 29 * MiB;
constexpr size_t WS_MEMN = 77 * MiB, WS_MKV = 85 * MiB;
constexpr size_t WS_H = 93 * MiB;
constexpr size_t WS_RQ = 221 * MiB;
constexpr size_t WS_RK = 285 * MiB;
constexpr size_t WS_RV = 349 * MiB;
constexpr size_t WS_GM = 413 * MiB;
constexpr size_t WS_CQ = 541 * MiB;
constexpr size_t WS_MISC = 573 * MiB;
constexpr size_t WS_GATES = 605 * MiB;
constexpr size_t WS_CKVN = 989 * MiB;
constexpr size_t WS_HID = 221 * MiB;
constexpr size_t WS_END = 1005 * MiB;
constexpr size_t WS_QIDX = WS_RQ, WS_MASK = WS_RQ + 32 * MiB, WS_MERGED = WS_RK;

constexpr int LDS_BYTES = 163840;
constexpr int LDSCTL_OFF = LDS_BYTES - 256;

#define XB_TMO      128
#define XB_XCNT(j)  (256  + 64 * (j))
#define XB_XSUB(j)  (1280 + 64 * (j))
#define XB_XGEN(j)  (2304 + 64 * (j))
#define XB_TOP      3328
#define XB_TOPGEN   3392
#define XCD_BAR_WORDS 3456
#define XB_SPIN_CAP (1u << 21)
constexpr int CW_BAR = 4096;

__device__ __forceinline__ unsigned xb_ld(unsigned* p)              { return __hip_atomic_load(p, __ATOMIC_RELAXED, __HIP_MEMORY_SCOPE_AGENT); }
__device__ __forceinline__ unsigned xb_add(unsigned* p, unsigned v) { return __hip_atomic_fetch_add(p, v, __ATOMIC_RELAXED, __HIP_MEMORY_SCOPE_AGENT); }
__device__ __forceinline__ unsigned xb_xcc_id() { return (unsigned)__builtin_amdgcn_s_getreg((3 << 11) | 20) & 0xFu; }
#define XB_SPIN(cond, bar) do { unsigned _sp = 0; while (cond) { __builtin_amdgcn_s_sleep(1); \
    if ((++_sp & 255u) == 0u) { if (xb_ld(&(bar)[XB_TMO])) break; if (_sp > XB_SPIN_CAP) { atomicAdd(&(bar)[XB_TMO], 1u); break; } } } } while (0)

struct XcdBarrier { unsigned* bar; unsigned x; volatile LAS unsigned* st; };

__device__ __forceinline__ XcdBarrier xcd_barrier_post(unsigned* bar, volatile LAS unsigned* st) {
    XcdBarrier b; b.bar = bar; b.x = xb_xcc_id(); b.st = st;
    if (threadIdx.x == 0) (void)xb_add(&bar[XB_XCNT(b.x)], 1u);
    return b;
}
__device__ __forceinline__ void xcd_barrier_complete(unsigned* bar, unsigned x, unsigned& nloc, unsigned& nx) {
    const unsigned G = gridDim.x * gridDim.y * gridDim.z;
    unsigned sum, cnt, mine, sp = 0u;
    for (;;) {
        sum = 0u; cnt = 0u; mine = 0u;
#pragma unroll
        for (unsigned j = 0; j < 16; ++j) { const unsigned c = xb_ld(&bar[XB_XCNT(j)]); sum += c; cnt += (c > 0u) ? 1u : 0u; mine = (j == x) ? c : mine; }
        if (sum == G) break;
        __builtin_amdgcn_s_sleep(1);
        if ((++sp & 255u) == 0u) { if (xb_ld(&bar[XB_TMO])) break; if (sp > XB_SPIN_CAP) { atomicAdd(&bar[XB_TMO], 1u); break; } }
    }
    nloc = mine > 0u ? mine : 1u; nx = cnt > 0u ? cnt : 1u;
}
__device__ __forceinline__ void xcd_barrier(const XcdBarrier& b) {
    asm volatile("s_waitcnt vmcnt(0)" ::: "memory");
    __syncthreads();
    if (threadIdx.x == 0) {
        unsigned* bar = b.bar;
        __builtin_amdgcn_s_waitcnt(0);
        unsigned nloc = b.st[0], nx = b.st[1];
        if (nloc == 0u) { xcd_barrier_complete(bar, b.x, nloc, nx); b.st[0] = nloc; b.st[1] = nx; }
        const unsigned old = xb_add(&bar[XB_XSUB(b.x)], 1u);
        const unsigned gen = old / nloc;
        if (old + 1u == (gen + 1u) * nloc) {
            __builtin_amdgcn_fence(__ATOMIC_RELEASE, "agent");
            asm volatile("s_waitcnt vmcnt(0)" ::: "memory");
            const unsigned og = xb_add(&bar[XB_TOP], 1u);
            const unsigned tg = og / nx;
            if (og + 1u == (tg + 1u) * nx) xb_add(&bar[XB_TOPGEN], 1u);
            else XB_SPIN(xb_ld(&bar[XB_TOPGEN]) == tg, bar);
            __builtin_amdgcn_fence(__ATOMIC_ACQUIRE, "agent");
            xb_add(&bar[XB_XGEN(b.x)], 1u);
            asm volatile("s_waitcnt vmcnt(0)" ::: "memory");
        } else {
            XB_SPIN(xb_ld(&bar[XB_XGEN(b.x)]) == gen, bar);
            __builtin_amdgcn_fence(__ATOMIC_ACQUIRE, "agent");
            asm volatile("s_waitcnt vmcnt(0)" ::: "memory");
        }
    }
    __syncthreads();
}

__device__ __forceinline__ unsigned pk2h(float lo, float hi) { const h2 p = __builtin_convertvector((f32x2){lo, hi}, h2); return __builtin_bit_cast(unsigned, p); }
__device__ __forceinline__ float wave_sum(float v) {
#pragma unroll
    for (int o = 1; o < 64; o <<= 1) v += __shfl_xor(v, o);
    return v;
}
#define LDS_WAIT() asm volatile("s_waitcnt lgkmcnt(0)" ::: "memory")

namespace pg8 {
constexpr int BM = 256, BK = 64, HALF = 128, HTB = HALF * BK * 2, STAGE_BYTES = 8 * HTB, NXCD = 8, WGM = 8;
__host__ __device__ __forceinline__ int lds_byte(int r, int c) { const int st = (r >> 4) * 2 + (c >> 5), rr = r & 15, cc = c & 31, ob = rr * 64 + cc * 2; return st * 1024 + (ob ^ (((ob >> 9) & 1) << 5)); }
__host__ __device__ __forceinline__ void stage_rc(int b, int& R, int& C) { const int st = b / 1024, sb = b % 1024, swz = sb ^ (((sb >> 9) & 1) << 5); R = (st >> 1) * 16 + swz / 64; C = (st & 1) * 32 + (swz % 64) / 2; }
__host__ __device__ __forceinline__ int perm32(int rho) { const int n = rho >> 4, i = rho & 15; return 8 * (i >> 2) + 4 * n + (i & 3); }

struct Unit { int pm, pn, seg; };

template <int NSEG> struct Order {
    int nM, nN, nwg, G, c;
    __device__ void init(int M, int N, int G_, int c_) { nM = M / BM; nN = N / BM; nwg = nM * nN; G = G_; c = c_; }
    __device__ bool next(int i, Unit& u) const {
        const int ti = i / NSEG; u.seg = i - ti * NSEG;
        const long L = (long)ti * G + c; if (L >= nwg) return false;
        int wgid = (int)L; { const int q = nwg / NXCD, r = nwg % NXCD, xcd = wgid % NXCD, off = wgid / NXCD; wgid = (xcd < r ? xcd * (q + 1) : r * (q + 1) + (xcd - r) * q) + off; }
        const int nig = WGM * nN, gid = wgid / nig, fm = gid * WGM, gsz = (nM - fm) < WGM ? (nM - fm) : WGM;
        u.pm = fm + ((wgid % nig) % gsz); u.pn = (wgid % nig) / gsz; return true;
    }
};
__device__ __forceinline__ unsigned long long pick3(int seg, unsigned long long v0, unsigned long long v1, unsigned long long v2) {
    const unsigned long long m1 = (unsigned long long)0 - (unsigned long long)(seg == 1), m2 = (unsigned long long)0 - (unsigned long long)(seg == 2);
    return v0 + ((v1 - v0) & m1) + ((v2 - v0) & m2);
}

template <int ACT  > struct EpiF16 {
    static constexpr bool PERM = true;
    f16* base[8]; int ld[8]; int lo[8]; int nd;
    __device__ __forceinline__ void operator()(f32x4 (&acc)[2][2][4][2], const Unit& u, int wr, int wc, int fr, int fq) const {
        f16* b = base[0]; int l = ld[0]; int t0 = lo[0];
#pragma unroll
        for (int i = 1; i < 8; ++i) if (i < nd && u.pn >= lo[i]) { b = base[i]; l = ld[i]; t0 = lo[i]; }
        const int row0 = u.pm * BM + wr * 64 + fr, col0 = (u.pn - t0) * BM + wc * 32 + 8 * fq;
#pragma unroll
        for (int ai = 0; ai < 2; ++ai)
#pragma unroll
            for (int m = 0; m < 4; ++m) { f16* rowp = b + (size_t)(row0 + ai * HALF + m * 16) * l + col0;
#pragma unroll
                for (int bj = 0; bj < 2; ++bj) { f32x4 v0 = acc[ai][bj][m][0], v1 = acc[ai][bj][m][1];
                    if (ACT == 1) {
#pragma unroll
                        for (int j = 0; j < 4; ++j) { const float a = fmaxf(v0[j], 0.f), c = fmaxf(v1[j], 0.f); v0[j] = a * a; v1[j] = c * c; } }
                    u32x4 w; w.x = pk2h(v0[0], v0[1]); w.y = pk2h(v0[2], v0[3]); w.z = pk2h(v1[0], v1[1]); w.w = pk2h(v1[2], v1[3]);
                    *(u32x4*)(rowp + bj * HALF) = w; } }
    }
};
struct EpiRes {
    static constexpr bool PERM = false;
    const float* base; float* out; int ldc;
    __device__ __forceinline__ void operator()(f32x4 (&acc)[2][2][4][2], const Unit& u, int wr, int wc, int fr, int fq) const {
        const int row0 = u.pm * BM + wr * 64 + fr, col0 = u.pn * BM + wc * 32 + 4 * fq;
#pragma unroll
        for (int ai = 0; ai < 2; ++ai)
#pragma unroll
            for (int m = 0; m < 4; ++m) { const size_t off = (size_t)(row0 + ai * HALF + m * 16) * ldc + col0;
#pragma unroll
                for (int bj = 0; bj < 2; ++bj)
#pragma unroll
                    for (int n = 0; n < 2; ++n) { const f32x4 bs = *(const f32x4*)(base + off + bj * HALF + n * 16); *(f32x4*)(out + off + bj * HALF + n * 16) = bs + acc[ai][bj][m][n]; }
                asm volatile("" ::: "memory"); }
    }
};
struct EpiMerge {
    static constexpr bool PERM = true;
    const f16* gates; f16* out;
    __device__ __forceinline__ void operator()(f32x4 (&acc)[2][2][4][2], const Unit& u, int wr, int wc, int fr, int fq) const {
        const int row0 = u.pm * BM + wr * 64 + fr, col0 = u.pn * BM + wc * 32 + 8 * fq;
        const int ga = (u.seg == 0 ? 0 : (u.seg == 1 ? 1024 : 2048)), gb = (u.seg == 0 ? 1024 : 2048);
#pragma unroll
        for (int ai = 0; ai < 2; ++ai)
#pragma unroll
            for (int m = 0; m < 4; ++m) { const int row = row0 + ai * HALF + m * 16; const f16* gp = gates + (size_t)row * 3072 + col0;
#pragma unroll
                for (int bj = 0; bj < 2; ++bj) {
                    const h8 xa = *(const h8*)(gp + ga + bj * HALF);
                    float f[8];
                    if (u.seg < 2) { const h8 xb = *(const h8*)(gp + gb + bj * HALF);
#pragma unroll
                        for (int j = 0; j < 8; ++j) { const float a = fminf(fmaxf((float)xa[j], -30.f), 30.f), b = fminf(fmaxf((float)xb[j], -30.f), 30.f);
                            f[j] = (1.f + __expf(-b)) * __builtin_amdgcn_rcpf(1.f + __expf(-a)); }
                    } else {
#pragma unroll
                        for (int j = 0; j < 8; ++j) { const float a = fminf(fmaxf((float)xa[j], -30.f), 30.f); f[j] = __builtin_amdgcn_rcpf(1.f + __expf(-a)); }
                    }
                    f32x4 v0 = acc[ai][bj][m][0], v1 = acc[ai][bj][m][1];
#pragma unroll
                    for (int j = 0; j < 4; ++j) { v0[j] *= f[j]; v1[j] *= f[4 + j]; }
                    if (u.seg < 2) { acc[ai][bj][m][0] = v0; acc[ai][bj][m][1] = v1; }
                    else { u32x4 w; w.x = pk2h(v0[0], v0[1]); w.y = pk2h(v0[2], v0[3]); w.z = pk2h(v1[0], v1[1]); w.w = pk2h(v1[2], v1[3]);
                        *(u32x4*)(out + (size_t)row * 1024 + col0 + bj * HALF) = w; } }
                asm volatile("" ::: "memory"); }
    }
};

template <class Epi, int NSEG, bool ALIGN_EPI, bool SP2>
__device__ __forceinline__ void gemm_phase(LAS unsigned char* lds, const f16* gA0, const f16* gA1, const f16* gA2, const f16* gB0, const f16* gB1, const f16* gB2,
                                           const int gK0, const int gK1, const int gK2, const int g_lda, const int g_ldb, const Order<NSEG>& S, const Epi& E) {
    const unsigned long long uA0 = (unsigned long long)gA0, uA1 = (unsigned long long)gA1, uA2 = (unsigned long long)gA2, uB0 = (unsigned long long)gB0, uB1 = (unsigned long long)gB1, uB2 = (unsigned long long)gB2;
#define SEG_A(u) ((const char*)(NSEG > 1 ? pick3((u).seg, uA0, uA1, uA2) : uA0) + (size_t)(u).pm * (size_t)(BM * 2) * g_lda)
#define SEG_B(u) ((const char*)(NSEG > 1 ? pick3((u).seg, uB0, uB1, uB2) : uB0) + (size_t)(u).pn * (size_t)(BM * 2) * g_ldb)
#define SEG_K(u) (NSEG > 1 ? (int)pick3((u).seg, (unsigned long long)gK0, (unsigned long long)gK1, (unsigned long long)gK2) : gK0)
    int tid_ = threadIdx.x; asm volatile("" : "+v"(tid_));
    const int tid = tid_, wid = __builtin_amdgcn_readfirstlane(tid >> 6), lane = tid & 63, wr = wid >> 2, wc = wid & 3, fr = lane & 15, fq = lane >> 4;
    unsigned voffA[2], voffB[2];
#pragma unroll
    for (int i = 0; i < 2; ++i) { int R, C; stage_rc(tid * 16 + i * 8192, R, C); const int Rb = Epi::PERM ? ((R & ~31) + perm32(R & 31)) : R;
        voffA[i] = (unsigned)(R * g_lda + C) * 2u; voffB[i] = (unsigned)(Rb * g_ldb + C) * 2u; }
    const size_t kstep = (size_t)(BK * 2);
    const size_t hstepA = (size_t)HALF * g_lda * 2, hstepB = (size_t)HALF * g_ldb * 2;
    const unsigned ldsw = (unsigned)wid * 1024u;
    const int aoff = lds_byte(wr * 64 + fr, fq * 8), boff = lds_byte(wc * 32 + fr, fq * 8);
#define PG8_SA(b, h) (((b) * 2 + (h)) * HTB)
#define PG8_SB(b, h) ((4 + (b) * 2 + (h)) * HTB)
#define PG8_STAGE(bufoff, gbase, voff) do { _Pragma("unroll") for (int _i = 0; _i < 2; ++_i) \
        __builtin_amdgcn_global_load_lds((const unsigned*)((const char*)(gbase) + (voff)[_i]), (LAS unsigned*)(lds + (bufoff) + ldsw + _i * 8192), 16, 0, 0); } while (0)
#define PG8_LDA(dst, b, h) do { _Pragma("unroll") for (int m = 0; m < 4; ++m) _Pragma("unroll") for (int k = 0; k < 2; ++k) dst[m][k] = *(const LAS h8*)(lds + PG8_SA(b, h) + aoff + m * 2048 + k * 1024); } while (0)
#define PG8_LDB(dst, b, h) do { _Pragma("unroll") for (int n = 0; n < 2; ++n) _Pragma("unroll") for (int k = 0; k < 2; ++k) dst[n][k] = *(const LAS h8*)(lds + PG8_SB(b, h) + boff + n * 2048 + k * 1024); } while (0)
#define PG8_MMA(ai, bj, At, Bt) do { __builtin_amdgcn_s_setprio(1); _Pragma("unroll") for (int m = 0; m < 4; ++m) _Pragma("unroll") for (int n = 0; n < 2; ++n) _Pragma("unroll") for (int k = 0; k < 2; ++k) \
        acc[ai][bj][m][n] = __builtin_amdgcn_mfma_f32_16x16x32_f16(Bt[n][k], At[m][k], acc[ai][bj][m][n], 0, 0, 0); __builtin_amdgcn_s_setprio(0); } while (0)
#define PG8_WAIT_V(n) asm volatile("s_waitcnt vmcnt(" #n ")" ::: "memory")
#define PG8_WAIT_L(n) asm volatile("s_waitcnt lgkmcnt(" #n ")" ::: "memory")
#define PG8_BAR __builtin_amdgcn_s_barrier()
#define PG8_SCHED __builtin_amdgcn_sched_barrier(0)
    Unit cur, nxt; int ui = 0;
    if (!S.next(0, cur)) return;
    f32x4 acc[2][2][4][2];
#pragma unroll
    for (int a = 0; a < 2; ++a)
#pragma unroll
        for (int b = 0; b < 2; ++b)
#pragma unroll
            for (int m = 0; m < 4; ++m)
#pragma unroll
                for (int n = 0; n < 2; ++n) acc[a][b][m][n] = (f32x4){0.f, 0.f, 0.f, 0.f};
    h8 At[4][2], B0[2][2], B1[2][2];
    const char* cA = SEG_A(cur); const char* cB = SEG_B(cur);
    if constexpr (SP2) {
        PG8_STAGE(PG8_SB(0, 0), cB, voffB); PG8_STAGE(PG8_SB(0, 1), cB + hstepB, voffB); PG8_STAGE(PG8_SA(0, 0), cA, voffA); PG8_STAGE(PG8_SA(0, 1), cA + hstepA, voffA);
        if (wr == 1) PG8_BAR;
        PG8_WAIT_V(2); PG8_BAR;
        PG8_STAGE(PG8_SB(1, 0), cB + kstep, voffB); PG8_STAGE(PG8_SA(1, 0), cA + kstep, voffA); PG8_STAGE(PG8_SB(1, 1), cB + hstepB + kstep, voffB);
        PG8_WAIT_V(6); PG8_BAR;
    } else {
        PG8_STAGE(PG8_SB(0, 0), cB, voffB); PG8_STAGE(PG8_SA(0, 0), cA, voffA); PG8_STAGE(PG8_SB(0, 1), cB + hstepB, voffB); PG8_STAGE(PG8_SA(0, 1), cA + hstepA, voffA);
        if (wr == 1) PG8_BAR;
        PG8_WAIT_V(4); PG8_BAR;
        PG8_STAGE(PG8_SB(1, 0), cB + kstep, voffB); PG8_STAGE(PG8_SA(1, 0), cA + kstep, voffA); PG8_STAGE(PG8_SB(1, 1), cB + hstepB + kstep, voffB);
        PG8_WAIT_V(6); PG8_BAR;
    }
    for (;;) {
        const bool has_next = S.next(ui + 1, nxt);
        const int nt = SEG_K(cur) / BK;
        const char* nA = has_next ? SEG_A(nxt) : cA; const char* nB = has_next ? SEG_B(nxt) : cB;
        for (int t = 0; t < nt; t += 2) {
            const bool last = (t == nt - 2);
            const char* a1 = cA + (size_t)(t + 1) * kstep;
            const char* a2 = last ? nA : cA + (size_t)(t + 2) * kstep; const char* b2 = last ? nB : cB + (size_t)(t + 2) * kstep;
            const char* a3 = a2 + kstep; const char* b3 = b2 + kstep;
            if constexpr (SP2) {
            PG8_LDB(B0, 0, 0); PG8_LDB(B1, 0, 1); PG8_SCHED; PG8_LDA(At, 0, 0); PG8_STAGE(PG8_SA(1, 1), a1 + hstepA, voffA);
            PG8_WAIT_V(8); PG8_WAIT_L(0); PG8_BAR; PG8_MMA(0, 0, At, B0); PG8_MMA(0, 1, At, B1); PG8_BAR; PG8_SCHED;
            PG8_LDA(At, 0, 1); PG8_STAGE(PG8_SB(0, 0), b2, voffB); PG8_STAGE(PG8_SB(0, 1), b2 + hstepB, voffB); PG8_STAGE(PG8_SA(0, 0), a2, voffA);
            PG8_WAIT_V(8); PG8_WAIT_L(0); PG8_BAR; PG8_MMA(1, 0, At, B0); PG8_MMA(1, 1, At, B1); PG8_BAR; PG8_SCHED;
            PG8_LDB(B0, 1, 0); PG8_LDB(B1, 1, 1); PG8_SCHED; PG8_LDA(At, 1, 0); PG8_STAGE(PG8_SA(0, 1), a2 + hstepA, voffA);
            PG8_WAIT_V(8); PG8_WAIT_L(0); PG8_BAR; PG8_MMA(0, 0, At, B0); PG8_MMA(0, 1, At, B1); PG8_BAR; PG8_SCHED;
            PG8_LDA(At, 1, 1); PG8_STAGE(PG8_SB(1, 0), b3, voffB); PG8_STAGE(PG8_SB(1, 1), b3 + hstepB, voffB); PG8_STAGE(PG8_SA(1, 0), a3, voffA);
            PG8_WAIT_V(8); PG8_WAIT_L(0); PG8_BAR; PG8_MMA(1, 0, At, B0); PG8_MMA(1, 1, At, B1); PG8_BAR; PG8_SCHED;
            } else {
            PG8_LDB(B0, 0, 0); PG8_SCHED; PG8_LDA(At, 0, 0); PG8_STAGE(PG8_SA(1, 1), a1 + hstepA, voffA);
            PG8_WAIT_L(8); PG8_BAR; PG8_WAIT_L(0); PG8_MMA(0, 0, At, B0); PG8_BAR; PG8_SCHED;
            PG8_LDB(B1, 0, 1); PG8_STAGE(PG8_SB(0, 0), b2, voffB);
            PG8_BAR; PG8_WAIT_L(0); PG8_MMA(0, 1, At, B1); PG8_BAR;
            PG8_LDA(At, 0, 1); PG8_STAGE(PG8_SA(0, 0), a2, voffA);
            PG8_BAR; PG8_WAIT_L(0); PG8_MMA(1, 0, At, B0); PG8_BAR; PG8_SCHED;
            PG8_STAGE(PG8_SB(0, 1), b2 + hstepB, voffB);
            PG8_WAIT_V(6); PG8_BAR; PG8_MMA(1, 1, At, B1); PG8_BAR;
            PG8_LDB(B0, 1, 0); PG8_SCHED; PG8_LDA(At, 1, 0); PG8_STAGE(PG8_SA(0, 1), a2 + hstepA, voffA);
            PG8_WAIT_L(8); PG8_BAR; PG8_WAIT_L(0); PG8_MMA(0, 0, At, B0); PG8_BAR; PG8_SCHED;
            PG8_LDB(B1, 1, 1); PG8_STAGE(PG8_SB(1, 0), b3, voffB);
            PG8_BAR; PG8_WAIT_L(0); PG8_MMA(0, 1, At, B1); PG8_BAR;
            PG8_LDA(At, 1, 1); PG8_STAGE(PG8_SA(1, 0), a3, voffA);
            PG8_BAR; PG8_WAIT_L(0); PG8_MMA(1, 0, At, B0); PG8_BAR; PG8_SCHED;
            PG8_STAGE(PG8_SB(1, 1), b3 + hstepB, voffB);
            PG8_WAIT_V(6); PG8_BAR; PG8_MMA(1, 1, At, B1); PG8_BAR;
            }
        }
        if constexpr (ALIGN_EPI) { if (wr == 0) PG8_BAR; }
        E(acc, cur, wr, wc, fr, fq);
        if (!has_next) break;
        if (NSEG == 1 || cur.seg == NSEG - 1) {
#pragma unroll
        for (int a = 0; a < 2; ++a)
#pragma unroll
            for (int b = 0; b < 2; ++b)
#pragma unroll
                for (int m = 0; m < 4; ++m)
#pragma unroll
                    for (int n = 0; n < 2; ++n) acc[a][b][m][n] = (f32x4){0.f, 0.f, 0.f, 0.f};
        }
        cur = nxt; cA = nA; cB = nB; ++ui;
        if constexpr (ALIGN_EPI) { if (wr == 1) PG8_BAR; }
    }
    PG8_WAIT_V(0);
    if constexpr (!ALIGN_EPI) { if (wr == 0) PG8_BAR; }
    PG8_BAR;
#undef SEG_A
#undef SEG_B
#undef SEG_K
#undef PG8_SA
#undef PG8_SB
#undef PG8_STAGE
#undef PG8_LDA
#undef PG8_LDB
#undef PG8_MMA
#undef PG8_WAIT_V
#undef PG8_WAIT_L
#undef PG8_BAR
#undef PG8_SCHED
}
}

namespace att {
constexpr int D = 128, NW = 8, QBLK = 32, KVBLK = 64;
constexpr float THR = 8.f;
constexpr size_t SHM_V = KVBLK * D * 2, SHM_K = KVBLK * D * 2, SHM_ATTN = 2 * SHM_V + 2 * SHM_K + NW * 64 * 4;
#define KSWZ(row, colB) ((row) * 256 + ((colB) ^ (((row) & 7) << 4)))
#define SBAR() __builtin_amdgcn_sched_barrier(0)
__device__ __forceinline__ int crow(int r, int hi) { return (r & 3) + 8 * (r >> 2) + 4 * hi; }
__device__ __forceinline__ unsigned cvtpk(float lo, float hi) { return pk2h(lo, hi); }

template <int SCALE_NUM> struct ScaleC { };
__device__ __forceinline__ void partialSM(f32x16& p0, f32x16& p1, float& m_reg, float& mn, float& alpha, const float SCALE) {
  const float C = SCALE * 1.4426950408889634f;
  float pmax = p0[0];
#pragma unroll
  for (int r = 1; r < 16; ++r) pmax = fmaxf(pmax, p0[r]);
#pragma unroll
  for (int r = 0; r < 16; ++r) pmax = fmaxf(pmax, p1[r]);
  { auto rr = __builtin_amdgcn_permlane32_swap(__float_as_uint(pmax), __float_as_uint(pmax), false, false);
    pmax = fmaxf(__uint_as_float(rr[0]), __uint_as_float(rr[1])); }
  if (__builtin_expect(__all(pmax - m_reg <= THR / SCALE), 1)) { mn = m_reg; alpha = 1.f; }
  else { mn = fmaxf(m_reg, pmax); alpha = __builtin_amdgcn_exp2f((m_reg - mn) * C); m_reg = mn; }
  float mnC = -mn * C;
#pragma unroll
  for (int r = 0; r < 16; ++r) p0[r] = fmaf(p0[r], C, mnC);
#pragma unroll
  for (int r = 0; r < 16; ++r) p1[r] = fmaf(p1[r], C, mnC);
#pragma unroll
  for (int r = 0; r < 16; ++r) p0[r] = __builtin_amdgcn_exp2f(p0[r]);
}
__device__ __forceinline__ void finishSM(f32x16& p0, f32x16& p1, float alpha, float& l_reg, h8& pa0, h8& pa1, h8& pa2, h8& pa3) {
#pragma unroll
  for (int r = 0; r < 16; ++r) p1[r] = __builtin_amdgcn_exp2f(p1[r]);
  float ps = 0;
#pragma unroll
  for (int r = 0; r < 16; ++r) ps += p0[r];
#pragma unroll
  for (int r = 0; r < 16; ++r) ps += p1[r];
  { auto rr = __builtin_amdgcn_permlane32_swap(__float_as_uint(ps), __float_as_uint(ps), false, false);
    ps = __uint_as_float(rr[0]) + __uint_as_float(rr[1]); }
  l_reg = l_reg * alpha + ps;
#define PK4(P, BASE, OUT) do { unsigned a0 = cvtpk(P[BASE + 0], P[BASE + 1]), a1 = cvtpk(P[BASE + 2], P[BASE + 3]);   \
    unsigned b0 = cvtpk(P[BASE + 4], P[BASE + 5]), b1 = cvtpk(P[BASE + 6], P[BASE + 7]);                              \
    auto r0 = __builtin_amdgcn_permlane32_swap(a0, b0, false, false); auto r1 = __builtin_amdgcn_permlane32_swap(a1, b1, false, false); \
    u32x4 w = {r0[0], r1[0], r0[1], r1[1]}; OUT = __builtin_bit_cast(h8, w); } while (0)
  PK4(p0, 0, pa0); PK4(p0, 8, pa1); PK4(p1, 0, pa2); PK4(p1, 8, pa3);
#undef PK4
}
__device__ __forceinline__ void qkt(f32x16& p0, f32x16& p1, const char* Ks, const h8* qr, int r32, int hi) {
  p0 = f32x16{}; p1 = f32x16{};
#pragma unroll
  for (int d0 = 0; d0 < 8; ++d0) { int cb = (d0 * 16 + hi * 8) * 2;
    h8 b0 = *reinterpret_cast<const h8*>(Ks + KSWZ(r32, cb));
    h8 b1 = *reinterpret_cast<const h8*>(Ks + KSWZ(32 + r32, cb));
    p0 = __builtin_amdgcn_mfma_f32_32x32x16_f16(b0, qr[d0], p0, 0, 0, 0);
    p1 = __builtin_amdgcn_mfma_f32_32x32x16_f16(b1, qr[d0], p1, 0, 0, 0); }
}
__device__ __forceinline__ int v_st(int k, int c) { const int kk = (k & ~0xC) | ((k & 4) << 1) | ((k & 8) >> 1); return ((kk >> 3) * 4 + (c >> 5)) * 512 + ((kk & 7) * 32 + (c & 31)) * 2; }
__device__ __forceinline__ int v_rd_base(int lane) { return ((lane & 3) << 3) | (((lane >> 2) & 3) << 6) | (((lane >> 4) & 1) << 5) | (((lane >> 5) & 1) << 8); }
constexpr int v_rd_off(int d0, int ks, int half) { return d0 * 512 + ks * 4096 + half * 2048; }
template <int OFF> __device__ __forceinline__ h4 tr_read(int vb) {
  h4 r; asm volatile("ds_read_b64_tr_b16 %0, %1 offset:%2" : "=&v"(r) : "v"(vb), "i"(OFF) : "memory"); return r;
}
template <int D0> __device__ __forceinline__ void pv_one(f32x16& od, int vb, h8 pa0, h8 pa1, h8 pa2, h8 pa3) {
  const h4 l0 = tr_read<v_rd_off(D0, 0, 0)>(vb), h0 = tr_read<v_rd_off(D0, 0, 1)>(vb), l1 = tr_read<v_rd_off(D0, 1, 0)>(vb), h1 = tr_read<v_rd_off(D0, 1, 1)>(vb);
  const h4 l2 = tr_read<v_rd_off(D0, 2, 0)>(vb), h2_ = tr_read<v_rd_off(D0, 2, 1)>(vb), l3 = tr_read<v_rd_off(D0, 3, 0)>(vb), h3 = tr_read<v_rd_off(D0, 3, 1)>(vb);
  asm volatile("s_waitcnt lgkmcnt(0)" ::: "memory"); SBAR();
#define PK(L, H) (h8){L[0], L[1], L[2], L[3], H[0], H[1], H[2], H[3]}
  od = __builtin_amdgcn_mfma_f32_32x32x16_f16(pa0, PK(l0, h0), od, 0, 0, 0);
  od = __builtin_amdgcn_mfma_f32_32x32x16_f16(pa1, PK(l1, h1), od, 0, 0, 0);
  od = __builtin_amdgcn_mfma_f32_32x32x16_f16(pa2, PK(l2, h2_), od, 0, 0, 0);
  od = __builtin_amdgcn_mfma_f32_32x32x16_f16(pa3, PK(l3, h3), od, 0, 0, 0);
#undef PK
}
__device__ __forceinline__ void pv_d0(f32x16* o, int vb, h8 pa0, h8 pa1, h8 pa2, h8 pa3) {
  pv_one<0>(o[0], vb, pa0, pa1, pa2, pa3); pv_one<1>(o[1], vb, pa0, pa1, pa2, pa3); pv_one<2>(o[2], vb, pa0, pa1, pa2, pa3); pv_one<3>(o[3], vb, pa0, pa1, pa2, pa3);
}
template <int LDQ, int LDK, int LDO>
__device__ __forceinline__ void attn_dense_body(const f16* __restrict__ Qb, const f16* __restrict__ Kh, const f16* __restrict__ Vh, f16* Ob, int seq, char* lds, const float SCALE) {
  int tid_ = threadIdx.x; asm volatile("" : "+v"(tid_));
  const int tid = tid_, wid = tid >> 6, lane = tid & 63, r32 = lane & 31, hi = lane >> 5;
  char* V_lds = lds; char* K_lds = lds + 2 * SHM_V;
  float* ws = (float*)(lds + 2 * SHM_V + 2 * SHM_K) + wid * 64; float* li_l = ws; float* al_l = ws + 32;
  float m_reg = -1e30f, l_reg = 0; f32x16 o[4] = {}; h8 qr[8];
  const f16* Qw = Qb + (long)(wid * QBLK + r32) * LDQ + hi * 8;
#pragma unroll
  for (int d0 = 0; d0 < 8; ++d0) qr[d0] = *reinterpret_cast<const h8*>(Qw + d0 * 16);
  const int sr = tid >> 4, sc = (tid & 15) * 8, vst0 = v_st(sr, sc), vst1 = v_st(32 + sr, sc);
  const int vb0 = (int)(uintptr_t)V_lds + v_rd_base(lane);
  struct { h8 vs0, vs1, ks0, ks1; } sr_[2];
#define SLOAD(i, k0) do { sr_[i].vs0 = *(const h8*)(&Vh[(long)((k0) + sr) * LDK + sc]); sr_[i].vs1 = *(const h8*)(&Vh[(long)((k0) + 32 + sr) * LDK + sc]); \
    sr_[i].ks0 = *(const h8*)(&Kh[(long)((k0) + sr) * LDK + sc]); sr_[i].ks1 = *(const h8*)(&Kh[(long)((k0) + 32 + sr) * LDK + sc]); } while (0)
#define SWRITE(b, i) do { *(h8*)(V_lds + (b) * SHM_V + vst0) = sr_[i].vs0;          \
    *(h8*)(V_lds + (b) * SHM_V + vst1) = sr_[i].vs1; int kc = sc * 2;               \
    *(h8*)(K_lds + (b) * SHM_K + KSWZ(sr, kc)) = sr_[i].ks0;                       \
    *(h8*)(K_lds + (b) * SHM_K + KSWZ(32 + sr, kc)) = sr_[i].ks1; } while (0)
#define SWAIT() asm volatile("s_waitcnt vmcnt(4)" ::: "memory")
#define RESC(a) do { if (__any((a) < 1.f)) { if (hi == 0) al_l[r32] = (a); asm volatile("s_waitcnt lgkmcnt(0)" ::: "memory"); \
    _Pragma("unroll") for (int d = 0; d < 4; ++d) _Pragma("unroll") for (int r = 0; r < 16; ++r) o[d][r] *= al_l[crow(r, hi)]; } } while (0)
  f32x16 pA0, pA1, pB0, pB1; float mnA, mnB, alA, alB; h8 pa0, pa1, pa2, pa3; const int NT = seq / KVBLK;
  constexpr int SE = 0, SO = 1;
  SLOAD(SE, 0); asm volatile("s_waitcnt vmcnt(0)" ::: "memory"); SWRITE(0, SE); __syncthreads();
  qkt(pA0, pA1, K_lds, qr, r32, hi); partialSM(pA0, pA1, m_reg, mnA, alA, SCALE);
  SLOAD(SO, KVBLK); if (2 < NT) SLOAD(SE, 2 * KVBLK);
  SWAIT(); SWRITE(1, SO); __syncthreads();
  for (int j = 1; j + 1 < NT; j += 2) {
    SBAR(); qkt(pB0, pB1, K_lds + SHM_K, qr, r32, hi);
    finishSM(pA0, pA1, alA, l_reg, pa0, pa1, pa2, pa3); SBAR();
    SLOAD(SO, (j + 2) * KVBLK); SBAR();
    pv_d0(o, vb0, pa0, pa1, pa2, pa3); partialSM(pB0, pB1, m_reg, mnB, alB, SCALE);
    __syncthreads(); SWAIT(); SWRITE(0, SE);
    RESC(alB); __syncthreads();
    SBAR(); qkt(pA0, pA1, K_lds, qr, r32, hi);
    finishSM(pB0, pB1, alB, l_reg, pa0, pa1, pa2, pa3); SBAR();
    if (j + 3 < NT) SLOAD(SE, (j + 3) * KVBLK); SBAR();
    pv_d0(o, vb0 + (int)SHM_V, pa0, pa1, pa2, pa3); partialSM(pA0, pA1, m_reg, mnA, alA, SCALE);
    __syncthreads(); SWAIT(); SWRITE(1, SO);
    RESC(alA); __syncthreads();
  }
  SBAR(); qkt(pB0, pB1, K_lds + SHM_K, qr, r32, hi);
  finishSM(pA0, pA1, alA, l_reg, pa0, pa1, pa2, pa3); SBAR();
  pv_d0(o, vb0, pa0, pa1, pa2, pa3); partialSM(pB0, pB1, m_reg, mnB, alB, SCALE);
  __syncthreads(); RESC(alB);
  finishSM(pB0, pB1, alB, l_reg, pa0, pa1, pa2, pa3); SBAR();
  pv_d0(o, vb0 + (int)SHM_V, pa0, pa1, pa2, pa3);
  if (hi == 0) li_l[r32] = l_reg; asm volatile("s_waitcnt lgkmcnt(0)" ::: "memory");
  float rli[16];
#pragma unroll
  for (int r = 0; r < 16; ++r) rli[r] = __builtin_amdgcn_rcpf(li_l[crow(r, hi)]);
  f16* Ow = Ob + (long)(wid * QBLK) * LDO;
#pragma unroll
  for (int r = 0; r < 16; ++r) { int orow = crow(r, hi);
#pragma unroll
    for (int d0 = 0; d0 < 4; ++d0) Ow[(long)orow * LDO + d0 * 32 + r32] = (f16)(o[d0][r] * rli[r]); }
#undef SLOAD
#undef SWRITE
#undef SWAIT
#undef RESC
}

__device__ __forceinline__ void maskbias(f32x16& p0, f32x16& p1, const unsigned long long mw, const bool far, const int base, const float b15, const LAS float* tbh, const int hi) {
  const unsigned mlo = (unsigned)mw >> (4 * hi), mhi = (unsigned)(mw >> 32) >> (4 * hi);
  const float NEG = -INFINITY;
  if (far) {
#pragma unroll
    for (int r = 0; r < 16; ++r) { const int c = (r & 3) + 8 * (r >> 2);
      p0[r] = ((mlo >> c) & 1u) ? p0[r] + b15 : NEG; p1[r] = ((mhi >> c) & 1u) ? p1[r] + b15 : NEG; }
  } else {
#pragma unroll
    for (int r = 0; r < 16; ++r) { const int c = (r & 3) + 8 * (r >> 2);
      int r0 = base + c, r1 = base + c + 32; r0 = r0 < 0 ? 0 : (r0 > 255 ? 255 : r0); r1 = r1 < 0 ? 0 : (r1 > 255 ? 255 : r1);
      const float b0 = tbh[r0 * 8], b1 = tbh[r1 * 8];
      p0[r] = ((mlo >> c) & 1u) ? p0[r] + b0 : NEG; p1[r] = ((mhi >> c) & 1u) ? p1[r] + b1 : NEG; }
  }
}
__device__ __forceinline__ void dsa_attn_unit(f16* Qb, const f16* __restrict__ Kh, const unsigned long long* __restrict__ M, const int NT, const int tq0, const LAS float* tbl, char* lds) {
  constexpr int LDQ = 128, LDK = 128, LDO = 128; const float SCALE = 1.f;
  int tid_ = threadIdx.x; asm volatile("" : "+v"(tid_));
  const int tid = tid_, wid = tid >> 6, lane = tid & 63, r32 = lane & 31, hi = lane >> 5;
  char* V_lds = lds; char* K_lds = lds + 2 * SHM_V;
  float* ws = (float*)(lds + 2 * SHM_V + 2 * SHM_K) + wid * 64; float* li_l = ws; float* al_l = ws + 32;
  float m_reg = -1e30f, l_reg = 0; f32x16 o[4] = {}; h8 qr[8];
  const f16* Qw = Qb + (long)(wid * QBLK + r32) * LDQ + hi * 8;
#pragma unroll
  for (int d0 = 0; d0 < 8; ++d0) qr[d0] = *reinterpret_cast<const h8*>(Qw + d0 * 16);
  const int qi = wid * 4 + (r32 >> 3), head = r32 & 7, tpos = tq0 + qi;
  const unsigned long long* Mq = M + (size_t)qi * 64;
  const LAS float* tbh = tbl + head; const float b15 = tbh[0];
  const int sr = tid >> 4, sc = (tid & 15) * 8, vst0 = v_st(sr, sc), vst1 = v_st(32 + sr, sc);
  const int vb0 = (int)(uintptr_t)V_lds + v_rd_base(lane);
  struct { h8 ks0, ks1; } sr_[2];
#define SLOAD(i, k0) do { sr_[i].ks0 = *(const h8*)(&Kh[(long)((k0) + sr) * LDK + sc]); sr_[i].ks1 = *(const h8*)(&Kh[(long)((k0) + 32 + sr) * LDK + sc]); } while (0)
#define SWRITE(b, i) do { *(h8*)(V_lds + (b) * SHM_V + vst0) = sr_[i].ks0; *(h8*)(V_lds + (b) * SHM_V + vst1) = sr_[i].ks1; int kc = sc * 2; \
    *(h8*)(K_lds + (b) * SHM_K + KSWZ(sr, kc)) = sr_[i].ks0; *(h8*)(K_lds + (b) * SHM_K + KSWZ(32 + sr, kc)) = sr_[i].ks1; } while (0)
#define RESC(a) do { if (__any((a) < 1.f)) { if (hi == 0) al_l[r32] = (a); asm volatile("s_waitcnt lgkmcnt(0)" ::: "memory"); \
    _Pragma("unroll") for (int d = 0; d < 4; ++d) _Pragma("unroll") for (int r = 0; r < 16; ++r) o[d][r] *= al_l[crow(r, hi)]; } } while (0)
#define FAR(j) (64 * (j) <= tq0 - 191)
#define MBASE(j) (64 * (j) + 4 * hi - tpos + 192)
  f32x16 pA0, pA1, pB0, pB1; float mnA, mnB, alA, alB; h8 pa0, pa1, pa2, pa3;
  constexpr int SE = 0, SO = 1;
  unsigned long long mA = Mq[0], mB = Mq[1];
  SLOAD(SE, 0); SWRITE(0, SE); __syncthreads();
  qkt(pA0, pA1, K_lds, qr, r32, hi); maskbias(pA0, pA1, mA, FAR(0), MBASE(0), b15, tbh, hi); if (2 < NT) mA = Mq[2];
  partialSM(pA0, pA1, m_reg, mnA, alA, SCALE);
  SLOAD(SO, KVBLK); if (2 < NT) SLOAD(SE, 2 * KVBLK);
  SWRITE(1, SO); __syncthreads();
  for (int j = 1; j + 1 < NT; j += 2) {
    SBAR(); qkt(pB0, pB1, K_lds + SHM_K, qr, r32, hi);
    finishSM(pA0, pA1, alA, l_reg, pa0, pa1, pa2, pa3); SBAR();
    SLOAD(SO, (j + 2) * KVBLK); SBAR();
    pv_d0(o, vb0, pa0, pa1, pa2, pa3);
    maskbias(pB0, pB1, mB, FAR(j), MBASE(j), b15, tbh, hi); mB = Mq[j + 2];
    partialSM(pB0, pB1, m_reg, mnB, alB, SCALE);
    __syncthreads(); SWRITE(0, SE);
    RESC(alB); __syncthreads();
    SBAR(); qkt(pA0, pA1, K_lds, qr, r32, hi);
    finishSM(pB0, pB1, alB, l_reg, pa0, pa1, pa2, pa3); SBAR();
    if (j + 3 < NT) SLOAD(SE, (j + 3) * KVBLK); SBAR();
    pv_d0(o, vb0 + (int)SHM_V, pa0, pa1, pa2, pa3);
    maskbias(pA0, pA1, mA, FAR(j + 1), MBASE(j + 1), b15, tbh, hi); if (j + 3 < NT) mA = Mq[j + 3];
    partialSM(pA0, pA1, m_reg, mnA, alA, SCALE);
    __syncthreads(); SWRITE(1, SO);
    RESC(alA); __syncthreads();
  }
  SBAR(); qkt(pB0, pB1, K_lds + SHM_K, qr, r32, hi);
  finishSM(pA0, pA1, alA, l_reg, pa0, pa1, pa2, pa3); SBAR();
  pv_d0(o, vb0, pa0, pa1, pa2, pa3);
  maskbias(pB0, pB1, mB, FAR(NT - 1), MBASE(NT - 1), b15, tbh, hi);
  partialSM(pB0, pB1, m_reg, mnB, alB, SCALE);
  __syncthreads(); RESC(alB);
  finishSM(pB0, pB1, alB, l_reg, pa0, pa1, pa2, pa3); SBAR();
  pv_d0(o, vb0 + (int)SHM_V, pa0, pa1, pa2, pa3);
  if (hi == 0) li_l[r32] = l_reg; asm volatile("s_waitcnt lgkmcnt(0)" ::: "memory");
  float rli[16];
#pragma unroll
  for (int r = 0; r < 16; ++r) rli[r] = __builtin_amdgcn_rcpf(li_l[crow(r, hi)]);
  f16* Ow = Qb + (long)(wid * QBLK) * LDO;
#pragma unroll
  for (int r = 0; r < 16; ++r) { int orow = crow(r, hi);
#pragma unroll
    for (int d0 = 0; d0 < 4; ++d0) Ow[(long)orow * LDO + d0 * 32 + r32] = (f16)(o[d0][r] * rli[r]); }
#undef SLOAD
#undef SWRITE
#undef RESC
#undef FAR
#undef MBASE
}
}

struct Args { const float* in[21]; float* out; unsigned char* ws; int ph_lo, ph_hi; };
enum { I_X = 0, I_MEM, I_NORM1, I_WIN, I_QNORM, I_KVNORM, I_WUQ, I_WIQ, I_WUK, I_WUV, I_MEMNORM, I_WMEMKV, I_WRETO, I_WDSAO, I_WMEMO, I_WOUT, I_NORM2, I_WFF1, I_WFF2, I_RELBIAS, I_FINALNORM };

typedef const __attribute__((address_space(4))) Args* KArgs;
#define INP(a, i) ((const float*)(const GAS float*)((a)->in[i]))
struct FrameU { LAS unsigned char* lds; char* ldsg; unsigned char* ws; int G; };
struct Frame { LAS unsigned char* lds; char* ldsg; unsigned char* ws; int tid, lane, wave, G; };

__device__ __forceinline__ Frame relaunder(const FrameU& F0) { Frame F; F.lds = F0.lds; F.ldsg = F0.ldsg; F.G = F0.G; int t = threadIdx.x; asm volatile("" : "+v"(t));
    { GAS unsigned char* w = (GAS unsigned char*)F0.ws; asm volatile("" : "+s"(w)); F.ws = (unsigned char*)w; }
    F.tid = t; F.lane = t & 63; F.wave = __builtin_amdgcn_readfirstlane(t >> 6); return F; }
__device__ __forceinline__ void norm_rows_f16(const FrameU& F0, const float* src, const float* gain, f16* dst, int rows, int w0, int wstride) {
    const Frame F = relaunder(F0);
    f32x4 g[4];
#pragma unroll
    for (int j = 0; j < 4; ++j) g[j] = ((const f32x4*)gain)[F.lane + 64 * j];
    for (int m = w0; m < rows; m += wstride) {
        const f32x4* xr = (const f32x4*)(src + (size_t)m * DM) + F.lane;
        f32x4 v[4]; float s = 0.f;
#pragma unroll
        for (int j = 0; j < 4; ++j) { v[j] = xr[64 * j]; s += (v[j].x * v[j].x + v[j].y * v[j].y) + (v[j].z * v[j].z + v[j].w * v[j].w); }
        const float rstd = 1.f / sqrtf(wave_sum(s) * (1.f / DM) + 1e-6f);
        u32x2* o8 = (u32x2*)(dst + (size_t)m * DM) + F.lane;
#pragma unroll
        for (int j = 0; j < 4; ++j) { u32x2 w; w.x = pk2h(v[j].x * rstd * g[j].x, v[j].y * rstd * g[j].y); w.y = pk2h(v[j].z * rstd * g[j].z, v[j].w * rstd * g[j].w); o8[64 * j] = w; }
    }
}
__device__ __forceinline__ void norm_rows_f32_inplace(const FrameU& F0, float* x, const float* gain, int rows, int w0, int wstride) {
    const Frame F = relaunder(F0);
    f32x4 g[4];
#pragma unroll
    for (int j = 0; j < 4; ++j) g[j] = ((const f32x4*)gain)[F.lane + 64 * j];
    for (int m = w0; m < rows; m += wstride) {
        f32x4* xr = (f32x4*)(x + (size_t)m * DM) + F.lane;
        f32x4 v[4]; float s = 0.f;
#pragma unroll
        for (int j = 0; j < 4; ++j) { v[j] = xr[64 * j]; s += (v[j].x * v[j].x + v[j].y * v[j].y) + (v[j].z * v[j].z + v[j].w * v[j].w); }
        const float rstd = 1.f / sqrtf(wave_sum(s) * (1.f / DM) + 1e-6f);
#pragma unroll
        for (int j = 0; j < 4; ++j) xr[64 * j] = v[j] * rstd * g[j];
    }
}

__device__ __forceinline__ void transpose_item(const float* src, int ldsrc, int nvalid, int k0, f16* WT, int ldk, int lane, LAS float* scr) {
#pragma unroll 8
    for (int i = 0; i < 32; ++i) { const int kk = 2 * i + (lane >> 5), n = lane & 31; scr[kk * 33 + n] = (n < nvalid) ? src[(size_t)(k0 + kk) * ldsrc + n] : 0.f; }
    LDS_WAIT(); asm volatile("" ::: "memory");
    const int c = lane & 7;
#pragma unroll
    for (int j = 0; j < 4; ++j) { const int n = (lane >> 3) + 8 * j; const LAS float* s = scr + (8 * c) * 33 + n;
        u32x4 o; o.x = pk2h(s[0 * 33], s[1 * 33]); o.y = pk2h(s[2 * 33], s[3 * 33]); o.z = pk2h(s[4 * 33], s[5 * 33]); o.w = pk2h(s[6 * 33], s[7 * 33]);
        *(u32x4*)(WT + (size_t)n * ldk + k0 + 8 * c) = o; }
    LDS_WAIT(); asm volatile("" ::: "memory");
}
struct TJob { const float* src; int ldsrc, K, ncols; f16* dst; int ldk; };
__device__ __forceinline__ TJob tjob(KArgs a, unsigned char* ws, int l, int j) {
    unsigned char* wl = ws + WS_W + (size_t)l * W_LAYER; TJob t;
    const float* w_in = INP(a, I_WIN) + (size_t)l * DM * NIN;
    switch (j) {
    case 0:  t = TJob{w_in, NIN, DM, 2464, (f16*)(wl + W_IN), DM}; break;
    case 1:  t = TJob{w_in + 2464, NIN, DM, 8, (f16*)(wl + W_IN) + (size_t)2464 * DM, DM}; break;
    case 2:  t = TJob{w_in, NIN, DM, 0, (f16*)(wl + W_IN) + (size_t)2496 * DM, DM}; break;
    case 3:  t = TJob{w_in, NIN, DM, 0, (f16*)(wl + W_IN) + (size_t)2528 * DM, DM}; break;
    case 4:  t = TJob{w_in + 2472, NIN, DM, 3584, (f16*)(wl + W_IN) + (size_t)2560 * DM, DM}; break;
    case 5:  t = TJob{INP(a, I_WIQ) + (size_t)l * 256 * 256, 256, 256, 256, (f16*)(wl + W_DQ) + (size_t)1024 * 256, 256}; break;
    case 6:  t = TJob{INP(a, I_WMEMKV) + (size_t)l * DM * 1024, 1024, DM, 1024, (f16*)(wl + W_MKV), DM}; break;
    case 7:  t = TJob{INP(a, I_WRETO) + (size_t)l * 512 * DM, DM, 512, 1024, (f16*)(wl + W_RM), 1024}; break;
    case 8:  t = TJob{INP(a, I_WMEMO) + (size_t)l * 512 * DM, DM, 512, 1024, (f16*)(wl + W_RM) + 512, 1024}; break;
    case 9:  t = TJob{INP(a, I_WOUT) + (size_t)l * DM * DM, DM, DM, 1024, (f16*)(wl + W_OUT), DM}; break;
    case 10: t = TJob{INP(a, I_WFF1) + (size_t)l * DM * FF, FF, DM, FF, (f16*)(wl + W_FF1), DM}; break;
    default: t = TJob{INP(a, I_WFF2) + (size_t)l * FF * DM, DM, FF, 1024, (f16*)(wl + W_FF2), FF}; break;
    }
    return t;
}
constexpr int NTJOBS = 12;

__device__ __forceinline__ int t5_bucket(int rel) {
    const int base = rel > 0 ? 16 : 0; const int n = rel < 0 ? -rel : rel;
    if (n < 8) return base + n;
    int lg = 8 + (n >= 12) + (n >= 16) + (n >= 23) + (n >= 32) + (n >= 46) + (n >= 64) + (n >= 91); if (lg > 15) lg = 15;
    return base + lg;
}

__device__ __forceinline__ void p_prologue(const FrameU& F0, KArgs a) {
    const Frame F = relaunder(F0);
    LAS float* scr = (LAS float*)(F.lds + F.wave * 16384);
    const int gw = blockIdx.x * NWAVES + F.wave, NGW = F.G * NWAVES;
    for (int l = 0; l < DEPTH; ++l)
        for (int j = 0; j < NTJOBS; ++j) {
            const TJob t = tjob(a, F.ws, l, j);
            const int nblk = (t.ncols + 31) / 32 > 0 ? (t.ncols + 31) / 32 : 1, items = (t.K / 64) * nblk;
            for (int it = gw; it < items; it += NGW) { const int kb = it / nblk, nb = it % nblk; int nv = t.ncols - 32 * nb; nv = nv > 32 ? 32 : (nv < 0 ? 0 : nv);
                transpose_item(t.src + 32 * nb, t.ldsrc, nv, 64 * kb, t.dst + (size_t)(32 * nb) * t.ldk, t.ldk, F.lane, scr); }
        }
    const int gt = blockIdx.x * NTHREADS + F.tid, NGT = F.G * NTHREADS;
    for (int l = 0; l < DEPTH; ++l) {
        unsigned char* wl = F.ws + WS_W + (size_t)l * W_LAYER;
        const float* wuq = INP(a, I_WUQ) + (size_t)l * 256 * 512; const float* wuk = INP(a, I_WUK) + (size_t)l * 128 * 512;
        f16* wdq = (f16*)(wl + W_DQ);
        for (int e = gt; e < 1024 * 256; e += NGT) {
            const int n = e >> 8, k = e & 255, h = n >> 7, r = n & 127;
            const float* pa = wuq + ((size_t)k * 8 + h) * 64; const float* pb = wuk + ((size_t)r * 8 + h) * 64; float s = 0.f;
            for (int d = 0; d < 64; ++d) s += pa[d] * pb[d];
            wdq[e] = (f16)(s * 0.125f);
        }
        const float* wuv = INP(a, I_WUV) + (size_t)l * 128 * 512; const float* wdo = INP(a, I_WDSAO) + (size_t)l * 512 * DM;
        f16* wvo = (f16*)(wl + W_VO);
        for (int e = gt; e < 1024 * 1024; e += NGT) {
            const int n = e & 1023, kk = e >> 10, h = kk >> 7, r = kk & 127;
            const float* pa = wuv + ((size_t)r * 8 + h) * 64; const float* pb = wdo + (size_t)(h * 64) * DM + n; float s = 0.f;
            for (int d = 0; d < 64; ++d) s += pa[d] * pb[(size_t)d * DM];
            wvo[(size_t)n * 1024 + kk] = (f16)s;
        }
    }
    float* rc = (float*)(F.ws + WS_ROPE); float* rs = rc + 4096 * 32;
    for (int e = gt; e < 4096 * 32; e += NGT) { const int pos = e >> 5, i = e & 31; const float fr = exp2f(-(float)i * (13.287712379549449f / 32.f)), ang = (float)pos * fr; rc[e] = cosf(ang); rs[e] = sinf(ang); }
    float* tb = (float*)(F.ws + WS_TB);
    for (int e = gt; e < 256 * 8; e += NGT) { const int ri = e >> 3, h = e & 7; tb[e] = INP(a, I_RELBIAS)[t5_bucket(ri - 192) * 8 + h]; }
}

__device__ __forceinline__ void p_dsa_norms(const FrameU& F0, KArgs a, int l, int w0, int wstride) {
    const Frame F = relaunder(F0);
    f16* CQ = (f16*)(F.ws + WS_CQ); const f16* MISC = (const f16*)(F.ws + WS_MISC); f16* CKVN = (f16*)(F.ws + WS_CKVN);
    const float* qn = INP(a, I_QNORM) + l * 256; const float* kn = INP(a, I_KVNORM) + l * 128;
    const f32x4 gq = ((const f32x4*)qn)[F.lane]; const f32x2 gk = ((const f32x2*)kn)[F.lane];
    for (int m = w0; m < T; m += wstride) {
        h4* cq = (h4*)(CQ + (size_t)m * 256) + F.lane; const h4 v = *cq;
        const h2 kv = *((const h2*)(MISC + (size_t)m * 256) + F.lane);
        const float q0 = v[0], q1 = v[1], q2 = v[2], q3 = v[3], k0 = kv[0], k1 = kv[1];
        const float sq = wave_sum(q0 * q0 + q1 * q1 + q2 * q2 + q3 * q3), sk = wave_sum(k0 * k0 + k1 * k1);
        const float rq = 1.f / sqrtf(sq * (1.f / 256.f) + 1e-6f), rk = 1.f / sqrtf(sk * (1.f / 128.f) + 1e-6f);
        u32x2 w; w.x = pk2h(q0 * rq * gq.x, q1 * rq * gq.y); w.y = pk2h(q2 * rq * gq.z, q3 * rq * gq.w); *(u32x2*)cq = w;
        *((unsigned*)(CKVN + (size_t)m * 128) + F.lane) = pk2h(k0 * rk * gk.x, k1 * rk * gk.y);
    }
}
__device__ __forceinline__ void p_retention_simple(const FrameU& F0, int unit) {
    const Frame F = relaunder(F0);
    const int b = unit >> 3, h = unit & 7;
    LAS float* Qf = (LAS float*)F.lds; LAS float* Kf = Qf + 64 * 65; LAS float* Vf = Kf + 64 * 65; LAS float* Sf = Vf + 64 * 65; LAS float* St = Sf + 64 * 65; LAS float* Of = St + 64 * 65; LAS float* Kd = Of + 64 * 65;
    const f16* RQ = (const f16*)(F.ws + WS_RQ); const f16* RK = (const f16*)(F.ws + WS_RK); const f16* RV = (const f16*)(F.ws + WS_RV); f16* GM = (f16*)(F.ws + WS_GM);
    const float* rc = (const float*)(F.ws + WS_ROPE); const float* rs = rc + 4096 * 32;
    const float lg = log2f(1.f - exp2f(-5.f - (float)h));
    const int tid = F.tid, i = tid >> 3, cg = tid & 7;
    for (int e = tid; e < 64 * 65; e += NTHREADS) St[e] = 0.f;
    if (tid < 64) Kd[tid] = exp2f(lg * (float)(63 - tid));
    const float g64 = exp2f(lg * 64.f);
    for (int n = 0; n < 64; ++n) {
        const size_t row = (size_t)b * SEQ + 64 * n + i; const int pos = 64 * n + i;
        const h8 qv = *(const h8*)(RQ + row * 512 + h * 64 + 8 * cg), kv = *(const h8*)(RK + row * 512 + h * 64 + 8 * cg), vv = *(const h8*)(RV + row * 512 + h * 64 + 8 * cg);
        const h8 gv = *(const h8*)(GM + row * 1024 + h * 64 + 8 * cg);
        const float* cp = rc + pos * 32 + 8 * (cg & 3); const float* sp = rs + pos * 32 + 8 * (cg & 3);
#pragma unroll
        for (int j = 0; j < 8; ++j) {
            const float q = (float)qv[j], k = (float)kv[j]; const float pq = __shfl_xor(q, 4), pk = __shfl_xor(k, 4); const float c = cp[j], s = sp[j];
            const float qo = (cg < 4) ? (q * c - pq * s) : (q * c + pq * s), ko = (cg < 4) ? (k * c - pk * s) : (k * c + pk * s);
            Qf[i * 65 + 8 * cg + j] = qo; Kf[i * 65 + 8 * cg + j] = ko * 0.125f; Vf[i * 65 + 8 * cg + j] = (float)vv[j];
        }
        __syncthreads();
#pragma unroll 1
        for (int jj = 0; jj < 8; ++jj) { const int j = cg + 8 * jj; float s = 0.f;
            for (int d = 0; d < 64; ++d) s += Qf[i * 65 + d] * Kf[j * 65 + d];
            const int dd = i > j ? i - j : j - i; Sf[i * 65 + j] = s * exp2f(lg * (float)dd); }
        __syncthreads();
        float ns[8];
        const float qd = exp2f(lg * (float)(i + 1));
#pragma unroll 1
        for (int ee = 0; ee < 8; ++ee) { const int e = cg + 8 * ee; float s1 = 0.f, s2 = 0.f, s3 = 0.f;
            for (int j = 0; j < 64; ++j) s1 += Sf[i * 65 + j] * Vf[j * 65 + e];
            for (int d = 0; d < 64; ++d) s2 += Qf[i * 65 + d] * St[d * 65 + e];
            Of[i * 65 + e] = s1 + qd * s2;
            for (int j = 0; j < 64; ++j) s3 += Kf[j * 65 + i] * Kd[j] * Vf[j * 65 + e];
            ns[ee] = g64 * St[i * 65 + e] + s3; }
        __syncthreads();
#pragma unroll
        for (int ee = 0; ee < 8; ++ee) St[i * 65 + cg + 8 * ee] = ns[ee];
        float ov[8]; float s = 0.f;
#pragma unroll
        for (int j = 0; j < 8; ++j) { ov[j] = Of[i * 65 + 8 * cg + j]; s += ov[j]; }
        s += __shfl_xor(s, 1); s += __shfl_xor(s, 2); s += __shfl_xor(s, 4);
        const float mu = s * (1.f / 64.f); float q = 0.f;
#pragma unroll
        for (int j = 0; j < 8; ++j) { ov[j] -= mu; q += ov[j] * ov[j]; }
        q += __shfl_xor(q, 1); q += __shfl_xor(q, 2); q += __shfl_xor(q, 4);
        const float rstd = 1.f / sqrtf(q * (1.f / 64.f) + 1e-5f);
        float ro[8];
#pragma unroll
        for (int j = 0; j < 8; ++j) { const float g = (float)gv[j]; ro[j] = ov[j] * rstd * (g / (1.f + __expf(-g))); }
        u32x4 w; w.x = pk2h(ro[0], ro[1]); w.y = pk2h(ro[2], ro[3]); w.z = pk2h(ro[4], ro[5]); w.w = pk2h(ro[6], ro[7]);
        *(u32x4*)(GM + row * 1024 + h * 64 + 8 * cg) = w;
        __syncthreads();
    }
}

__device__ __forceinline__ unsigned fkey(float v) { const unsigned b = __float_as_uint(v); return b ^ ((unsigned)((int)b >> 31) | 0x80000000u); }
__device__ __forceinline__ void p_topk(const FrameU& F0) {
    const Frame F = relaunder(F0);
    LAS float* sc = (LAS float*)F.lds;
    LAS float* qi = (LAS float*)(F.lds + 131072);
    LAS float* wq = (LAS float*)(F.lds + 131072 + 8192);
    LAS unsigned* hist = (LAS unsigned*)(F.lds + 131072 + 8192 + 256) + F.wave * 256;
    const f16* QIDX = (const f16*)(F.ws + WS_QIDX); const f16* MISC = (const f16*)(F.ws + WS_MISC); unsigned* MASK = (unsigned*)(F.ws + WS_MASK);
    const int tid = F.tid, lane = F.lane, wave = F.wave;
    for (int idx = blockIdx.x; idx < 8192; idx += F.G) {
        const int kq = idx & 255, r = idx >> 8, b = kq & 15, j = kq >> 4, sel = r >> 3, sub = r & 7;
        const int c = sel == 0 ? j : (sel == 1 ? 31 - j : (sel == 2 ? 32 + j : 63 - j));
        const int N = 64 * (c + 1), t0 = b * SEQ + 64 * c + 8 * sub, NTe = (c + 2) & ~1;
        unsigned long long* mrow = (unsigned long long*)(MASK + (size_t)(t0 + wave) * 128);
        if (c < 4) { if (lane < NTe) mrow[lane] = lane < (c + 1) ? ~0ull : 0ull; continue; }
        for (int e = tid; e < 2048; e += NTHREADS) qi[e] = (float)QIDX[(size_t)(t0 + (e >> 8)) * 256 + (e & 255)];
        if (tid < 64) wq[tid] = (float)MISC[(size_t)(t0 + (tid >> 3)) * 256 + 160 + (tid & 7)];
        __syncthreads();
        for (int key = tid; key < N; key += NTHREADS) {
            const h8* kp = (const h8*)(MISC + (size_t)(b * SEQ + key) * 256 + 128);
            const h8 k0 = kp[0], k1 = kp[1], k2 = kp[2], k3 = kp[3];
            float kf[32];
#pragma unroll
            for (int d = 0; d < 8; ++d) { kf[d] = (float)k0[d]; kf[8 + d] = (float)k1[d]; kf[16 + d] = (float)k2[d]; kf[24 + d] = (float)k3[d]; }
#pragma unroll 1
            for (int q = 0; q < 8; ++q) { float s = 0.f;
#pragma unroll 1
                for (int h = 0; h < 8; ++h) { float dot = 0.f; const LAS f32x4* qp = (const LAS f32x4*)(qi + q * 256 + h * 32);
#pragma unroll
                    for (int d = 0; d < 8; ++d) { const f32x4 qv = qp[d]; dot += qv.x * kf[4 * d] + qv.y * kf[4 * d + 1] + qv.z * kf[4 * d + 2] + qv.w * kf[4 * d + 3]; }
                    s += wq[q * 8 + h] * fmaxf(dot, 0.f); }
                sc[q * 4096 + key] = s + 0.f; }
        }
        __syncthreads();
        {
            const LAS float* s = sc + wave * 4096; const int ni = N >> 6;
            unsigned prefix = 0; int krem = 256;
#pragma unroll 1
            for (int pass = 0; pass < 4; ++pass) {
                const int shift = 24 - 8 * pass;
                hist[lane] = 0u; hist[lane + 64] = 0u; hist[lane + 128] = 0u; hist[lane + 192] = 0u;
                for (int i = 0; i < ni; ++i) { const unsigned u = fkey(s[i * 64 + lane]); const bool in = (pass == 0) || ((u >> (shift + 8)) == prefix);
                    if (in) atomicAdd((unsigned*)&hist[(u >> shift) & 255u], 1u); }
                LDS_WAIT();
                const int c0 = (int)hist[4 * lane], c1 = (int)hist[4 * lane + 1], c2 = (int)hist[4 * lane + 2], c3 = (int)hist[4 * lane + 3];
                const int tl = c0 + c1 + c2 + c3; int x = tl;
#pragma unroll
                for (int off = 1; off < 64; off <<= 1) { const int y = __shfl_down(x, off); if (lane + off < 64) x += y; }
                const int Sx = x - tl;
                const bool mine = (Sx < krem) && (krem <= Sx + tl);
                const unsigned long long bm = __ballot(mine);
                const int src = bm ? (__ffsll((long long)bm) - 1) : 0;
                int dd, gt; { int acc = Sx; if (acc + c3 >= krem) { dd = 3; gt = acc; } else { acc += c3; if (acc + c2 >= krem) { dd = 2; gt = acc; } else { acc += c2; if (acc + c1 >= krem) { dd = 1; gt = acc; } else { acc += c1; dd = 0; gt = acc; } } } }
                dd += 4 * lane;
                dd = __shfl(dd, src); gt = __shfl(gt, src);
                prefix = (prefix << 8) | (unsigned)dd; krem -= gt;
            }
            int tbf = 0; unsigned long long myword = 0ull;
            for (int i = 0; i < ni; ++i) { const unsigned u = fkey(s[i * 64 + lane]); const bool gtb = u > prefix, eq = u == prefix;
                const unsigned long long beq = __ballot(eq); const int rank = tbf + __popcll(beq & ((1ull << lane) - 1ull));
                const unsigned long long bs = __ballot(gtb || (eq && rank < krem)); if (lane == i) myword = bs; tbf += __popcll(beq); }
            if (lane < NTe) mrow[lane] = myword;
        }
        __syncthreads();
    }
}

__device__ __forceinline__ void p_dsa_attn_simple(const FrameU& F0) {
    const Frame F = relaunder(F0);
    f16* OLAT = (f16*)(F.ws + WS_H); const f16* CKVN = (const f16*)(F.ws + WS_CKVN); const unsigned* MASK = (const unsigned*)(F.ws + WS_MASK); const float* tb = (const float*)(F.ws + WS_TB);
    const int gw = blockIdx.x * NWAVES + F.wave, NGW = F.G * NWAVES, lane = F.lane;
    for (int task = gw; task < T * 8; task += NGW) {
        const int t = task >> 3, h = task & 7, b = t >> 12, tp = t & 4095, c = tp >> 6, N = 64 * (c + 1);
        h2* qp = (h2*)(OLAT + (size_t)t * 1024 + h * 128) + lane; const h2 qv = *qp; const float q0 = qv[0], q1 = qv[1];
        const unsigned* mrow = MASK + (size_t)t * 128;
        float m = -1e30f, ls = 0.f, o0 = 0.f, o1 = 0.f;
        for (int w = 0; w < N / 32; ++w) {
            unsigned bits = __builtin_amdgcn_readfirstlane(mrow[w]);
            while (bits) { const int bit = __builtin_ctz(bits); bits &= bits - 1u; const int s = 32 * w + bit;
                const h2 cv = *((const h2*)(CKVN + (size_t)(b * SEQ + s) * 128) + lane); const float c0 = cv[0], c1 = cv[1];
                const float part = wave_sum(q0 * c0 + q1 * c1);
                const int rel = s - tp, ri = rel < -192 ? 0 : rel + 192;
                const float logit = part + tb[ri * 8 + h];
                const float mn = fmaxf(m, logit), al = __expf(m - mn), p = __expf(logit - mn);
                ls = ls * al + p; o0 = o0 * al + p * c0; o1 = o1 * al + p * c1; m = mn; }
        }
        const float inv = 1.f / ls;
        *(unsigned*)qp = pk2h(o0 * inv, o1 * inv);
    }
}


__device__ __forceinline__ void p_dsa_attn(const FrameU& F0) {
    const Frame F = relaunder(F0);
    f16* OLAT = (f16*)(F.ws + WS_H); const f16* CKVN = (const f16*)(F.ws + WS_CKVN); const unsigned long long* MASK = (const unsigned long long*)(F.ws + WS_MASK); const float* tb = (const float*)(F.ws + WS_TB);
    LAS float* tbl = (LAS float*)(F.lds + 69632);
    for (int e = F.tid; e < 2048; e += NTHREADS) tbl[e] = tb[e];
    for (int idx = blockIdx.x; idx < 2048; idx += F.G) {
        const int kq = idx & 255, r = idx >> 8, b = kq & 15, j = kq >> 4, sel = r >> 1, half = r & 1;
        const int c = sel == 0 ? j : (sel == 1 ? 31 - j : (sel == 2 ? 32 + j : 63 - j));
        const int NTe = (c + 2) & ~1, tq0 = 64 * c + 32 * half; const size_t t0 = (size_t)b * SEQ + tq0;
        __syncthreads();
        att::dsa_attn_unit(OLAT + t0 * 1024, CKVN + (size_t)b * SEQ * 128, MASK + t0 * 64, NTe, tq0, tbl, F.ldsg);
    }
}

constexpr int PH_PRO = 0, PH_PER_LAYER = 11, PH_FINAL = 1 + DEPTH * PH_PER_LAYER, NPHASES = PH_FINAL + 1;
#ifndef PG8_SP2
#define PG8_SP2 true
#endif
#ifndef PG8_ALIGN
#define PG8_ALIGN true
#endif

__global__ void __launch_bounds__(NTHREADS, 2) mega_fwd(Args args) {
    extern __shared__ __attribute__((aligned(16))) unsigned char lds[];
    KArgs kp = (KArgs)__builtin_amdgcn_kernarg_segment_ptr();
    asm volatile("" : "+s"(kp));
    FrameU F;
    F.lds = (LAS unsigned char*)lds; F.ldsg = (char*)lds; F.ws = args.ws; F.G = gridDim.x;
    volatile LAS unsigned* MISCW = (volatile LAS unsigned*)(F.lds + LDSCTL_OFF);
    if (threadIdx.x < 64) MISCW[threadIdx.x] = 0u;
    __syncthreads();
    unsigned* ctl = (unsigned*)(args.ws + WS_CTL);
    XcdBarrier bar; bar.bar = ctl + CW_BAR; bar.x = 0; bar.st = MISCW + 8;
    const int lo = args.ph_lo, hi = args.ph_hi;
    if (hi - lo > 1) bar = xcd_barrier_post(ctl + CW_BAR, MISCW + 8);
#ifndef PHMASK
#define PHMASK 0xFFFF
#endif
#define HAS(p) ((PHMASK >> (p)) & 1)
#define IN(k) (lo <= (k) && (k) < hi)
#define SEAM(k) do { if (IN(k) && IN((k) + 1)) xcd_barrier(bar); } while (0)
    const int NGW = F.G * NWAVES;
#define GW (blockIdx.x * NWAVES + (int)__builtin_amdgcn_readfirstlane(threadIdx.x >> 6))
    unsigned char* ws0 = args.ws;
    float* xout0 = args.out;
#define PHASE_PTRS GAS unsigned char* wsg_ = (GAS unsigned char*)ws0; GAS float* xog_ = (GAS float*)xout0; asm volatile("" : "+s"(wsg_), "+s"(xog_)); unsigned char* ws = (unsigned char*)wsg_; float* xout = (float*)xog_; unsigned char* wl = ws + WS_W + (size_t)l * W_LAYER; (void)wl; (void)xout;

    if (HAS(11) && IN(PH_PRO)) { p_prologue(F, kp); }
    SEAM(PH_PRO);

    for (int l = 0; l < DEPTH; ++l) {
        const int P0 = 1 + l * PH_PER_LAYER;

        if (HAS(0) && IN(P0 + 0)) { PHASE_PTRS
            norm_rows_f16(F, (l == 0) ? INP(kp, I_X) : (const float*)xout, INP(kp, I_NORM1) + l * DM, (f16*)(ws + WS_H), T, GW, NGW);
            norm_rows_f16(F, INP(kp, I_MEM), INP(kp, I_MEMNORM) + l * DM, (f16*)(ws + WS_MEMN), BATCH * MEMLEN, GW, NGW);
        }
        SEAM(P0 + 0);
        if (HAS(1) && IN(P0 + 1)) { PHASE_PTRS
            {
              pg8::Order<1> S; S.init(T, NZ, F.G, (int)blockIdx.x);
              pg8::EpiF16<0> E{};
              E.base[0] = (f16*)(ws + WS_RQ); E.ld[0] = 512; E.lo[0] = 0;
              E.base[1] = (f16*)(ws + WS_RK); E.ld[1] = 512; E.lo[1] = 2;
              E.base[2] = (f16*)(ws + WS_RV); E.ld[2] = 512; E.lo[2] = 4;
              E.base[3] = (f16*)(ws + WS_GM); E.ld[3] = 1024; E.lo[3] = 6;
              E.base[4] = (f16*)(ws + WS_CQ); E.ld[4] = 256; E.lo[4] = 8;
              E.base[5] = (f16*)(ws + WS_MISC); E.ld[5] = 256; E.lo[5] = 9;
              E.base[6] = (f16*)(ws + WS_GM) + 512; E.ld[6] = 1024; E.lo[6] = 10;
              E.base[7] = (f16*)(ws + WS_GATES); E.ld[7] = 3072; E.lo[7] = 12; E.nd = 8;
              pg8::gemm_phase<pg8::EpiF16<0>, 1, PG8_ALIGN, PG8_SP2>(F.lds, (const f16*)(ws + WS_H), nullptr, nullptr, (const f16*)(wl + W_IN), nullptr, nullptr, DM, 0, 0, DM, DM, S, E); }
            {
              pg8::Order<1> S; S.init(BATCH * MEMLEN, 1024, F.G, (int)blockIdx.x);
              pg8::EpiF16<0> E{}; E.base[0] = (f16*)(ws + WS_MKV); E.ld[0] = 1024; E.lo[0] = 0; E.nd = 1;
              pg8::gemm_phase<pg8::EpiF16<0>, 1, PG8_ALIGN, PG8_SP2>(F.lds, (const f16*)(ws + WS_MEMN), nullptr, nullptr, (const f16*)(wl + W_MKV), nullptr, nullptr, DM, 0, 0, DM, DM, S, E); }
        }
        SEAM(P0 + 1);
        if (HAS(2) && IN(P0 + 2)) { PHASE_PTRS
            if (F.G >= 256) { if (blockIdx.x >= 128) p_dsa_norms(F, kp, l, GW - 128 * NWAVES, (F.G - 128) * NWAVES); }
            else p_dsa_norms(F, kp, l, GW, NGW);
            for (int u = blockIdx.x; u < 128; u += F.G) p_retention_simple(F, u);
        }
        SEAM(P0 + 2);
        if (HAS(3) && IN(P0 + 3)) { PHASE_PTRS

            pg8::Order<1> S; S.init(T, 1280, F.G, (int)blockIdx.x);
            pg8::EpiF16<0> E{}; E.base[0] = (f16*)(ws + WS_H); E.ld[0] = 1024; E.lo[0] = 0; E.base[1] = (f16*)(ws + WS_QIDX); E.ld[1] = 256; E.lo[1] = 4; E.nd = 2;
            pg8::gemm_phase<pg8::EpiF16<0>, 1, PG8_ALIGN, PG8_SP2>(F.lds, (const f16*)(ws + WS_CQ), nullptr, nullptr, (const f16*)(wl + W_DQ), nullptr, nullptr, 256, 0, 0, 256, 256, S, E);
        }
        SEAM(P0 + 3);
        if (HAS(4) && IN(P0 + 4)) { p_topk(F); }
        SEAM(P0 + 4);
        if (HAS(5) && IN(P0 + 5)) { PHASE_PTRS
#if DSA_SIMPLE
            p_dsa_attn_simple(F);
#else
            p_dsa_attn(F);
#endif
            f16* GM = (f16*)(ws + WS_GM); const f16* MKV = (const f16*)(ws + WS_MKV);
            for (int u = blockIdx.x; u < BATCH * 4 * 16; u += F.G) {
                const int b = u >> 6, h = (u >> 4) & 3, qb = u & 15;
                f16* q = GM + (size_t)(b * SEQ + qb * 256) * 1024 + 512 + h * 128; const f16* k = MKV + (size_t)(b * MEMLEN) * 1024 + h * 128;
                __syncthreads();
                att::attn_dense_body<1024, 1024, 1024>(q, k, k + 512, q, MEMLEN, F.ldsg, 0.088388347648318440f);
            }
        }
        SEAM(P0 + 5);
        if (HAS(6) && IN(P0 + 6)) { PHASE_PTRS
            const f16* GM = (const f16*)(ws + WS_GM); const f16* WRM = (const f16*)(wl + W_RM);

            pg8::Order<3> S; S.init(T, 1024, F.G, (int)blockIdx.x);
            pg8::EpiMerge E{(const f16*)(ws + WS_GATES), (f16*)(ws + WS_MERGED)};
            pg8::gemm_phase<pg8::EpiMerge, 3, PG8_ALIGN, PG8_SP2>(F.lds, GM, (const f16*)(ws + WS_H), GM + 512, WRM, (const f16*)(wl + W_VO), WRM + 512, 512, 1024, 512, 1024, 1024, S, E);
        }
        SEAM(P0 + 6);
        if (HAS(7) && IN(P0 + 7)) { PHASE_PTRS

            pg8::Order<1> S; S.init(T, DM, F.G, (int)blockIdx.x);
            pg8::EpiRes E{(l == 0) ? INP(kp, I_X) : (const float*)xout, xout, DM};
            pg8::gemm_phase<pg8::EpiRes, 1, PG8_ALIGN, PG8_SP2>(F.lds, (const f16*)(ws + WS_MERGED), nullptr, nullptr, (const f16*)(wl + W_OUT), nullptr, nullptr, DM, 0, 0, DM, DM, S, E);
        }
        SEAM(P0 + 7);
        if (HAS(8) && IN(P0 + 8)) { PHASE_PTRS norm_rows_f16(F, xout, INP(kp, I_NORM2) + l * DM, (f16*)(ws + WS_H), T, GW, NGW); }
        SEAM(P0 + 8);
        if (HAS(9) && IN(P0 + 9)) { PHASE_PTRS

            pg8::Order<1> S; S.init(T, FF, F.G, (int)blockIdx.x);
            pg8::EpiF16<1> E{}; E.base[0] = (f16*)(ws + WS_HID); E.ld[0] = FF; E.lo[0] = 0; E.nd = 1;
            pg8::gemm_phase<pg8::EpiF16<1>, 1, PG8_ALIGN, PG8_SP2>(F.lds, (const f16*)(ws + WS_H), nullptr, nullptr, (const f16*)(wl + W_FF1), nullptr, nullptr, DM, 0, 0, DM, DM, S, E);
        }
        SEAM(P0 + 9);
        if (HAS(10) && IN(P0 + 10)) { PHASE_PTRS

            pg8::Order<1> S; S.init(T, DM, F.G, (int)blockIdx.x);
            pg8::EpiRes E{xout, xout, DM};
            pg8::gemm_phase<pg8::EpiRes, 1, PG8_ALIGN, PG8_SP2>(F.lds, (const f16*)(ws + WS_HID), nullptr, nullptr, (const f16*)(wl + W_FF2), nullptr, nullptr, FF, 0, 0, FF, FF, S, E);
        }
        SEAM(P0 + 10);
    }
    if (HAS(12) && IN(PH_FINAL)) { const int l = 0; PHASE_PTRS norm_rows_f32_inplace(F, xout, INP(kp, I_FINALNORM), T, GW, NGW); }
#undef IN
#undef SEAM
}

extern "C" void kernel_launch(void* const* d_in, const int* in_sizes, int n_in, void* d_out, int out_size, void* d_ws, size_t ws_size, hipStream_t stream) {
    static int grid = 0;
    if (grid == 0) {
        if (n_in != 21 || in_sizes[0] != T * DM || out_size != T * DM || ws_size < WS_END) {
            fprintf(stderr, "kernel_launch: shape mismatch (n_in %d, in0 %d, out %d, ws %zu < %zu); nothing launched\n", n_in, n_in > 0 ? in_sizes[0] : -1, out_size, ws_size, (size_t)WS_END); grid = -1; return; }
        int dev = 0, cus = 0;
        if (hipGetDevice(&dev) != hipSuccess || hipDeviceGetAttribute(&cus, hipDeviceAttributeMultiprocessorCount, dev) != hipSuccess) { grid = -1; return; }
        if (hipFuncSetAttribute((const void*)mega_fwd, hipFuncAttributeMaxDynamicSharedMemorySize, LDS_BYTES) != hipSuccess) { fprintf(stderr, "kernel_launch: hipFuncSetAttribute failed\n"); grid = -1; return; }
        int per_cu = 0;
        if (hipOccupancyMaxActiveBlocksPerMultiprocessor(&per_cu, (const void*)mega_fwd, NTHREADS, LDS_BYTES) != hipSuccess || per_cu < 1)
            fprintf(stderr, "kernel_launch: note: occupancy query reports %d workgroups per CU\n", per_cu);
        (void)hipGetLastError();
        grid = cus;
    }
    if (grid < 0) return;
    (void)hipMemsetAsync((char*)d_ws + WS_CTL, 0, CTL_ZERO_BYTES, stream);
    Args a{};
    for (int i = 0; i < 21; ++i) a.in[i] = (const float*)d_in[i];
    a.out = (float*)d_out; a.ws = (unsigned char*)d_ws;
#if MK_SPLIT
    for (int p = 0; p < NPHASES; ++p) { a.ph_lo = p; a.ph_hi = p + 1; hipLaunchKernelGGL(mega_fwd, dim3(grid), dim3(NTHREADS), LDS_BYTES, stream, a); }
#else
    a.ph_lo = 0; a.ph_hi = NPHASES; hipLaunchKernelGGL(mega_fwd, dim3(grid), dim3(NTHREADS), LDS_BYTES, stream, a);
#endif
    const hipError_t le = hipPeekAtLastError();
    if (le != hipSuccess) fprintf(stderr, "kernel_launch: launch failed: %s\n", hipGetErrorName(le));
}
```

```cpp
#include <hip/hip_runtime.h>
#include <cstdio>
#include <cstdint>

#ifndef DSA_GATHER
#define DSA_GATHER 1
#endif
#ifndef DSA_SIMPLE
#define DSA_SIMPLE 0
#endif
#ifndef RET_SIMPLE
#define RET_SIMPLE 0
#endif
#ifndef MK_SPLIT
#define MK_SPLIT 0
#endif
#ifndef RET_SPLIT3
#define RET_SPLIT3 1
#endif
#ifndef RET_IN_ATTN
#define RET_IN_ATTN 1
#endif
#ifndef ATT16
#define ATT16 1
#endif

#define GAS __attribute__((address_space(1)))
#define LAS __attribute__((address_space(3)))
typedef _Float16 f16;
typedef _Float16 h8 __attribute__((ext_vector_type(8)));
typedef _Float16 h4 __attribute__((ext_vector_type(4)));
typedef _Float16 h2 __attribute__((ext_vector_type(2)));
typedef float f32x2 __attribute__((ext_vector_type(2)));
typedef float f32x4 __attribute__((ext_vector_type(4)));
typedef float f32x8 __attribute__((ext_vector_type(8)));
typedef float f32x16 __attribute__((ext_vector_type(16)));
typedef unsigned u32x4 __attribute__((ext_vector_type(4)));
typedef unsigned u32x2 __attribute__((ext_vector_type(2)));

constexpr int BATCH = 16, SEQ = 4096, DM = 1024, T = BATCH * SEQ, DEPTH = 2;
constexpr int NIN = 6056, NZ = 6144, FF = 4096, MEMLEN = 256;
constexpr int NWAVES = 8, NTHREADS = 512;

constexpr size_t MiB = 1u << 20;
constexpr size_t WS_CTL = 0, CTL_ZERO_BYTES = 1 * MiB;
constexpr size_t WS_ROPE = 1 * MiB;
constexpr size_t WS_TB = 2 * MiB;
constexpr size_t WS_W = 3 * MiB, W_LAYER = 37 * MiB;
constexpr size_t W_IN = 0, W_DQ = 12 * MiB, W_MKV = 13 * MiB, W_RM = 15 * MiB, W_VO = 17 * MiB, W_OUT = 19 * MiB, W_FF1 = 21 * MiB, W_FF2 = 29 * MiB;
constexpr size_t WS_MEMN = 77 * MiB, WS_MKV = 85 * MiB;
constexpr size_t WS_H = 221 * MiB;
constexpr size_t WS_RQ = 349 * MiB;
constexpr size_t WS_RK = 413 * MiB;
constexpr size_t WS_RV = 477 * MiB;
constexpr size_t WS_X16 = 93 * MiB;
constexpr size_t DO_GM = 0;
constexpr size_t DO_MERGED = 128 * MiB;
constexpr size_t WS_CQ = 541 * MiB;
constexpr size_t WS_MISC = 573 * MiB;
constexpr size_t WS_GATES = 605 * MiB;
constexpr size_t WS_CKVN = 989 * MiB;
constexpr size_t WS_HID = 221 * MiB;
constexpr size_t WS_IKC = 1005 * MiB;
constexpr size_t WS_SS1 = 1009 * MiB;
constexpr size_t WS_SS2 = 1013 * MiB;
constexpr size_t WS_END = 1017 * MiB;
constexpr size_t DO_QIDX = 192 * MiB, DO_MASK = 224 * MiB;

constexpr int LDS_BYTES = 163840;
constexpr int LDSCTL_OFF = LDS_BYTES - 256;

#define XB_TMO      128
#define XB_XCNT(j)  (256  + 64 * (j))
#define XB_XSUB(j)  (1280 + 64 * (j))
#define XB_XGEN(j)  (2304 + 64 * (j))
#define XB_TOP      3328
#define XB_TOPGEN   3392
#define XCD_BAR_WORDS 3456
#define XB_SPIN_CAP (1u << 21)
constexpr int CW_BAR = 4096;
constexpr int CW_ATTQ = 16384;

__device__ __forceinline__ unsigned xb_ld(unsigned* p)              { return __hip_atomic_load(p, __ATOMIC_RELAXED, __HIP_MEMORY_SCOPE_AGENT); }
__device__ __forceinline__ unsigned xb_add(unsigned* p, unsigned v) { return __hip_atomic_fetch_add(p, v, __ATOMIC_RELAXED, __HIP_MEMORY_SCOPE_AGENT); }
__device__ __forceinline__ unsigned xb_xcc_id() { return (unsigned)__builtin_amdgcn_s_getreg((3 << 11) | 20) & 0xFu; }
#define XB_SPIN(cond, bar) do { unsigned _sp = 0; while (cond) { __builtin_amdgcn_s_sleep(1); \
    if ((++_sp & 255u) == 0u) { if (xb_ld(&(bar)[XB_TMO])) break; if (_sp > XB_SPIN_CAP) { atomicAdd(&(bar)[XB_TMO], 1u); break; } } } } while (0)

struct XcdBarrier { unsigned* bar; unsigned x; volatile LAS unsigned* st; int wave; };

__device__ __forceinline__ int lane_now();
__device__ __forceinline__ bool xb_leader(int wave) { return wave == 0 && lane_now() == 0; }
__device__ __forceinline__ XcdBarrier xcd_barrier_post(unsigned* bar, volatile LAS unsigned* st, int wave) {
    XcdBarrier b; b.bar = bar; b.x = xb_xcc_id(); b.st = st; b.wave = wave;
    if (xb_leader(wave)) (void)xb_add(&bar[XB_XCNT(b.x)], 1u);
    return b;
}
__device__ __forceinline__ void xcd_barrier_complete(unsigned* bar, unsigned x, unsigned& nloc, unsigned& nx) {
    const unsigned G = gridDim.x * gridDim.y * gridDim.z;
    unsigned sum, cnt, mine, sp = 0u;
    for (;;) {
        sum = 0u; cnt = 0u; mine = 0u;
#pragma unroll
        for (unsigned j = 0; j < 16; ++j) { const unsigned c = xb_ld(&bar[XB_XCNT(j)]); sum += c; cnt += (c > 0u) ? 1u : 0u; mine = (j == x) ? c : mine; }
        if (sum == G) break;
        __builtin_amdgcn_s_sleep(1);
        if ((++sp & 255u) == 0u) { if (xb_ld(&bar[XB_TMO])) break; if (sp > XB_SPIN_CAP) { atomicAdd(&bar[XB_TMO], 1u); break; } }
    }
    nloc = mine > 0u ? mine : 1u; nx = cnt > 0u ? cnt : 1u;
}
__device__ __forceinline__ void xcd_barrier(const XcdBarrier& b0) {
    asm volatile("s_waitcnt vmcnt(0)" ::: "memory");
    __syncthreads();
    XcdBarrier b = b0; { GAS unsigned* p_ = (GAS unsigned*)b0.bar; unsigned x_ = b0.x; asm volatile("" : "+s"(p_), "+s"(x_)); b.bar = (unsigned*)p_; b.x = x_; }
    if (xb_leader(b.wave)) {
        unsigned* bar = b.bar;
        __builtin_amdgcn_s_waitcnt(0);
        unsigned nloc = b.st[0], nx = b.st[1];
        if (nloc == 0u) { xcd_barrier_complete(bar, b.x, nloc, nx); b.st[0] = nloc; b.st[1] = nx; }
        const unsigned old = xb_add(&bar[XB_XSUB(b.x)], 1u);
        const unsigned gen = old / nloc;
        if (old + 1u == (gen + 1u) * nloc) {
            __builtin_amdgcn_fence(__ATOMIC_RELEASE, "agent");
            asm volatile("s_waitcnt vmcnt(0)" ::: "memory");
            const unsigned og = xb_add(&bar[XB_TOP], 1u);
            const unsigned tg = og / nx;
            if (og + 1u == (tg + 1u) * nx) xb_add(&bar[XB_TOPGEN], 1u);
            else XB_SPIN(xb_ld(&bar[XB_TOPGEN]) == tg, bar);
            __builtin_amdgcn_fence(__ATOMIC_ACQUIRE, "agent");
            xb_add(&bar[XB_XGEN(b.x)], 1u);
            asm volatile("s_waitcnt vmcnt(0)" ::: "memory");
        } else {
            XB_SPIN(xb_ld(&bar[XB_XGEN(b.x)]) == gen, bar);
            __builtin_amdgcn_fence(__ATOMIC_ACQUIRE, "agent");
            asm volatile("s_waitcnt vmcnt(0)" ::: "memory");
        }
    }
    __syncthreads();
}

__device__ __forceinline__ int lane_now() { int l; asm volatile("v_mbcnt_lo_u32_b32 %0, -1, 0\n\tv_mbcnt_hi_u32_b32 %0, -1, %0" : "=v"(l)); return l; }
__device__ __forceinline__ int tid_of(int wave) { return wave * 64 + lane_now(); }
__device__ __forceinline__ unsigned pk2h(float lo, float hi) { const h2 p = __builtin_convertvector((f32x2){lo, hi}, h2); return __builtin_bit_cast(unsigned, p); }
__device__ __forceinline__ float sx(float v, int o, int lane) { return __int_as_float(__builtin_amdgcn_ds_bpermute((lane ^ o) << 2, __float_as_int(v))); }
__device__ __forceinline__ int shfl_i(int v, int src) { return __builtin_amdgcn_ds_bpermute(src << 2, v); }
__device__ __forceinline__ float wave_sum(float v, int lane) {
#pragma unroll
    for (int o = 1; o < 64; o <<= 1) v += sx(v, o, lane);
    return v;
}
__device__ __forceinline__ int wave_incl_scan(int v) {
    v += __builtin_amdgcn_update_dpp(0, v, 0x111, 0xf, 0xf, false); v += __builtin_amdgcn_update_dpp(0, v, 0x112, 0xf, 0xf, false);
    v += __builtin_amdgcn_update_dpp(0, v, 0x114, 0xf, 0xf, false); v += __builtin_amdgcn_update_dpp(0, v, 0x118, 0xf, 0xf, false);
    v += __builtin_amdgcn_update_dpp(0, v, 0x142, 0xa, 0xf, false); v += __builtin_amdgcn_update_dpp(0, v, 0x143, 0xc, 0xf, false);
    return v;
}
#define LDS_WAIT() asm volatile("s_waitcnt lgkmcnt(0)" ::: "memory")

namespace pg8 {
constexpr int BM = 256, BK = 64, HALF = 128, HTB = HALF * BK * 2, STAGE_BYTES = 8 * HTB, NXCD = 8, WGM = 8;
__host__ __device__ __forceinline__ int lds_byte(int r, int c) { const int st = (r >> 4) * 2 + (c >> 5), rr = r & 15, cc = c & 31, ob = rr * 64 + cc * 2; return st * 1024 + (ob ^ (((ob >> 9) & 1) << 5)); }
__host__ __device__ __forceinline__ void stage_rc(int b, int& R, int& C) { const int st = b / 1024, sb = b % 1024, swz = sb ^ (((sb >> 9) & 1) << 5); R = (st >> 1) * 16 + swz / 64; C = (st & 1) * 32 + (swz % 64) / 2; }
__host__ __device__ __forceinline__ int perm32(int rho) { const int n = rho >> 4, i = rho & 15; return 8 * (i >> 2) + 4 * n + (i & 3); }

struct Unit { int pm, pn, seg; };

template <int NSEG> struct Order {
    int nM, nN, nwg, G, c;
    __device__ void init(int M, int N, int G_, int c_) { nM = M / BM; nN = N / BM; nwg = nM * nN; G = G_; c = c_; }
    __device__ bool next(int i, Unit& u) const {
        const int ti = i / NSEG; u.seg = i - ti * NSEG;
        const long L = (long)ti * G + c; if (L >= nwg) return false;
        int wgid = (int)L; { const int q = nwg / NXCD, r = nwg % NXCD, xcd = wgid % NXCD, off = wgid / NXCD; wgid = (xcd < r ? xcd * (q + 1) : r * (q + 1) + (xcd - r) * q) + off; }
        const int nig = WGM * nN, gid = wgid / nig, fm = gid * WGM, gsz = (nM - fm) < WGM ? (nM - fm) : WGM;
        u.pm = fm + ((wgid % nig) % gsz); u.pn = (wgid % nig) / gsz; return true;
    }
};
__device__ __forceinline__ unsigned long long pick3(int seg, unsigned long long v0, unsigned long long v1, unsigned long long v2) {
    const unsigned long long m1 = (unsigned long long)0 - (unsigned long long)(seg == 1), m2 = (unsigned long long)0 - (unsigned long long)(seg == 2);
    return v0 + ((v1 - v0) & m1) + ((v2 - v0) & m2);
}

template <int ACT  , bool PF = true  > struct EpiF16 {
    static constexpr bool PERM = true;
    f16* base[8]; int ld[8]; int lo[8]; int nd;
    const f16* ss;
    struct Pre { h2 pa[2][2]; };
    __device__ __forceinline__ void prefetch(Pre& p, const Unit& u, int wr, int wc, int fr, int fq) const {
        if (PF && ss) { const int row0 = u.pm * BM + wr * 64 + fr;
#pragma unroll
            for (int ai = 0; ai < 2; ++ai)
#pragma unroll
                for (int mm = 0; mm < 2; ++mm) { h2 v; v.x = ss[(size_t)(row0 + ai * HALF + (2 * mm) * 16) * 4 + fq]; v.y = ss[(size_t)(row0 + ai * HALF + (2 * mm + 1) * 16) * 4 + fq]; p.pa[ai][mm] = v; } }
    }
    __device__ __forceinline__ void operator()(f32x4 (&acc)[2][2][4][2], const Unit& u, int wr, int wc, int fr, int fq, const Pre& pre_in) const {
        Pre pre = pre_in;
        if (!PF && ss) { const int row0_ = u.pm * BM + wr * 64 + fr;
#pragma unroll
            for (int ai = 0; ai < 2; ++ai)
#pragma unroll
                for (int mm = 0; mm < 2; ++mm) { h2 v; v.x = ss[(size_t)(row0_ + ai * HALF + (2 * mm) * 16) * 4 + fq]; v.y = ss[(size_t)(row0_ + ai * HALF + (2 * mm + 1) * 16) * 4 + fq]; pre.pa[ai][mm] = v; } }
        f16* b = base[0]; int l = ld[0]; int t0 = lo[0];
#pragma unroll
        for (int i = 1; i < 8; ++i) if (i < nd && u.pn >= lo[i]) { b = base[i]; l = ld[i]; t0 = lo[i]; }
        const int row0 = u.pm * BM + wr * 64 + fr, col0 = (u.pn - t0) * BM + wc * 32 + 8 * fq;
        const int lane_ = fr + 16 * fq;
#pragma unroll
        for (int ai = 0; ai < 2; ++ai) {
            float rs[4] = {1.f, 1.f, 1.f, 1.f};
            if (ss) {
#pragma unroll
                for (int m = 0; m < 4; ++m) { float t = (m & 1) ? (float)pre.pa[ai][m >> 1].y : (float)pre.pa[ai][m >> 1].x; t += sx(t, 16, lane_); t += sx(t, 32, lane_); rs[m] = __builtin_amdgcn_rsqf(t * (1.f / 1024.f) + 1e-6f); }
            }
#pragma unroll
            for (int m = 0; m < 4; ++m) { f16* rowp = b + (size_t)(row0 + ai * HALF + m * 16) * l + col0;
#pragma unroll
                for (int bj = 0; bj < 2; ++bj) { f32x4 v0 = acc[ai][bj][m][0] * rs[m], v1 = acc[ai][bj][m][1] * rs[m];
                    if (ACT == 1) {
#pragma unroll
                        for (int j = 0; j < 4; ++j) { const float a = fmaxf(v0[j], 0.f), c = fmaxf(v1[j], 0.f); v0[j] = a * a; v1[j] = c * c; } }
                    u32x4 w; w.x = pk2h(v0[0], v0[1]); w.y = pk2h(v0[2], v0[3]); w.z = pk2h(v1[0], v1[1]); w.w = pk2h(v1[2], v1[3]);
                    *(u32x4*)(rowp + bj * HALF) = w; } }
        }
    }
};
struct EpiRes {
    static constexpr bool PERM = true;
    f16* x; f16* ssw; LAS float* comb;
    struct Pre {}; __device__ __forceinline__ void prefetch(Pre&, const Unit&, int, int, int, int) const {}
    __device__ __forceinline__ void operator()(f32x4 (&acc)[2][2][4][2], const Unit& u, int wr, int wc, int fr, int fq, const Pre&) const {
        const int row0 = u.pm * BM + wr * 64 + fr, col0 = u.pn * BM + wc * 32 + 8 * fq;
        const int lane_ = fr + 16 * fq;
        h8 rb[2][2];
#define ER_LOAD(g, s_) do { const size_t off_ = (size_t)(row0 + ((g) >> 2) * HALF + ((g) & 3) * 16) * 1024 + col0; rb[s_][0] = *(const h8*)(x + off_); rb[s_][1] = *(const h8*)(x + off_ + HALF); } while (0)
        ER_LOAD(0, 0);
#pragma unroll
        for (int g = 0; g < 8; ++g) { const int ai = g >> 2, m = g & 3, sl = g & 1;
            if (g + 1 < 8) ER_LOAD(g + 1, sl ^ 1);
            asm volatile("" ::: "memory");
            const size_t off = (size_t)(row0 + ai * HALF + m * 16) * 1024 + col0; float sq = 0.f;
#pragma unroll
            for (int bj = 0; bj < 2; ++bj) { const h8 r = rb[sl][bj]; float o[8];
#pragma unroll
                for (int j = 0; j < 4; ++j) { o[j] = (float)r[j] + acc[ai][bj][m][0][j]; o[4 + j] = (float)r[4 + j] + acc[ai][bj][m][1][j]; }
                u32x4 w; w.x = pk2h(o[0], o[1]); w.y = pk2h(o[2], o[3]); w.z = pk2h(o[4], o[5]); w.w = pk2h(o[6], o[7]); *(u32x4*)(x + off + bj * HALF) = w;
                if (ssw) sq += ((o[0] * o[0] + o[1] * o[1]) + (o[2] * o[2] + o[3] * o[3])) + ((o[4] * o[4] + o[5] * o[5]) + (o[6] * o[6] + o[7] * o[7])); }
            if (ssw) { sq += sx(sq, 16, lane_); sq += sx(sq, 32, lane_); if (fq == 0) comb[(wr * 64 + ai * HALF + m * 16 + fr) * 4 + wc] = sq; }
        }
#undef ER_LOAD
        if (ssw) {
            asm volatile("s_waitcnt lgkmcnt(0)" ::: "memory"); __builtin_amdgcn_s_barrier(); asm volatile("" ::: "memory");
            const int wid_ = wr * 4 + wc;
            if (lane_ < 32) { const int r = wid_ * 32 + lane_; const f32x4 p = *(const LAS f32x4*)(comb + r * 4); ssw[(size_t)(u.pm * BM + r) * 4 + u.pn] = (f16)((p.x + p.y) + (p.z + p.w)); }
        }
    }
};
struct EpiMerge {
    static constexpr bool PERM = true;
    const f16* gates; f16* out;
    struct Pre {}; __device__ __forceinline__ void prefetch(Pre&, const Unit&, int, int, int, int) const {}
    __device__ __forceinline__ void operator()(f32x4 (&acc)[2][2][4][2], const Unit& u, int wr, int wc, int fr, int fq, const Pre&) const {
        const int row0 = u.pm * BM + wr * 64 + fr, col0 = u.pn * BM + wc * 32 + 8 * fq;
        const int ga = (u.seg == 0 ? 0 : (u.seg == 1 ? 1024 : 2048)), gb = (u.seg == 0 ? 1024 : 2048);
        h8 xa[2][2], xb[2][2];
#define EM_LOAD(g, s_) do { const f16* gp_ = gates + (size_t)(row0 + ((g) >> 2) * HALF + ((g) & 3) * 16) * 3072 + col0; \
            xa[s_][0] = *(const h8*)(gp_ + ga); xa[s_][1] = *(const h8*)(gp_ + ga + HALF); xb[s_][0] = *(const h8*)(gp_ + gb); xb[s_][1] = *(const h8*)(gp_ + gb + HALF); } while (0)
        EM_LOAD(0, 0);
#pragma unroll
        for (int g = 0; g < 8; ++g) { const int ai = g >> 2, m = g & 3, sl = g & 1;
            if (g + 1 < 8) EM_LOAD(g + 1, sl ^ 1);
            asm volatile("" ::: "memory");
            const int row = row0 + ai * HALF + m * 16;
#pragma unroll
            for (int bj = 0; bj < 2; ++bj) {
                float f[8];
                if (u.seg < 2) {
#pragma unroll
                    for (int j = 0; j < 8; ++j) { const float a = fminf(fmaxf((float)xa[sl][bj][j], -30.f), 30.f), b = fminf(fmaxf((float)xb[sl][bj][j], -30.f), 30.f);
                        f[j] = (1.f + __expf(-b)) * __builtin_amdgcn_rcpf(1.f + __expf(-a)); }
                } else {
#pragma unroll
                    for (int j = 0; j < 8; ++j) { const float a = fminf(fmaxf((float)xa[sl][bj][j], -30.f), 30.f); f[j] = __builtin_amdgcn_rcpf(1.f + __expf(-a)); }
                }
                f32x4 v0 = acc[ai][bj][m][0], v1 = acc[ai][bj][m][1];
#pragma unroll
                for (int j = 0; j < 4; ++j) { v0[j] *= f[j]; v1[j] *= f[4 + j]; }
                if (u.seg < 2) { acc[ai][bj][m][0] = v0; acc[ai][bj][m][1] = v1; }
                else { u32x4 w; w.x = pk2h(v0[0], v0[1]); w.y = pk2h(v0[2], v0[3]); w.z = pk2h(v1[0], v1[1]); w.w = pk2h(v1[2], v1[3]);
                    *(u32x4*)(out + (size_t)row * 1024 + col0 + bj * HALF) = w; } }
        }
#undef EM_LOAD
    }
};

template <class Epi, int NSEG, bool ALIGN_EPI, bool SP2>
__device__ __forceinline__ void gemm_phase(LAS unsigned char* lds, const f16* gA0, const f16* gA1, const f16* gA2, const f16* gB0, const f16* gB1, const f16* gB2,
                                           const int gK0, const int gK1, const int gK2, const int g_lda, const int g_ldb, const Order<NSEG>& S, const Epi& E, const int wave_in) {
    const unsigned long long uA0 = (unsigned long long)gA0, uA1 = (unsigned long long)gA1, uA2 = (unsigned long long)gA2, uB0 = (unsigned long long)gB0, uB1 = (unsigned long long)gB1, uB2 = (unsigned long long)gB2;
#define SEG_A(u) ((const char*)(NSEG > 1 ? pick3((u).seg, uA0, uA1, uA2) : uA0) + (size_t)(u).pm * (size_t)(BM * 2) * g_lda)
#define SEG_B(u) ((const char*)(NSEG > 1 ? pick3((u).seg, uB0, uB1, uB2) : uB0) + (size_t)(u).pn * (size_t)(BM * 2) * g_ldb)
#define SEG_K(u) (NSEG > 1 ? (int)pick3((u).seg, (unsigned long long)gK0, (unsigned long long)gK1, (unsigned long long)gK2) : gK0)
    const int tid_ = tid_of(wave_in);
    const int tid = tid_, wid = __builtin_amdgcn_readfirstlane(tid >> 6), lane = tid & 63, wr = wid >> 2, wc = wid & 3, fr = lane & 15, fq = lane >> 4;
    unsigned voffA[2], voffB[2];
#pragma unroll
    for (int i = 0; i < 2; ++i) { int R, C; stage_rc(tid * 16 + i * 8192, R, C); const int Rb = Epi::PERM ? ((R & ~31) + perm32(R & 31)) : R;
        voffA[i] = (unsigned)(R * g_lda + C) * 2u; voffB[i] = (unsigned)(Rb * g_ldb + C) * 2u; }
    const size_t kstep = (size_t)(BK * 2);
    const size_t hstepA = (size_t)HALF * g_lda * 2, hstepB = (size_t)HALF * g_ldb * 2;
    const unsigned ldsw = (unsigned)wid * 1024u;
    const int aoff = lds_byte(wr * 64 + fr, fq * 8), boff = lds_byte(wc * 32 + fr, fq * 8);
#define PG8_SA(b, h) (((b) * 2 + (h)) * HTB)
#define PG8_SB(b, h) ((4 + (b) * 2 + (h)) * HTB)
#define PG8_STAGE(bufoff, gbase, voff) do { _Pragma("unroll") for (int _i = 0; _i < 2; ++_i) \
        __builtin_amdgcn_global_load_lds((const unsigned*)((const char*)(gbase) + (voff)[_i]), (LAS unsigned*)(lds + (bufoff) + ldsw + _i * 8192), 16, 0, 0); } while (0)
#define PG8_LDA(dst, b, h) do { _Pragma("unroll") for (int m = 0; m < 4; ++m) _Pragma("unroll") for (int k = 0; k < 2; ++k) dst[m][k] = *(const LAS h8*)(lds + PG8_SA(b, h) + aoff + m * 2048 + k * 1024); } while (0)
#define PG8_LDB(dst, b, h) do { _Pragma("unroll") for (int n = 0; n < 2; ++n) _Pragma("unroll") for (int k = 0; k < 2; ++k) dst[n][k] = *(const LAS h8*)(lds + PG8_SB(b, h) + boff + n * 2048 + k * 1024); } while (0)
#define PG8_MMA(ai, bj, At, Bt) do { __builtin_amdgcn_s_setprio(1); _Pragma("unroll") for (int m = 0; m < 4; ++m) _Pragma("unroll") for (int n = 0; n < 2; ++n) _Pragma("unroll") for (int k = 0; k < 2; ++k) \
        acc[ai][bj][m][n] = __builtin_amdgcn_mfma_f32_16x16x32_f16(Bt[n][k], At[m][k], acc[ai][bj][m][n], 0, 0, 0); __builtin_amdgcn_s_setprio(0); } while (0)
#define PG8_WAIT_V(n) asm volatile("s_waitcnt vmcnt(" #n ")" ::: "memory")
#define PG8_WAIT_L(n) asm volatile("s_waitcnt lgkmcnt(" #n ")" ::: "memory")
#define PG8_BAR __builtin_amdgcn_s_barrier()
#define PG8_SCHED __builtin_amdgcn_sched_barrier(0)
    Unit cur, nxt; int ui = 0;
    if (!S.next(0, cur)) return;
    f32x4 acc[2][2][4][2];
#pragma unroll
    for (int a = 0; a < 2; ++a)
#pragma unroll
        for (int b = 0; b < 2; ++b)
#pragma unroll
            for (int m = 0; m < 4; ++m)
#pragma unroll
                for (int n = 0; n < 2; ++n) acc[a][b][m][n] = (f32x4){0.f, 0.f, 0.f, 0.f};
    h8 At[4][2], B0[2][2], B1[2][2];
    typename Epi::Pre pre;
    const char* cA = SEG_A(cur); const char* cB = SEG_B(cur);
    if constexpr (SP2) {
        PG8_STAGE(PG8_SB(0, 0), cB, voffB); PG8_STAGE(PG8_SB(0, 1), cB + hstepB, voffB); PG8_STAGE(PG8_SA(0, 0), cA, voffA); PG8_STAGE(PG8_SA(0, 1), cA + hstepA, voffA);
        if (wr == 1) PG8_BAR;
        PG8_WAIT_V(2); PG8_BAR;
        PG8_STAGE(PG8_SB(1, 0), cB + kstep, voffB); PG8_STAGE(PG8_SA(1, 0), cA + kstep, voffA); PG8_STAGE(PG8_SB(1, 1), cB + hstepB + kstep, voffB);
        PG8_WAIT_V(6); PG8_BAR;
    } else {
        PG8_STAGE(PG8_SB(0, 0), cB, voffB); PG8_STAGE(PG8_SA(0, 0), cA, voffA); PG8_STAGE(PG8_SB(0, 1), cB + hstepB, voffB); PG8_STAGE(PG8_SA(0, 1), cA + hstepA, voffA);
        if (wr == 1) PG8_BAR;
        PG8_WAIT_V(4); PG8_BAR;
        PG8_STAGE(PG8_SB(1, 0), cB + kstep, voffB); PG8_STAGE(PG8_SA(1, 0), cA + kstep, voffA); PG8_STAGE(PG8_SB(1, 1), cB + hstepB + kstep, voffB);
        PG8_WAIT_V(6); PG8_BAR;
    }
    for (;;) {
        const bool has_next = S.next(ui + 1, nxt);
        const int nt = SEG_K(cur) / BK;
        E.prefetch(pre, cur, wr, wc, fr, fq);
        const char* nA = has_next ? SEG_A(nxt) : cA; const char* nB = has_next ? SEG_B(nxt) : cB;
#pragma unroll 1
        for (int t = 0; t < nt; t += 2) {
            const bool last = (t == nt - 2);
            const char* a1 = cA + (size_t)(t + 1) * kstep;
            const char* a2 = last ? nA : cA + (size_t)(t + 2) * kstep; const char* b2 = last ? nB : cB + (size_t)(t + 2) * kstep;
            const char* a3 = a2 + kstep; const char* b3 = b2 + kstep;
            if constexpr (SP2) {
            PG8_LDB(B0, 0, 0); PG8_LDB(B1, 0, 1); PG8_SCHED; PG8_LDA(At, 0, 0); PG8_STAGE(PG8_SA(1, 1), a1 + hstepA, voffA);
            PG8_WAIT_V(8); PG8_WAIT_L(0); PG8_BAR; PG8_MMA(0, 0, At, B0); PG8_MMA(0, 1, At, B1); PG8_BAR; PG8_SCHED;
            PG8_LDA(At, 0, 1); PG8_STAGE(PG8_SB(0, 0), b2, voffB); PG8_STAGE(PG8_SB(0, 1), b2 + hstepB, voffB); PG8_STAGE(PG8_SA(0, 0), a2, voffA);
            PG8_WAIT_V(8); PG8_WAIT_L(0); PG8_BAR; PG8_MMA(1, 0, At, B0); PG8_MMA(1, 1, At, B1); PG8_BAR; PG8_SCHED;
            PG8_LDB(B0, 1, 0); PG8_LDB(B1, 1, 1); PG8_SCHED; PG8_LDA(At, 1, 0); PG8_STAGE(PG8_SA(0, 1), a2 + hstepA, voffA);
            PG8_WAIT_V(8); PG8_WAIT_L(0); PG8_BAR; PG8_MMA(0, 0, At, B0); PG8_MMA(0, 1, At, B1); PG8_BAR; PG8_SCHED;
            PG8_LDA(At, 1, 1); PG8_STAGE(PG8_SB(1, 0), b3, voffB); PG8_STAGE(PG8_SB(1, 1), b3 + hstepB, voffB); PG8_STAGE(PG8_SA(1, 0), a3, voffA);
            PG8_WAIT_V(8); PG8_WAIT_L(0); PG8_BAR; PG8_MMA(1, 0, At, B0); PG8_MMA(1, 1, At, B1); PG8_BAR; PG8_SCHED;
            } else {
            PG8_LDB(B0, 0, 0); PG8_SCHED; PG8_LDA(At, 0, 0); PG8_STAGE(PG8_SA(1, 1), a1 + hstepA, voffA);
            PG8_WAIT_L(8); PG8_BAR; PG8_WAIT_L(0); PG8_MMA(0, 0, At, B0); PG8_BAR; PG8_SCHED;
            PG8_LDB(B1, 0, 1); PG8_STAGE(PG8_SB(0, 0), b2, voffB);
            PG8_BAR; PG8_WAIT_L(0); PG8_MMA(0, 1, At, B1); PG8_BAR;
            PG8_LDA(At, 0, 1); PG8_STAGE(PG8_SA(0, 0), a2, voffA);
            PG8_BAR; PG8_WAIT_L(0); PG8_MMA(1, 0, At, B0); PG8_BAR; PG8_SCHED;
            PG8_STAGE(PG8_SB(0, 1), b2 + hstepB, voffB);
            PG8_WAIT_V(6); PG8_BAR; PG8_MMA(1, 1, At, B1); PG8_BAR;
            PG8_LDB(B0, 1, 0); PG8_SCHED; PG8_LDA(At, 1, 0); PG8_STAGE(PG8_SA(0, 1), a2 + hstepA, voffA);
            PG8_WAIT_L(8); PG8_BAR; PG8_WAIT_L(0); PG8_MMA(0, 0, At, B0); PG8_BAR; PG8_SCHED;
            PG8_LDB(B1, 1, 1); PG8_STAGE(PG8_SB(1, 0), b3, voffB);
            PG8_BAR; PG8_WAIT_L(0); PG8_MMA(0, 1, At, B1); PG8_BAR;
            PG8_LDA(At, 1, 1); PG8_STAGE(PG8_SA(1, 0), a3, voffA);
            PG8_BAR; PG8_WAIT_L(0); PG8_MMA(1, 0, At, B0); PG8_BAR; PG8_SCHED;
            PG8_STAGE(PG8_SB(1, 1), b3 + hstepB, voffB);
            PG8_WAIT_V(6); PG8_BAR; PG8_MMA(1, 1, At, B1); PG8_BAR;
            }
        }
        if constexpr (ALIGN_EPI) { if (wr == 0) PG8_BAR; }
        E(acc, cur, wr, wc, fr, fq, pre);
        if (!has_next) break;
        if (NSEG == 1 || cur.seg == NSEG - 1) {
#pragma unroll
        for (int a = 0; a < 2; ++a)
#pragma unroll
            for (int b = 0; b < 2; ++b)
#pragma unroll
                for (int m = 0; m < 4; ++m)
#pragma unroll
                    for (int n = 0; n < 2; ++n) acc[a][b][m][n] = (f32x4){0.f, 0.f, 0.f, 0.f};
        }
        cur = nxt; cA = nA; cB = nB; ++ui;
        if constexpr (ALIGN_EPI) { if (wr == 1) PG8_BAR; }
    }
    PG8_WAIT_V(0);
    if constexpr (!ALIGN_EPI) { if (wr == 0) PG8_BAR; }
    PG8_BAR;
#undef SEG_A
#undef SEG_B
#undef SEG_K
#undef PG8_SA
#undef PG8_SB
#undef PG8_STAGE
#undef PG8_LDA
#undef PG8_LDB
#undef PG8_MMA
#undef PG8_WAIT_V
#undef PG8_WAIT_L
#undef PG8_BAR
#undef PG8_SCHED
}
}

namespace att {
constexpr int D = 128, NW = 8, QBLK = 32, KVBLK = 64;
constexpr float THR = 8.f;
constexpr size_t SHM_V = KVBLK * D * 2, SHM_K = KVBLK * D * 2, SHM_ATTN = 2 * SHM_V + 2 * SHM_K + NW * 64 * 4;
#define KSWZ(row, colB) ((row) * 256 + ((colB) ^ (((row) & 7) << 4)))
#define SBAR() __builtin_amdgcn_sched_barrier(0)
__device__ __forceinline__ int crow(int r, int hi) { return (r & 3) + 8 * (r >> 2) + 4 * hi; }
__device__ __forceinline__ unsigned cvtpk(float lo, float hi) { return pk2h(lo, hi); }

template <int SCALE_NUM> struct ScaleC { };
__device__ __forceinline__ void partialSM(f32x16& p0, f32x16& p1, float& m_reg, float& mn, float& alpha, const float SCALE) {
  const float C = SCALE * 1.4426950408889634f;
  float pmax = p0[0];
#pragma unroll
  for (int r = 1; r < 16; ++r) pmax = fmaxf(pmax, p0[r]);
#pragma unroll
  for (int r = 0; r < 16; ++r) pmax = fmaxf(pmax, p1[r]);
  { auto rr = __builtin_amdgcn_permlane32_swap(__float_as_uint(pmax), __float_as_uint(pmax), false, false);
    pmax = fmaxf(__uint_as_float(rr[0]), __uint_as_float(rr[1])); }
  if (__builtin_expect(__all(pmax - m_reg <= THR / SCALE), 1)) { mn = m_reg; alpha = 1.f; }
  else { mn = fmaxf(m_reg, pmax); alpha = __builtin_amdgcn_exp2f((m_reg - mn) * C); m_reg = mn; }
  float mnC = -mn * C;
#pragma unroll
  for (int r = 0; r < 16; ++r) p0[r] = fmaf(p0[r], C, mnC);
#pragma unroll
  for (int r = 0; r < 16; ++r) p1[r] = fmaf(p1[r], C, mnC);
#pragma unroll
  for (int r = 0; r < 16; ++r) p0[r] = __builtin_amdgcn_exp2f(p0[r]);
}
__device__ __forceinline__ void finishSM(f32x16& p0, f32x16& p1, float alpha, float& l_reg, h8& pa0, h8& pa1, h8& pa2, h8& pa3) {
#pragma unroll
  for (int r = 0; r < 16; ++r) p1[r] = __builtin_amdgcn_exp2f(p1[r]);
  float ps = 0;
#pragma unroll
  for (int r = 0; r < 16; ++r) ps += p0[r];
#pragma unroll
  for (int r = 0; r < 16; ++r) ps += p1[r];
  { auto rr = __builtin_amdgcn_permlane32_swap(__float_as_uint(ps), __float_as_uint(ps), false, false);
    ps = __uint_as_float(rr[0]) + __uint_as_float(rr[1]); }
  l_reg = l_reg * alpha + ps;
#define PK4(P, BASE, OUT) do { unsigned a0 = cvtpk(P[BASE + 0], P[BASE + 1]), a1 = cvtpk(P[BASE + 2], P[BASE + 3]);   \
    unsigned b0 = cvtpk(P[BASE + 4], P[BASE + 5]), b1 = cvtpk(P[BASE + 6], P[BASE + 7]);                              \
    auto r0 = __builtin_amdgcn_permlane32_swap(a0, b0, false, false); auto r1 = __builtin_amdgcn_permlane32_swap(a1, b1, false, false); \
    u32x4 w = {r0[0], r1[0], r0[1], r1[1]}; OUT = __builtin_bit_cast(h8, w); } while (0)
  PK4(p0, 0, pa0); PK4(p0, 8, pa1); PK4(p1, 0, pa2); PK4(p1, 8, pa3);
#undef PK4
}
__device__ __forceinline__ void qkt(f32x16& p0, f32x16& p1, const char* Ks, const h8* qr, int r32, int hi) {
  p0 = f32x16{}; p1 = f32x16{};
#pragma unroll
  for (int d0 = 0; d0 < 8; ++d0) { int cb = (d0 * 16 + hi * 8) * 2;
    h8 b0 = *reinterpret_cast<const h8*>(Ks + KSWZ(r32, cb));
    h8 b1 = *reinterpret_cast<const h8*>(Ks + KSWZ(32 + r32, cb));
    p0 = __builtin_amdgcn_mfma_f32_32x32x16_f16(b0, qr[d0], p0, 0, 0, 0);
    p1 = __builtin_amdgcn_mfma_f32_32x32x16_f16(b1, qr[d0], p1, 0, 0, 0); }
}
__device__ __forceinline__ int v_st(int k, int c) { const int kk = (k & ~0xC) | ((k & 4) << 1) | ((k & 8) >> 1); return ((kk >> 3) * 4 + (c >> 5)) * 512 + ((kk & 7) * 32 + (c & 31)) * 2; }
__device__ __forceinline__ int v_rd_base(int lane) { return ((lane & 3) << 3) | (((lane >> 2) & 3) << 6) | (((lane >> 4) & 1) << 5) | (((lane >> 5) & 1) << 8); }
constexpr int v_rd_off(int d0, int ks, int half) { return d0 * 512 + ks * 4096 + half * 2048; }
template <int OFF> __device__ __forceinline__ h4 tr_read(int vb) {
  h4 r; asm volatile("ds_read_b64_tr_b16 %0, %1 offset:%2" : "=&v"(r) : "v"(vb), "i"(OFF) : "memory"); return r;
}
template <int D0> __device__ __forceinline__ void pv_one(f32x16& od, int vb, h8 pa0, h8 pa1, h8 pa2, h8 pa3) {
  const h4 l0 = tr_read<v_rd_off(D0, 0, 0)>(vb), h0 = tr_read<v_rd_off(D0, 0, 1)>(vb), l1 = tr_read<v_rd_off(D0, 1, 0)>(vb), h1 = tr_read<v_rd_off(D0, 1, 1)>(vb);
  const h4 l2 = tr_read<v_rd_off(D0, 2, 0)>(vb), h2_ = tr_read<v_rd_off(D0, 2, 1)>(vb), l3 = tr_read<v_rd_off(D0, 3, 0)>(vb), h3 = tr_read<v_rd_off(D0, 3, 1)>(vb);
  asm volatile("s_waitcnt lgkmcnt(0)" ::: "memory"); SBAR();
#define PK(L, H) (h8){L[0], L[1], L[2], L[3], H[0], H[1], H[2], H[3]}
  od = __builtin_amdgcn_mfma_f32_32x32x16_f16(pa0, PK(l0, h0), od, 0, 0, 0);
  od = __builtin_amdgcn_mfma_f32_32x32x16_f16(pa1, PK(l1, h1), od, 0, 0, 0);
  od = __builtin_amdgcn_mfma_f32_32x32x16_f16(pa2, PK(l2, h2_), od, 0, 0, 0);
  od = __builtin_amdgcn_mfma_f32_32x32x16_f16(pa3, PK(l3, h3), od, 0, 0, 0);
#undef PK
}
__device__ __forceinline__ void pv_d0(f32x16* o, int vb, h8 pa0, h8 pa1, h8 pa2, h8 pa3) {
  pv_one<0>(o[0], vb, pa0, pa1, pa2, pa3); pv_one<1>(o[1], vb, pa0, pa1, pa2, pa3); pv_one<2>(o[2], vb, pa0, pa1, pa2, pa3); pv_one<3>(o[3], vb, pa0, pa1, pa2, pa3);
}
template <int LDQ, int LDK, int LDO>
__device__ __forceinline__ void attn_dense_body(const f16* __restrict__ Qb, const f16* __restrict__ Kh, const f16* __restrict__ Vh, f16* Ob, int seq, char* lds, const float SCALE, const int wave_in) {
  const int tid_ = tid_of(wave_in);
  const int tid = tid_, wid = tid >> 6, lane = tid & 63, r32 = lane & 31, hi = lane >> 5;
  char* V_lds = lds; char* K_lds = lds + 2 * SHM_V;
  float* ws = (float*)(lds + 2 * SHM_V + 2 * SHM_K) + wid * 64; float* li_l = ws; float* al_l = ws + 32;
  float m_reg = -1e30f, l_reg = 0; f32x16 o[4] = {}; h8 qr[8];
  const f16* Qw = Qb + (long)(wid * QBLK + r32) * LDQ + hi * 8;
#pragma unroll
  for (int d0 = 0; d0 < 8; ++d0) qr[d0] = *reinterpret_cast<const h8*>(Qw + d0 * 16);
  const int sr = tid >> 4, sc = (tid & 15) * 8, vst0 = v_st(sr, sc), vst1 = v_st(32 + sr, sc);
  const int vb0 = (int)(uintptr_t)V_lds + v_rd_base(lane);
  struct { h8 vs0, vs1, ks0, ks1; } sr_[2];
#define SLOAD(i, k0) do { sr_[i].vs0 = *(const h8*)(&Vh[(long)((k0) + sr) * LDK + sc]); sr_[i].vs1 = *(const h8*)(&Vh[(long)((k0) + 32 + sr) * LDK + sc]); \
    sr_[i].ks0 = *(const h8*)(&Kh[(long)((k0) + sr) * LDK + sc]); sr_[i].ks1 = *(const h8*)(&Kh[(long)((k0) + 32 + sr) * LDK + sc]); } while (0)
#define SWRITE(b, i) do { *(h8*)(V_lds + (b) * SHM_V + vst0) = sr_[i].vs0;          \
    *(h8*)(V_lds + (b) * SHM_V + vst1) = sr_[i].vs1; int kc = sc * 2;               \
    *(h8*)(K_lds + (b) * SHM_K + KSWZ(sr, kc)) = sr_[i].ks0;                       \
    *(h8*)(K_lds + (b) * SHM_K + KSWZ(32 + sr, kc)) = sr_[i].ks1; } while (0)
#define SWAIT() asm volatile("s_waitcnt vmcnt(4)" ::: "memory")
#define RESC(a) do { if (__any((a) < 1.f)) { if (hi == 0) al_l[r32] = (a); asm volatile("s_waitcnt lgkmcnt(0)" ::: "memory"); \
    _Pragma("unroll") for (int d = 0; d < 4; ++d) _Pragma("unroll") for (int r = 0; r < 16; ++r) o[d][r] *= al_l[crow(r, hi)]; } } while (0)
  f32x16 pA0, pA1, pB0, pB1; float mnA, mnB, alA, alB; h8 pa0, pa1, pa2, pa3; const int NT = seq / KVBLK;
  constexpr int SE = 0, SO = 1;
  SLOAD(SE, 0); asm volatile("s_waitcnt vmcnt(0)" ::: "memory"); SWRITE(0, SE); __syncthreads();
  qkt(pA0, pA1, K_lds, qr, r32, hi); partialSM(pA0, pA1, m_reg, mnA, alA, SCALE);
  SLOAD(SO, KVBLK); if (2 < NT) SLOAD(SE, 2 * KVBLK);
  SWAIT(); SWRITE(1, SO); __syncthreads();
  for (int j = 1; j + 1 < NT; j += 2) {
    SBAR(); qkt(pB0, pB1, K_lds + SHM_K, qr, r32, hi);
    finishSM(pA0, pA1, alA, l_reg, pa0, pa1, pa2, pa3); SBAR();
    SLOAD(SO, (j + 2) * KVBLK); SBAR();
    pv_d0(o, vb0, pa0, pa1, pa2, pa3); partialSM(pB0, pB1, m_reg, mnB, alB, SCALE);
    __syncthreads(); SWAIT(); SWRITE(0, SE);
    RESC(alB); __syncthreads();
    SBAR(); qkt(pA0, pA1, K_lds, qr, r32, hi);
    finishSM(pB0, pB1, alB, l_reg, pa0, pa1, pa2, pa3); SBAR();
    if (j + 3 < NT) SLOAD(SE, (j + 3) * KVBLK); SBAR();
    pv_d0(o, vb0 + (int)SHM_V, pa0, pa1, pa2, pa3); partialSM(pA0, pA1, m_reg, mnA, alA, SCALE);
    __syncthreads(); SWAIT(); SWRITE(1, SO);
    RESC(alA); __syncthreads();
  }
  SBAR(); qkt(pB0, pB1, K_lds + SHM_K, qr, r32, hi);
  finishSM(pA0, pA1, alA, l_reg, pa0, pa1, pa2, pa3); SBAR();
  pv_d0(o, vb0, pa0, pa1, pa2, pa3); partialSM(pB0, pB1, m_reg, mnB, alB, SCALE);
  __syncthreads(); RESC(alB);
  finishSM(pB0, pB1, alB, l_reg, pa0, pa1, pa2, pa3); SBAR();
  pv_d0(o, vb0 + (int)SHM_V, pa0, pa1, pa2, pa3);
  if (hi == 0) li_l[r32] = l_reg; asm volatile("s_waitcnt lgkmcnt(0)" ::: "memory");
  float rli[16];
#pragma unroll
  for (int r = 0; r < 16; ++r) rli[r] = __builtin_amdgcn_rcpf(li_l[crow(r, hi)]);
  f16* Ow = Ob + (long)(wid * QBLK) * LDO;
#pragma unroll
  for (int r = 0; r < 16; ++r) { int orow = crow(r, hi);
#pragma unroll
    for (int d0 = 0; d0 < 4; ++d0) Ow[(long)orow * LDO + d0 * 32 + r32] = (f16)(o[d0][r] * rli[r]); }
#undef SLOAD
#undef SWRITE
#undef SWAIT
#undef RESC
}

__device__ __forceinline__ void nearbias(f32x16& p0, f32x16& p1, const LAS float* tp) {
#pragma unroll
  for (int q = 0; q < 4; ++q) {
#pragma unroll
    for (int r = 4 * q; r < 4 * q + 4; ++r) { const int c = (r & 3) + 8 * (r >> 2); p0[r] += tp[c * 8]; p1[r] += tp[(c + 32) * 8]; }
    SBAR();
  }
}
__device__ __forceinline__ void finishSM_m(f32x16& p0, f32x16& p1, float alpha, float& l_reg, h8& pa0, h8& pa1, h8& pa2, h8& pa3, const unsigned long long mw, const int hi) {
  const unsigned mlo = (unsigned)mw >> (4 * hi), mhi = (unsigned)(mw >> 32) >> (4 * hi);
  float ps = 0;
#pragma unroll
  for (int q = 0; q < 4; ++q) {
#pragma unroll
    for (int r = 4 * q; r < 4 * q + 4; ++r) { const int c = (r & 3) + 8 * (r >> 2);
      const int t0 = ((int)(mlo << (31 - c))) >> 31, t1 = ((int)(mhi << (31 - c))) >> 31;
      p0[r] = __int_as_float(__float_as_int(p0[r]) & t0); p1[r] = __int_as_float(__float_as_int(__builtin_amdgcn_exp2f(p1[r])) & t1); ps += p0[r] + p1[r]; }
    SBAR();
  }
  { auto rr = __builtin_amdgcn_permlane32_swap(__float_as_uint(ps), __float_as_uint(ps), false, false);
    ps = __uint_as_float(rr[0]) + __uint_as_float(rr[1]); }
  l_reg = l_reg * alpha + ps;
#define PK4(P, BASE, OUT) do { unsigned a0 = cvtpk(P[BASE + 0], P[BASE + 1]), a1 = cvtpk(P[BASE + 2], P[BASE + 3]);   \
    unsigned b0 = cvtpk(P[BASE + 4], P[BASE + 5]), b1 = cvtpk(P[BASE + 6], P[BASE + 7]);                              \
    auto r0 = __builtin_amdgcn_permlane32_swap(a0, b0, false, false); auto r1 = __builtin_amdgcn_permlane32_swap(a1, b1, false, false); \
    u32x4 w = {r0[0], r1[0], r0[1], r1[1]}; OUT = __builtin_bit_cast(h8, w); } while (0)
  PK4(p0, 0, pa0); PK4(p0, 8, pa1); PK4(p1, 0, pa2); PK4(p1, 8, pa3);
#undef PK4
}
__device__ __forceinline__ void dsa_attn_unit(f16* Qb, const f16* __restrict__ Kh, const unsigned long long* __restrict__ M, const int NT, const int tq0, const LAS float* tbl, char* lds, const int wave_in) {
  constexpr int LDQ = 128, LDK = 128, LDO = 128; const float SCALE = 1.f;
  __builtin_assume(NT >= 4);
  const int tid_ = tid_of(wave_in);
  const int tid = tid_, wid = tid >> 6, lane = tid & 63, r32 = lane & 31, hi = lane >> 5;
  char* V_lds = lds; char* K_lds = lds + 2 * SHM_V;
  float* ws = (float*)(lds + 2 * SHM_V + 2 * SHM_K) + wid * 64; float* li_l = ws; float* al_l = ws + 32;
  float m_reg = -1e30f, l_reg = 0; f32x16 o[4] = {}; h8 qr[8];
  const f16* Qw = Qb + (long)(wid * QBLK + r32) * LDQ + hi * 8;
#pragma unroll
  for (int d0 = 0; d0 < 8; ++d0) qr[d0] = *reinterpret_cast<const h8*>(Qw + d0 * 16);
  const int qi = wid * 4 + (r32 >> 3), head = r32 & 7, tpos = tq0 + qi;
  const unsigned long long* Mq = M + (size_t)qi * 64;
  const LAS float* tbh = tbl + (4 * hi - tpos + 320) * 8 + head;
  const int sr = tid >> 4, sc = (tid & 15) * 8, vst0 = v_st(sr, sc), vst1 = v_st(32 + sr, sc);
  const int vb0 = (int)(uintptr_t)V_lds + v_rd_base(lane);
  struct { h8 ks0, ks1; } sr_[1];
#define SLOAD(i, k0) do { sr_[i].ks0 = *(const h8*)(&Kh[(long)((k0) + sr) * LDK + sc]); sr_[i].ks1 = *(const h8*)(&Kh[(long)((k0) + 32 + sr) * LDK + sc]); } while (0)
#define SWRITE(b, i) do { *(h8*)(V_lds + (b) * SHM_V + vst0) = sr_[i].ks0; *(h8*)(V_lds + (b) * SHM_V + vst1) = sr_[i].ks1; int kc = sc * 2; \
    *(h8*)(K_lds + (b) * SHM_K + KSWZ(sr, kc)) = sr_[i].ks0; *(h8*)(K_lds + (b) * SHM_K + KSWZ(32 + sr, kc)) = sr_[i].ks1; } while (0)
#define RESC(a) do { if (__any((a) < 1.f)) { if (hi == 0) al_l[r32] = (a); asm volatile("s_waitcnt lgkmcnt(0)" ::: "memory"); \
    _Pragma("unroll") for (int d = 0; d < 4; ++d) _Pragma("unroll") for (int r = 0; r < 16; ++r) o[d][r] *= al_l[crow(r, hi)]; } } while (0)
#define NEAR(j) (64 * (j) > tq0 - 191)
  f32x16 pA0, pA1, pB0, pB1; float mnA, mnB, alA, alB; h8 pa0, pa1, pa2, pa3;
  constexpr int SE = 0, SO = 0;
  unsigned long long mA = Mq[0], mB = Mq[1];
  SLOAD(SE, 0); SWRITE(0, SE); __syncthreads();
  qkt(pA0, pA1, K_lds, qr, r32, hi); if (NEAR(0)) nearbias(pA0, pA1, tbh);
  partialSM(pA0, pA1, m_reg, mnA, alA, SCALE);
  SLOAD(SO, KVBLK);
  SWRITE(1, SO); __syncthreads();
  for (int j = 1; j + 1 < NT; j += 2) {
    SBAR(); qkt(pB0, pB1, K_lds + SHM_K, qr, r32, hi);
    finishSM_m(pA0, pA1, alA, l_reg, pa0, pa1, pa2, pa3, mA, hi); mA = Mq[j + 1]; SBAR();
    SLOAD(SE, (j + 1) * KVBLK); SBAR();
    pv_d0(o, vb0, pa0, pa1, pa2, pa3);
    if (NEAR(j)) nearbias(pB0, pB1, tbh + 512 * j);
    partialSM(pB0, pB1, m_reg, mnB, alB, SCALE);
    __syncthreads(); SWRITE(0, SE);
    RESC(alB); __syncthreads();
    SBAR(); qkt(pA0, pA1, K_lds, qr, r32, hi);
    finishSM_m(pB0, pB1, alB, l_reg, pa0, pa1, pa2, pa3, mB, hi); mB = Mq[j + 2]; SBAR();
    SLOAD(SO, (j + 2) * KVBLK); SBAR();
    pv_d0(o, vb0 + (int)SHM_V, pa0, pa1, pa2, pa3);
    if (NEAR(j + 1)) nearbias(pA0, pA1, tbh + 512 * (j + 1));
    partialSM(pA0, pA1, m_reg, mnA, alA, SCALE);
    __syncthreads(); SWRITE(1, SO);
    RESC(alA); __syncthreads();
  }
  SBAR(); qkt(pB0, pB1, K_lds + SHM_K, qr, r32, hi);
  finishSM_m(pA0, pA1, alA, l_reg, pa0, pa1, pa2, pa3, mA, hi); SBAR();
  pv_d0(o, vb0, pa0, pa1, pa2, pa3);
  if (NEAR(NT - 1)) nearbias(pB0, pB1, tbh + 512 * (NT - 1));
  partialSM(pB0, pB1, m_reg, mnB, alB, SCALE);
  __syncthreads(); RESC(alB);
  finishSM_m(pB0, pB1, alB, l_reg, pa0, pa1, pa2, pa3, mB, hi); SBAR();
  pv_d0(o, vb0 + (int)SHM_V, pa0, pa1, pa2, pa3);
  if (hi == 0) li_l[r32] = l_reg; asm volatile("s_waitcnt lgkmcnt(0)" ::: "memory");
  float rli[16];
#pragma unroll
  for (int r = 0; r < 16; ++r) rli[r] = __builtin_amdgcn_rcpf(li_l[crow(r, hi)]);
  f16* Ow = Qb + (long)(wid * QBLK) * LDO;
#pragma unroll
  for (int r = 0; r < 16; ++r) { int orow = crow(r, hi);
#pragma unroll
    for (int d0 = 0; d0 < 4; ++d0) Ow[(long)orow * LDO + d0 * 32 + r32] = (f16)(o[d0][r] * rli[r]); }
#undef SLOAD
#undef SWRITE
#undef RESC
#undef NEAR
}

__device__ __forceinline__ unsigned off_b(unsigned row, unsigned ch) { return 256u * row + 16u * (ch ^ (((row & 3u) << 2) | ((row >> 2) & 3u))); }
template <int OFF> __device__ __forceinline__ h4 tr_read_o(unsigned vb) { h4 r; asm volatile("ds_read_b64_tr_b16 %0, %1 offset:%2" : "=&v"(r) : "v"(vb), "i"(OFF) : "memory"); return r; }
constexpr int GW_TILE = 16384, GW_ULIST = 2176, GW_QM = 544, GW_SCR = 256, GW_BYTES = GW_TILE + GW_ULIST + GW_QM + GW_SCR;
template <int C> __device__ __forceinline__ void pv_gw(f32x16& od, const unsigned (&tva)[2][4], h8 pa0, h8 pa1, h8 pa2, h8 pa3) {
  const h4 a0 = tr_read_o<0>(tva[0][C]), a1 = tr_read_o<0>(tva[1][C]), b0 = tr_read_o<4096>(tva[0][C]), b1 = tr_read_o<4096>(tva[1][C]);
  const h4 c0 = tr_read_o<8192>(tva[0][C]), c1 = tr_read_o<8192>(tva[1][C]), d0 = tr_read_o<12288>(tva[0][C]), d1 = tr_read_o<12288>(tva[1][C]);
  asm volatile("s_waitcnt lgkmcnt(0)" ::: "memory"); SBAR();
#define PK(L, H) (h8){L[0], L[1], L[2], L[3], H[0], H[1], H[2], H[3]}
  od = __builtin_amdgcn_mfma_f32_32x32x16_f16(pa0, PK(a0, a1), od, 0, 0, 0);
  od = __builtin_amdgcn_mfma_f32_32x32x16_f16(pa1, PK(b0, b1), od, 0, 0, 0);
  od = __builtin_amdgcn_mfma_f32_32x32x16_f16(pa2, PK(c0, c1), od, 0, 0, 0);
  od = __builtin_amdgcn_mfma_f32_32x32x16_f16(pa3, PK(d0, d1), od, 0, 0, 0);
#undef PK
}
__device__ __forceinline__ void dsa_attn_wave(f16* Qw, const f16* __restrict__ Kb, const unsigned long long* __restrict__ Mw, const int nw, const int tpos0, const LAS float* tbl, LAS unsigned char* wl, const int lane) {
  const int r32 = lane & 31, hi = lane >> 5;
  LAS unsigned char* tile = wl; LAS unsigned short* ulist = (LAS unsigned short*)(wl + GW_TILE); LAS unsigned* qm = (LAS unsigned*)(wl + GW_TILE + GW_ULIST);
  LAS float* al_l = (LAS float*)(wl + GW_TILE + GW_ULIST + GW_QM); LAS float* li_l = al_l + 32;
  h8 qr[8]; { const f16* Qp = Qw + (long)r32 * 128 + hi * 8;
#pragma unroll
    for (int d0 = 0; d0 < 8; ++d0) qr[d0] = *reinterpret_cast<const h8*>(Qp + d0 * 16); }
  const int qi = r32 >> 3, head = r32 & 7, tpos = tpos0 + qi;
  unsigned long long m0 = 0ull, m1 = 0ull, m2 = 0ull, m3 = 0ull;
  if (lane < nw) { m0 = Mw[lane]; m1 = Mw[64 + lane]; m2 = Mw[128 + lane]; m3 = Mw[192 + lane]; }
  unsigned long long u = (m0 | m1) | (m2 | m3);
  const int cnt = __popcll(u), incl = wave_incl_scan(cnt); int pos = incl - cnt; const int U = __builtin_amdgcn_readlane(incl, 63);
  qm[lane] = 0u; qm[lane + 64] = 0u; if (lane < 8) qm[lane + 128] = 0u;
  asm volatile("s_waitcnt lgkmcnt(0)" ::: "memory");
  while (u) { const int b = __builtin_ctzll(u); u &= u - 1ull; ulist[pos] = (unsigned short)(64 * lane + b); const unsigned bit = 1u << (pos & 31); const int w = pos >> 5;
    if ((m0 >> b) & 1ull) __hip_atomic_fetch_or(qm + w, bit, __ATOMIC_RELAXED, __HIP_MEMORY_SCOPE_WORKGROUP);
    if ((m1 >> b) & 1ull) __hip_atomic_fetch_or(qm + 34 + w, bit, __ATOMIC_RELAXED, __HIP_MEMORY_SCOPE_WORKGROUP);
    if ((m2 >> b) & 1ull) __hip_atomic_fetch_or(qm + 68 + w, bit, __ATOMIC_RELAXED, __HIP_MEMORY_SCOPE_WORKGROUP);
    if ((m3 >> b) & 1ull) __hip_atomic_fetch_or(qm + 102 + w, bit, __ATOMIC_RELAXED, __HIP_MEMORY_SCOPE_WORKGROUP);
    ++pos; }
  const int NTu = (U + 63) >> 6;
  if (U + lane < 64 * NTu) ulist[U + lane] = 0;
  asm volatile("s_waitcnt lgkmcnt(0)" ::: "memory");
  const unsigned tb_ = (unsigned)(uintptr_t)tile;
  unsigned ka[8];
#pragma unroll
  for (int d0 = 0; d0 < 8; ++d0) ka[d0] = off_b((unsigned)r32, (unsigned)(2 * d0 + hi));
  unsigned tva[2][4]; { const unsigned blk = (lane >> 4) & 1, q = (lane & 15) >> 2, p = lane & 3;
#pragma unroll
    for (int t_ = 0; t_ < 2; ++t_)
#pragma unroll
      for (int c = 0; c < 4; ++c) tva[t_][c] = tb_ + off_b(8u * hi + 4u * t_ + q, 4u * c + 2u * blk + (p >> 1)) + 8u * (p & 1); }
  const int srow = lane >> 4, sch = lane & 15;
#define GW_DMA(t) do { _Pragma("unroll") for (int i_ = 0; i_ < 16; ++i_) { const int key_ = ulist[64 * (t) + 4 * i_ + srow]; const int ch_ = sch ^ ((srow << 2) | (i_ & 3)); \
      __builtin_amdgcn_global_load_lds((const unsigned*)(Kb + (size_t)key_ * 128 + 8 * ch_), (LAS unsigned*)(tile + (i_ >> 3) * 8192 + 1024 * (i_ & 7)), 16, 0, 0); } } while (0)
  float m_reg = -1e30f, l_reg = 0.f; f32x16 o[4] = {};
  GW_DMA(0);
#pragma unroll 1
  for (int t = 0; t < NTu; ++t) {
    asm volatile("s_waitcnt vmcnt(0)" ::: "memory");
    f32x16 p0 = f32x16{}, p1 = f32x16{};
#pragma unroll
    for (int d0 = 0; d0 < 8; ++d0) { const h8 b0 = *(const LAS h8*)(tile + ka[d0]), b1 = *(const LAS h8*)(tile + 8192 + ka[d0]);
      p0 = __builtin_amdgcn_mfma_f32_32x32x16_f16(b0, qr[d0], p0, 0, 0, 0); p1 = __builtin_amdgcn_mfma_f32_32x32x16_f16(b1, qr[d0], p1, 0, 0, 0); }
    const int klast = __builtin_amdgcn_readfirstlane((int)ulist[(64 * t + 63 < U) ? 64 * t + 63 : U - 1]);
    if (klast > tpos0 - 128) {
      const LAS unsigned short* kp = ulist + 64 * t + 4 * hi;
#pragma unroll
      for (int q4 = 0; q4 < 4; ++q4) {
#pragma unroll
        for (int r = 4 * q4; r < 4 * q4 + 4; ++r) { const int c = (r & 3) + 8 * (r >> 2); int i0 = (int)kp[c] - tpos + 128, i1 = (int)kp[c + 32] - tpos + 128;
          i0 = i0 < 0 ? 0 : (i0 > 255 ? 255 : i0); i1 = i1 < 0 ? 0 : (i1 > 255 ? 255 : i1); p0[r] += tbl[i0 * 8 + head]; p1[r] += tbl[i1 * 8 + head]; }
        SBAR(); }
    }
    float mn, alpha; partialSM(p0, p1, m_reg, mn, alpha, 1.f);
    if (__any(alpha < 1.f)) { if (hi == 0) al_l[r32] = alpha; asm volatile("s_waitcnt lgkmcnt(0)" ::: "memory");
#pragma unroll
      for (int d = 0; d < 4; ++d)
#pragma unroll
        for (int r = 0; r < 16; ++r) o[d][r] *= al_l[crow(r, hi)]; }
    const u32x2 mwv = *(const LAS u32x2*)(qm + qi * 34 + 2 * t);
    h8 pa0, pa1, pa2, pa3;
    finishSM_m(p0, p1, alpha, l_reg, pa0, pa1, pa2, pa3, ((unsigned long long)mwv.y << 32) | mwv.x, hi);
    pv_gw<0>(o[0], tva, pa0, pa1, pa2, pa3); pv_gw<1>(o[1], tva, pa0, pa1, pa2, pa3); pv_gw<2>(o[2], tva, pa0, pa1, pa2, pa3); pv_gw<3>(o[3], tva, pa0, pa1, pa2, pa3);
    asm volatile("s_waitcnt lgkmcnt(0)" ::: "memory");
    if (t + 1 < NTu) GW_DMA(t + 1);
  }
#undef GW_DMA
  if (hi == 0) li_l[r32] = l_reg; asm volatile("s_waitcnt lgkmcnt(0)" ::: "memory");
  float rli[16];
#pragma unroll
  for (int r = 0; r < 16; ++r) rli[r] = __builtin_amdgcn_rcpf(li_l[crow(r, hi)]);
#pragma unroll
  for (int r = 0; r < 16; ++r) { const int orow = crow(r, hi);
#pragma unroll
    for (int d0 = 0; d0 < 4; ++d0) Qw[(long)orow * 128 + d0 * 32 + r32] = (f16)(o[d0][r] * rli[r]); }
}

__device__ __forceinline__ void partialSM32(f32x16& p0, float& m_reg, float& mn, float& alpha) {
  constexpr float C = 1.4426950408889634f;
  float pmax = p0[0];
#pragma unroll
  for (int r = 1; r < 16; ++r) pmax = fmaxf(pmax, p0[r]);
  { auto rr = __builtin_amdgcn_permlane32_swap(__float_as_uint(pmax), __float_as_uint(pmax), false, false);
    pmax = fmaxf(__uint_as_float(rr[0]), __uint_as_float(rr[1])); }
  if (__builtin_expect(__all(pmax - m_reg <= THR), 1)) { mn = m_reg; alpha = 1.f; }
  else { mn = fmaxf(m_reg, pmax); alpha = __builtin_amdgcn_exp2f((m_reg - mn) * C); m_reg = mn; }
  const float mnC = -mn * C;
#pragma unroll
  for (int r = 0; r < 16; ++r) p0[r] = __builtin_amdgcn_exp2f(fmaf(p0[r], C, mnC));
}
__device__ __forceinline__ void finishSM32_m(f32x16& p0, float alpha, float& l_reg, h8& pa0, h8& pa1, const unsigned mw, const int hi) {
  const unsigned mlo = mw >> (4 * hi);
  float ps = 0;
#pragma unroll
  for (int r = 0; r < 16; ++r) { const int c = (r & 3) + 8 * (r >> 2); const int t0 = ((int)(mlo << (31 - c))) >> 31; p0[r] = __int_as_float(__float_as_int(p0[r]) & t0); ps += p0[r]; }
  { auto rr = __builtin_amdgcn_permlane32_swap(__float_as_uint(ps), __float_as_uint(ps), false, false);
    ps = __uint_as_float(rr[0]) + __uint_as_float(rr[1]); }
  l_reg = l_reg * alpha + ps;
#define PK4(P, BASE, OUT) do { unsigned a0 = cvtpk(P[BASE + 0], P[BASE + 1]), a1 = cvtpk(P[BASE + 2], P[BASE + 3]);   \
    unsigned b0 = cvtpk(P[BASE + 4], P[BASE + 5]), b1 = cvtpk(P[BASE + 6], P[BASE + 7]);                              \
    auto r0 = __builtin_amdgcn_permlane32_swap(a0, b0, false, false); auto r1 = __builtin_amdgcn_permlane32_swap(a1, b1, false, false); \
    u32x4 w = {r0[0], r1[0], r0[1], r1[1]}; OUT = __builtin_bit_cast(h8, w); } while (0)
  PK4(p0, 0, pa0); PK4(p0, 8, pa1);
#undef PK4
}
template <int C, int BO> __device__ __forceinline__ void pv_gw32(f32x16& od, const unsigned (&tvb)[2][4], h8 pa0, h8 pa1) {
  const h4 a0 = tr_read_o<BO>(tvb[0][C]), a1 = tr_read_o<BO>(tvb[1][C]), b0 = tr_read_o<BO + 4096>(tvb[0][C]), b1 = tr_read_o<BO + 4096>(tvb[1][C]);
  asm volatile("s_waitcnt lgkmcnt(0)" ::: "memory"); SBAR();
#define PK(L, H) (h8){L[0], L[1], L[2], L[3], H[0], H[1], H[2], H[3]}
  od = __builtin_amdgcn_mfma_f32_32x32x16_f16(pa0, PK(a0, a1), od, 0, 0, 0);
  od = __builtin_amdgcn_mfma_f32_32x32x16_f16(pa1, PK(b0, b1), od, 0, 0, 0);
#undef PK
}
#ifndef ATT_PROBE_SEC
#define ATT_PROBE_SEC 0
#endif
#define AT_MARK(sec) do { if (ATT_PROBE_SEC) { const unsigned long long t_ = __builtin_amdgcn_s_memrealtime(); if (ATT_PROBE_SEC == (sec)) at_acc += t_ - at_t; at_t = t_; } } while (0)
__device__ __forceinline__ unsigned long long dsa_attn_wave32(f16* Qw, const f16* __restrict__ Kb, const unsigned long long* __restrict__ Mw, const int nw, const int tpos0, const LAS float* tbl, LAS unsigned char* wl, const int lane) {
  unsigned long long at_acc = 0ull, at_t = ATT_PROBE_SEC ? __builtin_amdgcn_s_memrealtime() : 0ull;
  const int r32 = lane & 31, hi = lane >> 5;
  LAS unsigned char* tile = wl; LAS unsigned short* ulist = (LAS unsigned short*)(wl + GW_TILE); LAS unsigned* qm = (LAS unsigned*)(wl + GW_TILE + GW_ULIST);
  LAS float* al_l = (LAS float*)(wl + GW_TILE + GW_ULIST + GW_QM); LAS float* li_l = al_l + 32;
  h8 qr[8]; { const f16* Qp = Qw + (long)r32 * 128 + hi * 8;
#pragma unroll
    for (int d0 = 0; d0 < 8; ++d0) qr[d0] = *reinterpret_cast<const h8*>(Qp + d0 * 16); }
  const int qi = r32 >> 3, head = r32 & 7, tpos = tpos0 + qi;
  unsigned long long m0 = 0ull, m1 = 0ull, m2 = 0ull, m3 = 0ull;
  if (lane < nw) { m0 = Mw[lane]; m1 = Mw[64 + lane]; m2 = Mw[128 + lane]; m3 = Mw[192 + lane]; }
  unsigned long long u = (m0 | m1) | (m2 | m3);
  const int cnt = __popcll(u), incl = wave_incl_scan(cnt); int pos = incl - cnt; const int U = __builtin_amdgcn_readlane(incl, 63);
  qm[lane] = 0u; qm[lane + 64] = 0u; if (lane < 8) qm[lane + 128] = 0u;
  asm volatile("s_waitcnt lgkmcnt(0)" ::: "memory");
  while (u) { const int b = __builtin_ctzll(u); u &= u - 1ull; ulist[pos] = (unsigned short)(64 * lane + b); const unsigned bit = 1u << (pos & 31); const int w = pos >> 5;
    if ((m0 >> b) & 1ull) __hip_atomic_fetch_or(qm + w, bit, __ATOMIC_RELAXED, __HIP_MEMORY_SCOPE_WORKGROUP);
    if ((m1 >> b) & 1ull) __hip_atomic_fetch_or(qm + 34 + w, bit, __ATOMIC_RELAXED, __HIP_MEMORY_SCOPE_WORKGROUP);
    if ((m2 >> b) & 1ull) __hip_atomic_fetch_or(qm + 68 + w, bit, __ATOMIC_RELAXED, __HIP_MEMORY_SCOPE_WORKGROUP);
    if ((m3 >> b) & 1ull) __hip_atomic_fetch_or(qm + 102 + w, bit, __ATOMIC_RELAXED, __HIP_MEMORY_SCOPE_WORKGROUP);
    ++pos; }
  const int NT = (U + 31) >> 5;
  if (lane < 32 && U + lane < 32 * NT) ulist[U + lane] = 0;
  asm volatile("s_waitcnt lgkmcnt(0)" ::: "memory");
  AT_MARK(1);
  const unsigned tb_ = (unsigned)(uintptr_t)tile;
  unsigned ka[8];
#pragma unroll
  for (int d0 = 0; d0 < 8; ++d0) ka[d0] = off_b((unsigned)r32, (unsigned)(2 * d0 + hi));
  unsigned tva[2][4]; { const unsigned blk = (lane >> 4) & 1, q = (lane & 15) >> 2, p = lane & 3;
#pragma unroll
    for (int t_ = 0; t_ < 2; ++t_)
#pragma unroll
      for (int c = 0; c < 4; ++c) tva[t_][c] = tb_ + off_b(8u * hi + 4u * t_ + q, 4u * c + 2u * blk + (p >> 1)) + 8u * (p & 1); }
  const int srow = lane >> 4, sch = lane & 15;
  const unsigned chx = (unsigned)(sch ^ (srow << 2)) * 16u;
#define GW_DMA32(t, bo_) do { _Pragma("unroll") for (int i_ = 0; i_ < 8; ++i_) { const unsigned key_ = ulist[32 * (t) + 4 * i_ + srow]; \
      __builtin_amdgcn_global_load_lds((const unsigned*)((const char*)Kb + (key_ * 256u + (chx ^ (unsigned)((i_ & 3) * 16)))), (LAS unsigned*)(tile + (bo_) + 1024 * i_), 16, 0, 0); } } while (0)
  float m_reg = -1e30f, l_reg = 0.f; f32x16 o[4] = {};
  GW_DMA32(0, 0);
#define GW_STEP(targ_, BO) do { const int t = (targ_); \
    AT_MARK(3); \
    if (t + 1 < NT) { GW_DMA32(t + 1, 8192 - BO); AT_MARK(4); asm volatile("s_waitcnt vmcnt(8)" ::: "memory"); } \
    else asm volatile("s_waitcnt vmcnt(0)" ::: "memory"); \
    AT_MARK(2); \
    f32x16 p0 = f32x16{}; \
_Pragma("unroll") \
    for (int d0 = 0; d0 < 8; ++d0) { const h8 b0 = *(const LAS h8*)(tile + BO + ka[d0]); p0 = __builtin_amdgcn_mfma_f32_32x32x16_f16(b0, qr[d0], p0, 0, 0, 0); } \
    const int klast = __builtin_amdgcn_readfirstlane((int)ulist[(32 * t + 31 < U) ? 32 * t + 31 : U - 1]); \
    if (klast > tpos0 - 128) { \
      const LAS unsigned short* kp = ulist + 32 * t + 4 * hi; \
_Pragma("unroll") \
      for (int q4 = 0; q4 < 4; ++q4) { \
_Pragma("unroll") \
        for (int r = 4 * q4; r < 4 * q4 + 4; ++r) { const int c = (r & 3) + 8 * (r >> 2); int i0 = (int)kp[c] - tpos + 128; i0 = i0 < 0 ? 0 : (i0 > 255 ? 255 : i0); p0[r] += tbl[i0 * 8 + head]; } \
        SBAR(); } \
    } \
    float mn, alpha; partialSM32(p0, m_reg, mn, alpha); \
    if (__any(alpha < 1.f)) { if (hi == 0) al_l[r32] = alpha; asm volatile("s_waitcnt lgkmcnt(0)" ::: "memory"); \
_Pragma("unroll") \
      for (int d = 0; d < 4; ++d) \
_Pragma("unroll") \
        for (int r = 0; r < 16; ++r) o[d][r] *= al_l[crow(r, hi)]; } \
    const unsigned mwv = qm[qi * 34 + t]; \
    h8 pa0, pa1; \
    finishSM32_m(p0, alpha, l_reg, pa0, pa1, mwv, hi); \
    pv_gw32<0, BO>(o[0], tva, pa0, pa1); pv_gw32<1, BO>(o[1], tva, pa0, pa1); pv_gw32<2, BO>(o[2], tva, pa0, pa1); pv_gw32<3, BO>(o[3], tva, pa0, pa1); \
    asm volatile("s_waitcnt lgkmcnt(0)" ::: "memory"); \
  } while (0)
#pragma unroll 1
  for (int tt = 0; tt < NT; tt += 2) {
    GW_STEP(tt, 0);
    if (tt + 1 < NT) GW_STEP(tt + 1, 8192);
  }
#undef GW_STEP
#undef GW_DMA32
  AT_MARK(3);
  if (hi == 0) li_l[r32] = l_reg; asm volatile("s_waitcnt lgkmcnt(0)" ::: "memory");
  float rli[16];
#pragma unroll
  for (int r = 0; r < 16; ++r) rli[r] = __builtin_amdgcn_rcpf(li_l[crow(r, hi)]);
#pragma unroll
  for (int r = 0; r < 16; ++r) { const int orow = crow(r, hi);
#pragma unroll
    for (int d0 = 0; d0 < 4; ++d0) Qw[(long)orow * 128 + d0 * 32 + r32] = (f16)(o[d0][r] * rli[r]); }
  AT_MARK(5);
  return at_acc;
}
__device__ __forceinline__ void tr_settle4(h4& a, h4& b, h4& c, h4& d) { asm volatile("s_waitcnt lgkmcnt(0)" : "+v"(a), "+v"(b), "+v"(c), "+v"(d) : : "memory"); }
__device__ __forceinline__ float xg_max(float v) {
  { auto rr = __builtin_amdgcn_permlane16_swap(__float_as_uint(v), __float_as_uint(v), false, false); v = fmaxf(__uint_as_float(rr[0]), __uint_as_float(rr[1])); }
  { auto rr = __builtin_amdgcn_permlane32_swap(__float_as_uint(v), __float_as_uint(v), false, false); v = fmaxf(__uint_as_float(rr[0]), __uint_as_float(rr[1])); }
  return v; }
__device__ __forceinline__ float xg_sum(float v) {
  { auto rr = __builtin_amdgcn_permlane16_swap(__float_as_uint(v), __float_as_uint(v), false, false); v = __uint_as_float(rr[0]) + __uint_as_float(rr[1]); }
  { auto rr = __builtin_amdgcn_permlane32_swap(__float_as_uint(v), __float_as_uint(v), false, false); v = __uint_as_float(rr[0]) + __uint_as_float(rr[1]); }
  return v; }
__device__ __forceinline__ float max3f(float a, float b, float c) { float r; asm("v_max3_f32 %0, %1, %2, %3" : "=v"(r) : "v"(a), "v"(b), "v"(c)); return r; }
__device__ __forceinline__ float max2f(float a, float b) { float r; asm("v_max_f32 %0, %1, %2" : "=v"(r) : "v"(a), "v"(b)); return r; }
__device__ __forceinline__ float xg_max_raw(float v) {
  { auto rr = __builtin_amdgcn_permlane16_swap(__float_as_uint(v), __float_as_uint(v), false, false); v = max2f(__uint_as_float(rr[0]), __uint_as_float(rr[1])); }
  { auto rr = __builtin_amdgcn_permlane32_swap(__float_as_uint(v), __float_as_uint(v), false, false); v = max2f(__uint_as_float(rr[0]), __uint_as_float(rr[1])); }
  return v; }
struct Pre16 { h8 q[4]; unsigned long long m0, m1; };
__device__ __forceinline__ void pre16_load(Pre16& p, const f16* Qw, const unsigned long long* __restrict__ Mw, const int nw, const int lane_in) {
  int lane = lane_in; asm volatile("" : "+v"(lane));
  const int r16 = lane & 15, g = lane >> 4; const f16* Qp = Qw + (long)r16 * 128 + g * 8;
#pragma unroll
  for (int ks = 0; ks < 4; ++ks) p.q[ks] = *reinterpret_cast<const h8*>(Qp + ks * 32);
  const int sh = nw <= 16 ? 2 : (nw <= 32 ? 1 : 0), wi = lane >> sh;
  p.m0 = 0ull; p.m1 = 0ull;
  if (wi < nw) { p.m0 = Mw[wi]; p.m1 = Mw[64 + wi]; }
}
__device__ __forceinline__ unsigned long long dsa_attn_wave16(f16* Qw, const f16* __restrict__ Kb, const Pre16& pre, const int nw, const int tpos0, const LAS float* tbl, LAS unsigned char* wl, const int lane_in) {
  int lane = lane_in; asm volatile("" : "+v"(lane));
  unsigned long long at_acc = 0ull, at_t = ATT_PROBE_SEC ? __builtin_amdgcn_s_memrealtime() : 0ull;
  constexpr float C = 1.4426950408889634f;
  const int r16 = lane & 15, g = lane >> 4;
  LAS unsigned char* tile = wl; LAS unsigned short* ulist = (LAS unsigned short*)(wl + GW_TILE); LAS unsigned* qm = (LAS unsigned*)(wl + GW_TILE + GW_ULIST);
  h8 qr[4];
#pragma unroll
  for (int ks = 0; ks < 4; ++ks) qr[ks] = pre.q[ks];
  const int qi = r16 >> 3, head = r16 & 7, tpos = tpos0 + qi;
  const int sh = nw <= 16 ? 2 : (nw <= 32 ? 1 : 0), wd = 64 >> sh, pc = lane & ((1 << sh) - 1), kbase = 64 * (lane >> sh) + pc * wd;
  const unsigned long long pm = sh ? ((1ull << wd) - 1ull) : ~0ull;
  const unsigned long long m0 = (pre.m0 >> (pc * wd)) & pm, m1 = (pre.m1 >> (pc * wd)) & pm;
  unsigned long long u = m0 | m1;
  const int cnt = __popcll(u), incl = wave_incl_scan(cnt); int pos = incl - cnt; const int U = __builtin_amdgcn_readlane(incl, 63);
  qm[lane] = 0u; if (lane < 8) qm[lane + 64] = 0u;
  asm volatile("s_waitcnt lgkmcnt(0)" ::: "memory");
  while (u) { const int b = __builtin_ctzll(u); u &= u - 1ull; ulist[pos] = (unsigned short)(kbase + b); const unsigned bit = 1u << (pos & 31); const int w = pos >> 5;
    if ((m0 >> b) & 1ull) __hip_atomic_fetch_or(qm + w, bit, __ATOMIC_RELAXED, __HIP_MEMORY_SCOPE_WORKGROUP);
    if ((m1 >> b) & 1ull) __hip_atomic_fetch_or(qm + 34 + w, bit, __ATOMIC_RELAXED, __HIP_MEMORY_SCOPE_WORKGROUP);
    ++pos; }
  const int NT = (U + 31) >> 5;
  if (lane < 32 && U + lane < 32 * NT) ulist[U + lane] = 0;
  asm volatile("s_waitcnt lgkmcnt(0)" ::: "memory");
  AT_MARK(1);
  const unsigned tb_ = (unsigned)(uintptr_t)tile;
  unsigned ka[2][4];
#pragma unroll
  for (int kb = 0; kb < 2; ++kb)
#pragma unroll
    for (int ks = 0; ks < 4; ++ks) ka[kb][ks] = off_b((unsigned)(16 * kb + r16), (unsigned)(4 * ks + g));
  unsigned tvb[8]; { const unsigned q = (lane & 15) >> 2, p = lane & 3;
#pragma unroll
    for (int db = 0; db < 8; ++db) tvb[db] = tb_ + off_b(4u * g + q, 2u * db + (p >> 1)) + 8u * (p & 1); }
  const int srow = lane >> 4, sch = lane & 15;
  const unsigned chx = (unsigned)(sch ^ (srow << 2)) * 16u;
#define GW_KEYS(t) do { _Pragma("unroll") for (int i_ = 0; i_ < 8; ++i_) kn[i_] = ulist[32 * (t) + 4 * i_ + srow]; } while (0)
#define GW_DMA32K(bo_) do { _Pragma("unroll") for (int i_ = 0; i_ < 8; ++i_) \
      __builtin_amdgcn_global_load_lds((const unsigned*)((const char*)Kb + ((unsigned)kn[i_] * 256u + (chx ^ (unsigned)((i_ & 3) * 16)))), (LAS unsigned*)(tile + (bo_) + 1024 * i_), 16, 0, 0); } while (0)
  unsigned short kn[8];
  float m_reg = -1e30f, l_reg = 0.f; f32x4 o[8];
#pragma unroll
  for (int db = 0; db < 8; ++db) o[db] = (f32x4){0.f, 0.f, 0.f, 0.f};
  GW_KEYS(0); GW_DMA32K(0); if (1 < NT) GW_KEYS(1);
#define GW_STEP(targ_, BO) do { const int t = (targ_); \
    AT_MARK(3); \
    if (t + 1 < NT) { GW_DMA32K(8192 - BO); AT_MARK(4); asm volatile("s_waitcnt vmcnt(8)" ::: "memory"); } \
    else asm volatile("s_waitcnt vmcnt(0)" ::: "memory"); \
    AT_MARK(2); \
    f32x4 s0 = (f32x4){0.f, 0.f, 0.f, 0.f}, s1 = (f32x4){0.f, 0.f, 0.f, 0.f}; \
_Pragma("unroll") \
    for (int ks = 0; ks < 4; ++ks) { const h8 a0 = *(const LAS h8*)(tile + BO + ka[0][ks]); const h8 a1 = *(const LAS h8*)(tile + BO + ka[1][ks]); \
      s0 = __builtin_amdgcn_mfma_f32_16x16x32_f16(a0, qr[ks], s0, 0, 0, 0); s1 = __builtin_amdgcn_mfma_f32_16x16x32_f16(a1, qr[ks], s1, 0, 0, 0); } \
    h4 v0[8], v1[8];                        \
_Pragma("unroll") \
    for (int db = 0; db < 8; ++db) { v0[db] = tr_read_o<BO>(tvb[db]); v1[db] = tr_read_o<BO + 4096>(tvb[db]); } \
    if (t + 2 < NT) GW_KEYS(t + 2); \
    const int klast = __builtin_amdgcn_readfirstlane((int)ulist[(32 * t + 31 < U) ? 32 * t + 31 : U - 1]); \
    if (klast > tpos0 - 128) { \
      const LAS unsigned short* kp = ulist + 32 * t + 4 * g; \
_Pragma("unroll") \
      for (int ii = 0; ii < 4; ++ii) { int i0 = (int)kp[ii] - tpos + 128; i0 = i0 < 0 ? 0 : (i0 > 255 ? 255 : i0); s0[ii] += tbl[i0 * 8 + head]; \
        int i1 = (int)kp[16 + ii] - tpos + 128; i1 = i1 < 0 ? 0 : (i1 > 255 ? 255 : i1); s1[ii] += tbl[i1 * 8 + head]; } \
    } \
    float pmax = max2f(max3f(s0[0], s0[1], s0[2]), max3f(s0[3], s1[0], max3f(s1[1], s1[2], s1[3])));     \
    float mn, alpha; \
    if (__builtin_expect(__all(pmax - m_reg <= THR), 1)) { mn = m_reg; alpha = 1.f; } \
    else { pmax = xg_max_raw(pmax); mn = max2f(m_reg, pmax); alpha = __builtin_amdgcn_exp2f((m_reg - mn) * C); m_reg = mn; \
_Pragma("unroll") \
      for (int db = 0; db < 8; ++db) o[db] = o[db] * alpha; } \
    const float mnC = -mn * C; \
    const unsigned mlo = qm[qi * 34 + t] >> (4 * g); \
    float ps = 0.f; \
_Pragma("unroll") \
    for (int ii = 0; ii < 4; ++ii) { \
      const int t0 = __builtin_amdgcn_sbfe((int)mlo, ii, 1), t1 = __builtin_amdgcn_sbfe((int)mlo, 16 + ii, 1); \
      s0[ii] = __int_as_float(__float_as_int(__builtin_amdgcn_exp2f(fmaf(s0[ii], C, mnC))) & t0); s1[ii] = __int_as_float(__float_as_int(__builtin_amdgcn_exp2f(fmaf(s1[ii], C, mnC))) & t1); \
      ps += s0[ii] + s1[ii]; } \
    l_reg = l_reg * alpha + ps;              \
    u32x4 pw; pw.x = cvtpk(s0[0], s0[1]); pw.y = cvtpk(s0[2], s0[3]); pw.z = cvtpk(s1[0], s1[1]); pw.w = cvtpk(s1[2], s1[3]); \
    const h8 pa = __builtin_bit_cast(h8, pw); \
_Pragma("unroll") \
    for (int db = 0; db < 8; db += 2) tr_settle4(v0[db], v1[db], v0[db + 1], v1[db + 1]); \
    SBAR(); \
_Pragma("unroll") \
    for (int db = 0; db < 8; ++db) o[db] = __builtin_amdgcn_mfma_f32_16x16x32_f16((h8){v0[db][0], v0[db][1], v0[db][2], v0[db][3], v1[db][0], v1[db][1], v1[db][2], v1[db][3]}, pa, o[db], 0, 0, 0); \
    asm volatile("s_waitcnt lgkmcnt(0)" ::: "memory"); \
  } while (0)
#pragma unroll 1
  for (int tt = 0; tt < NT; tt += 2) {
    GW_STEP(tt, 0);
    if (tt + 1 < NT) GW_STEP(tt + 1, 8192);
  }
#undef GW_STEP
#undef GW_DMA32K
#undef GW_KEYS
  AT_MARK(3);
  const float rl = __builtin_amdgcn_rcpf(xg_sum(l_reg));
#pragma unroll
  for (int db = 0; db < 8; ++db) { u32x2 w; w.x = cvtpk(o[db][0] * rl, o[db][1] * rl); w.y = cvtpk(o[db][2] * rl, o[db][3] * rl); *(u32x2*)(Qw + (long)r16 * 128 + 16 * db + 4 * g) = w; }
  AT_MARK(5);
  return at_acc;
}
}

struct Args { const float* in[21]; float* out; unsigned char* ws; int ph_lo, ph_hi; };
enum { I_X = 0, I_MEM, I_NORM1, I_WIN, I_QNORM, I_KVNORM, I_WUQ, I_WIQ, I_WUK, I_WUV, I_MEMNORM, I_WMEMKV, I_WRETO, I_WDSAO, I_WMEMO, I_WOUT, I_NORM2, I_WFF1, I_WFF2, I_RELBIAS, I_FINALNORM };

typedef const __attribute__((address_space(4))) Args* KArgs;
#define INP(a, i) ((const float*)(const GAS float*)((a)->in[i]))
struct FrameU { LAS unsigned char* lds; char* ldsg; unsigned char* ws; unsigned char* dout; int G, wave0; };
struct Frame { LAS unsigned char* lds; char* ldsg; unsigned char* ws; unsigned char* dout; int tid, lane, wave, G; };

__device__ __forceinline__ Frame relaunder(const FrameU& F0) { Frame F; F.lds = F0.lds; F.ldsg = F0.ldsg; F.G = F0.G; const int t = tid_of(F0.wave0);
    { GAS unsigned char* w = (GAS unsigned char*)F0.ws; GAS unsigned char* d = (GAS unsigned char*)F0.dout; asm volatile("" : "+s"(w), "+s"(d)); F.ws = (unsigned char*)w; F.dout = (unsigned char*)d; }
    F.tid = t; F.lane = t & 63; F.wave = F0.wave0; return F; }
__device__ __forceinline__ void norm_rows_f16(const FrameU& F0, const float* src, const float* gain, f16* dst, int rows, int w0, int wstride) {
    const Frame F = relaunder(F0);
    f32x4 g[4];
#pragma unroll
    for (int j = 0; j < 4; ++j) g[j] = ((const f32x4*)gain)[F.lane + 64 * j];
    for (int m = w0; m < rows; m += wstride) {
        const f32x4* xr = (const f32x4*)(src + (size_t)m * DM) + F.lane;
        f32x4 v[4]; float s = 0.f;
#pragma unroll
        for (int j = 0; j < 4; ++j) { v[j] = xr[64 * j]; s += (v[j].x * v[j].x + v[j].y * v[j].y) + (v[j].z * v[j].z + v[j].w * v[j].w); }
        const float rstd = 1.f / sqrtf(wave_sum(s, F.lane) * (1.f / DM) + 1e-6f);
        u32x2* o8 = (u32x2*)(dst + (size_t)m * DM) + F.lane;
#pragma unroll
        for (int j = 0; j < 4; ++j) { u32x2 w; w.x = pk2h(v[j].x * rstd * g[j].x, v[j].y * rstd * g[j].y); w.y = pk2h(v[j].z * rstd * g[j].z, v[j].w * rstd * g[j].w); o8[64 * j] = w; }
    }
}
__device__ __forceinline__ void cvt_rows_f16_ss(const FrameU& F0, const float* src, f16* dst, f16* ss, int rows, int w0, int wstride) {
    const Frame F = relaunder(F0);
    for (int m = w0; m < rows; m += wstride) {
        const f32x4* xr = (const f32x4*)(src + (size_t)m * DM) + F.lane;
        f32x4 v[4]; float s = 0.f;
#pragma unroll
        for (int j = 0; j < 4; ++j) { v[j] = xr[64 * j]; s += (v[j].x * v[j].x + v[j].y * v[j].y) + (v[j].z * v[j].z + v[j].w * v[j].w); }
        s = wave_sum(s, F.lane);
        u32x2* o8 = (u32x2*)(dst + (size_t)m * DM) + F.lane;
#pragma unroll
        for (int j = 0; j < 4; ++j) { u32x2 w; w.x = pk2h(v[j].x, v[j].y); w.y = pk2h(v[j].z, v[j].w); o8[64 * j] = w; }
        if (F.lane < 4) ss[(size_t)m * 4 + F.lane] = (f16)(s * 0.25f);
    }
}
__device__ __forceinline__ void norm_rows_final(const FrameU& F0, const f16* x16, float* x, const float* gain, int rows, int w0, int wstride) {
    const Frame F = relaunder(F0);
    f32x4 g[4];
#pragma unroll
    for (int j = 0; j < 4; ++j) g[j] = ((const f32x4*)gain)[F.lane + 64 * j];
    for (int m = w0; m < rows; m += wstride) {
        f32x4* xr = (f32x4*)(x + (size_t)m * DM) + F.lane; const h4* hr = (const h4*)(x16 + (size_t)m * DM) + F.lane;
        f32x4 v[4]; float s = 0.f;
#pragma unroll
        for (int j = 0; j < 4; ++j) { const h4 t = hr[64 * j]; v[j] = (f32x4){(float)t[0], (float)t[1], (float)t[2], (float)t[3]}; s += (v[j].x * v[j].x + v[j].y * v[j].y) + (v[j].z * v[j].z + v[j].w * v[j].w); }
        const float rstd = 1.f / sqrtf(wave_sum(s, F.lane) * (1.f / DM) + 1e-6f);
#pragma unroll
        for (int j = 0; j < 4; ++j) xr[64 * j] = v[j] * rstd * g[j];
    }
}

__device__ __forceinline__ void transpose_item(const float* src, int ldsrc, int nvalid, int k0, f16* WT, int ldk, int lane, LAS float* scr, const float* gain) {
#pragma unroll
    for (int i = 0; i < 8; ++i) { const int kk = 8 * i + (lane >> 3), n = (lane & 7) * 4; const float gk = gain ? gain[k0 + kk] : 1.f;
        f32x4 v = (f32x4){0.f, 0.f, 0.f, 0.f}; if (n < nvalid) v = *(const f32x4*)(src + (size_t)(k0 + kk) * ldsrc + n);
        scr[kk * 33 + n] = v.x * gk; scr[kk * 33 + n + 1] = v.y * gk; scr[kk * 33 + n + 2] = v.z * gk; scr[kk * 33 + n + 3] = v.w * gk; }
    LDS_WAIT(); asm volatile("" ::: "memory");
    const int c = lane & 7;
#pragma unroll
    for (int j = 0; j < 4; ++j) { const int n = (lane >> 3) + 8 * j; const LAS float* s = scr + (8 * c) * 33 + n;
        u32x4 o; o.x = pk2h(s[0 * 33], s[1 * 33]); o.y = pk2h(s[2 * 33], s[3 * 33]); o.z = pk2h(s[4 * 33], s[5 * 33]); o.w = pk2h(s[6 * 33], s[7 * 33]);
        *(u32x4*)(WT + (size_t)n * ldk + k0 + 8 * c) = o; }
    LDS_WAIT(); asm volatile("" ::: "memory");
}
struct TJob { const float* src; int ldsrc, K, ncols; f16* dst; int ldk; const float* gain; };
__device__ __forceinline__ TJob tjob(KArgs a, unsigned char* ws, int l, int j) {
    unsigned char* wl = ws + WS_W + (size_t)l * W_LAYER; TJob t;
    const float* w_in = INP(a, I_WIN) + (size_t)l * DM * NIN;
    switch (j) {
    case 0:  t = TJob{w_in, NIN, DM, 2464, (f16*)(wl + W_IN), DM, INP(a, I_NORM1) + l * DM}; break;
    case 1:  t = TJob{w_in + 2464, NIN, DM, 8, (f16*)(wl + W_IN) + (size_t)2464 * DM, DM, INP(a, I_NORM1) + l * DM}; break;
    case 2:  t = TJob{w_in, NIN, DM, 0, (f16*)(wl + W_IN) + (size_t)2496 * DM, DM, INP(a, I_NORM1) + l * DM}; break;
    case 3:  t = TJob{w_in, NIN, DM, 0, (f16*)(wl + W_IN) + (size_t)2528 * DM, DM, INP(a, I_NORM1) + l * DM}; break;
    case 4:  t = TJob{w_in + 2472, NIN, DM, 3584, (f16*)(wl + W_IN) + (size_t)2560 * DM, DM, INP(a, I_NORM1) + l * DM}; break;
    case 5:  t = TJob{INP(a, I_WIQ) + (size_t)l * 256 * 256, 256, 256, 256, (f16*)(wl + W_DQ) + (size_t)1024 * 256, 256, nullptr}; break;
    case 6:  t = TJob{INP(a, I_WMEMKV) + (size_t)l * DM * 1024, 1024, DM, 1024, (f16*)(wl + W_MKV), DM, nullptr}; break;
    case 7:  t = TJob{INP(a, I_WRETO) + (size_t)l * 512 * DM, DM, 512, 1024, (f16*)(wl + W_RM), 1024, nullptr}; break;
    case 8:  t = TJob{INP(a, I_WMEMO) + (size_t)l * 512 * DM, DM, 512, 1024, (f16*)(wl + W_RM) + 512, 1024, nullptr}; break;
    case 9:  t = TJob{INP(a, I_WOUT) + (size_t)l * DM * DM, DM, DM, 1024, (f16*)(wl + W_OUT), DM, nullptr}; break;
    case 10: t = TJob{INP(a, I_WFF1) + (size_t)l * DM * FF, FF, DM, FF, (f16*)(wl + W_FF1), DM, INP(a, I_NORM2) + l * DM}; break;
    default: t = TJob{INP(a, I_WFF2) + (size_t)l * FF * DM, DM, FF, 1024, (f16*)(wl + W_FF2), FF, nullptr}; break;
    }
    return t;
}
constexpr int NTJOBS = 12;

__device__ __forceinline__ int t5_bucket(int rel) {
    const int base = rel > 0 ? 16 : 0; const int n = rel < 0 ? -rel : rel;
    if (n < 8) return base + n;
    int lg = 8 + (n >= 12) + (n >= 16) + (n >= 23) + (n >= 32) + (n >= 46) + (n >= 64) + (n >= 91); if (lg > 15) lg = 15;
    return base + lg;
}

#ifndef PRO_PROBE_SEC
#define PRO_PROBE_SEC 0
#endif
#define PR_MARK(sec) do { if (PRO_PROBE_SEC) { const unsigned long long t_ = __builtin_amdgcn_s_memrealtime(); if (PRO_PROBE_SEC == (sec)) pp_acc += t_ - pp_t; pp_t = t_; } } while (0)
__device__ __forceinline__ unsigned long long p_prologue(const FrameU& F0, KArgs a) {
    const Frame F = relaunder(F0);
    unsigned long long pp_acc = 0ull, pp_t = PRO_PROBE_SEC ? __builtin_amdgcn_s_memrealtime() : 0ull;
    LAS float* scr = (LAS float*)(F.lds + F.wave * 16384);
    const int gw = blockIdx.x * NWAVES + F.wave, NGW = F.G * NWAVES;
    {
        constexpr int TJ_TOTAL = 16 * 77 + 16 * 3 + 16 * 112 + 32 + 512 + 256 + 256 + 512 + 2048 + 2048;
#define TJ_ITEMS(j) ((j) == 0 ? 16 * 77 : (j) <= 3 ? 16 : (j) == 4 ? 16 * 112 : (j) == 5 ? 32 : (j) == 6 ? 512 : (j) <= 8 ? 256 : (j) == 9 ? 512 : 2048)
        struct TI { const float* src; const float* gain; f16* dst; int ldsrc, ldk, nv, k0; };
#define TJ_DECODE(f, ti) do { int l_ = (f) >= TJ_TOTAL ? 1 : 0, r_ = (f) - l_ * TJ_TOTAL, j_ = 0; \
            _Pragma("unroll 1") for (; j_ < NTJOBS - 1; ++j_) { const int n_ = TJ_ITEMS(j_); if (r_ < n_) break; r_ -= n_; } \
            const TJob t_ = tjob(a, F.ws, l_, j_); const int nblk_ = (t_.ncols + 31) / 32 > 0 ? (t_.ncols + 31) / 32 : 1; const int kb_ = r_ / nblk_, nb_ = r_ - kb_ * nblk_; \
            int nv_ = t_.ncols - 32 * nb_; nv_ = nv_ > 32 ? 32 : (nv_ < 0 ? 0 : nv_); \
            (ti).src = t_.src + 32 * nb_; (ti).gain = t_.gain; (ti).dst = t_.dst + (size_t)(32 * nb_) * t_.ldk; (ti).ldsrc = t_.ldsrc; (ti).ldk = t_.ldk; (ti).nv = nv_; (ti).k0 = 64 * kb_; } while (0)
#define TJ_LOAD(ti, v, gk) do { _Pragma("unroll") for (int i = 0; i < 8; ++i) { const int kk = 8 * i + (F.lane >> 3), n = (F.lane & 7) * 4; gk[i] = (ti).gain ? (ti).gain[(ti).k0 + kk] : 1.f; \
            v[i] = (f32x4){0.f, 0.f, 0.f, 0.f}; if (n < (ti).nv) v[i] = *(const f32x4*)((ti).src + (size_t)((ti).k0 + kk) * (ti).ldsrc + n); } } while (0)
        int f = gw; TI cur, nxt; f32x4 v[8], vn[8]; float gk[8], gn[8];
        if (f < 2 * TJ_TOTAL) { TJ_DECODE(f, cur); TJ_LOAD(cur, v, gk); }
#pragma unroll 1
        while (f < 2 * TJ_TOTAL) {
            const int fn = f + NGW;
            if (fn < 2 * TJ_TOTAL) { TJ_DECODE(fn, nxt); TJ_LOAD(nxt, vn, gn); }
#pragma unroll
            for (int i = 0; i < 8; ++i) { const int kk = 8 * i + (F.lane >> 3), n = (F.lane & 7) * 4;
                scr[kk * 33 + n] = v[i].x * gk[i]; scr[kk * 33 + n + 1] = v[i].y * gk[i]; scr[kk * 33 + n + 2] = v[i].z * gk[i]; scr[kk * 33 + n + 3] = v[i].w * gk[i]; }
            LDS_WAIT(); asm volatile("" ::: "memory");
            { const int c = F.lane & 7;
#pragma unroll
              for (int j = 0; j < 4; ++j) { const int n = (F.lane >> 3) + 8 * j; const LAS float* sp = scr + (8 * c) * 33 + n;
                u32x4 o; o.x = pk2h(sp[0 * 33], sp[1 * 33]); o.y = pk2h(sp[2 * 33], sp[3 * 33]); o.z = pk2h(sp[4 * 33], sp[5 * 33]); o.w = pk2h(sp[6 * 33], sp[7 * 33]);
                *(u32x4*)(cur.dst + (size_t)n * cur.ldk + cur.k0 + 8 * c) = o; } }
            LDS_WAIT(); asm volatile("" ::: "memory");
            cur = nxt; f = fn;
#pragma unroll
            for (int i = 0; i < 8; ++i) { v[i] = vn[i]; gk[i] = gn[i]; }
        }
#undef TJ_LOAD
#undef TJ_DECODE
#undef TJ_ITEMS
    }
    PR_MARK(1);
    const int gt = blockIdx.x * NTHREADS + F.tid, NGT = F.G * NTHREADS;
    for (int l = 0; l < DEPTH; ++l) {
        unsigned char* wl = F.ws + WS_W + (size_t)l * W_LAYER;
        const float* wuq = INP(a, I_WUQ) + (size_t)l * 256 * 512; const float* wuk = INP(a, I_WUK) + (size_t)l * 128 * 512;
        f16* wdq = (f16*)(wl + W_DQ);
        for (int e = gt; e < 1024 * 256; e += NGT) {
            const int n = e >> 8, k = e & 255, h = n >> 7, r = n & 127;
            const f32x4* pa = (const f32x4*)(wuq + ((size_t)k * 8 + h) * 64); const f32x4* pb = (const f32x4*)(wuk + ((size_t)r * 8 + h) * 64); float s = 0.f;
#pragma unroll
            for (int d = 0; d < 16; ++d) { const f32x4 a4 = pa[d], b4 = pb[d]; s += (a4.x * b4.x + a4.y * b4.y) + (a4.z * b4.z + a4.w * b4.w); }
            wdq[e] = (f16)(s * 0.125f);
        }
        const float* wuv = INP(a, I_WUV) + (size_t)l * 128 * 512; const float* wdo = INP(a, I_WDSAO) + (size_t)l * 512 * DM;
        f16* wvo = (f16*)(wl + W_VO);
        for (int e = gt; e < 1024 * 8 * 16; e += NGT) {
            const int n = e & 1023, hb = e >> 10, h = hb >> 4, r0 = (hb & 15) * 8;
            float acc8[8] = {0.f, 0.f, 0.f, 0.f, 0.f, 0.f, 0.f, 0.f};
            const float* pb = wdo + (size_t)(h * 64) * DM + n;
#pragma unroll 4
            for (int d = 0; d < 64; ++d) { const float bv = pb[(size_t)d * DM];
#pragma unroll
                for (int j = 0; j < 8; ++j) acc8[j] += wuv[((size_t)(r0 + j) * 8 + h) * 64 + d] * bv; }
            u32x4 w; w.x = pk2h(acc8[0], acc8[1]); w.y = pk2h(acc8[2], acc8[3]); w.z = pk2h(acc8[4], acc8[5]); w.w = pk2h(acc8[6], acc8[7]);
            *(u32x4*)(wvo + (size_t)n * 1024 + h * 128 + r0) = w;
        }
    }
    PR_MARK(2);
    cvt_rows_f16_ss(F0, INP(a, I_X), (f16*)(F.ws + WS_X16), (f16*)(F.ws + WS_SS1), T, gw, NGW);
    norm_rows_f16(F0, INP(a, I_MEM), INP(a, I_MEMNORM), (f16*)(F.ws + WS_MEMN), BATCH * MEMLEN, gw, NGW);
    PR_MARK(3);
    float* rc = (float*)(F.ws + WS_ROPE); float* rs = rc + 4096 * 32;
    for (int e = gt; e < 4096 * 32; e += NGT) { const int pos = e >> 5, i = e & 31; const float fr = exp2f(-(float)i * (13.287712379549449f / 32.f)), ang = (float)pos * fr; rc[e] = cosf(ang); rs[e] = sinf(ang); }
    float* tb = (float*)(F.ws + WS_TB);
    for (int e = gt; e < 256 * 8; e += NGT) { const int ri = e >> 3, h = e & 7; tb[e] = INP(a, I_RELBIAS)[t5_bucket(ri - 192) * 8 + h]; }
    PR_MARK(4);
    return pp_acc;
}

__device__ __forceinline__ float dpp_sum16(float v) {
#define DS_(c) v += __int_as_float(__builtin_amdgcn_update_dpp(0, __float_as_int(v), c, 0xf, 0xf, false));
    DS_(0xB1) DS_(0x4E) DS_(0x141) DS_(0x140)
#undef DS_
    return v;
}
__device__ __forceinline__ void p_dsa_norms(const FrameU& F0, KArgs a, int l, int w0, int wstride) {
    const Frame F = relaunder(F0);
    f16* CQ = (f16*)(F.ws + WS_CQ); const f16* MISC = (const f16*)(F.ws + WS_MISC); f16* CKVN = (f16*)(F.ws + WS_CKVN); f16* IKC = (f16*)(F.ws + WS_IKC);
    const float* qn = INP(a, I_QNORM) + l * 256; const float* kn = INP(a, I_KVNORM) + l * 128;
    const int c = F.lane & 15, sub = F.lane >> 4;
    f32x4 gq[4], gk[2];
#pragma unroll
    for (int i = 0; i < 4; ++i) gq[i] = ((const f32x4*)qn)[4 * c + i];
#pragma unroll
    for (int i = 0; i < 2; ++i) gk[i] = ((const f32x4*)kn)[2 * c + i];
    const int step = wstride * 4;
#pragma unroll 1
    for (int m0 = w0 * 4; m0 < T; m0 += 2 * step) {
        h8 q0[2], q1[2], kv[2], ik[2];
#pragma unroll
        for (int u = 0; u < 2; ++u) { const int m = m0 + u * step + sub;
            if (m0 + u * step < T) { q0[u] = *(const h8*)(CQ + (size_t)m * 256 + 16 * c); q1[u] = *(const h8*)(CQ + (size_t)m * 256 + 16 * c + 8); kv[u] = *(const h8*)(MISC + (size_t)m * 256 + 8 * c);
                ik[u] = *(const h8*)(MISC + (size_t)m * 256 + 128 + 8 * (c & 3)); } }
#pragma unroll
        for (int u = 0; u < 2; ++u) { const int m = m0 + u * step + sub;
            if (m0 + u * step < T) {
                float qf_[16], kf_[8]; float sq = 0.f, sk = 0.f;
#pragma unroll
                for (int j = 0; j < 8; ++j) { qf_[j] = (float)q0[u][j]; qf_[8 + j] = (float)q1[u][j]; kf_[j] = (float)kv[u][j]; sq += qf_[j] * qf_[j] + qf_[8 + j] * qf_[8 + j]; sk += kf_[j] * kf_[j]; }
                sq = dpp_sum16(sq); sk = dpp_sum16(sk);
                const float rq = 1.f / sqrtf(sq * (1.f / 256.f) + 1e-6f), rk = 1.f / sqrtf(sk * (1.f / 128.f) + 1e-6f);
                u32x4 w0_, w1_, wk_;
                w0_.x = pk2h(qf_[0] * rq * gq[0].x, qf_[1] * rq * gq[0].y); w0_.y = pk2h(qf_[2] * rq * gq[0].z, qf_[3] * rq * gq[0].w); w0_.z = pk2h(qf_[4] * rq * gq[1].x, qf_[5] * rq * gq[1].y); w0_.w = pk2h(qf_[6] * rq * gq[1].z, qf_[7] * rq * gq[1].w);
                w1_.x = pk2h(qf_[8] * rq * gq[2].x, qf_[9] * rq * gq[2].y); w1_.y = pk2h(qf_[10] * rq * gq[2].z, qf_[11] * rq * gq[2].w); w1_.z = pk2h(qf_[12] * rq * gq[3].x, qf_[13] * rq * gq[3].y); w1_.w = pk2h(qf_[14] * rq * gq[3].z, qf_[15] * rq * gq[3].w);
                wk_.x = pk2h(kf_[0] * rk * gk[0].x, kf_[1] * rk * gk[0].y); wk_.y = pk2h(kf_[2] * rk * gk[0].z, kf_[3] * rk * gk[0].w); wk_.z = pk2h(kf_[4] * rk * gk[1].x, kf_[5] * rk * gk[1].y); wk_.w = pk2h(kf_[6] * rk * gk[1].z, kf_[7] * rk * gk[1].w);
                *(u32x4*)(CQ + (size_t)m * 256 + 16 * c) = w0_; *(u32x4*)(CQ + (size_t)m * 256 + 16 * c + 8) = w1_; *(u32x4*)(CKVN + (size_t)m * 128 + 8 * c) = wk_;
                if (c < 4) *(h8*)(IKC + (size_t)m * 32 + 8 * c) = ik[u];
            } }
    }
}
__device__ __forceinline__ void p_retention_simple(const FrameU& F0, int unit) {
    const Frame F = relaunder(F0);
    const int b = unit >> 3, h = unit & 7;
    LAS float* Qf = (LAS float*)F.lds; LAS float* Kf = Qf + 64 * 65; LAS float* Vf = Kf + 64 * 65; LAS float* Sf = Vf + 64 * 65; LAS float* St = Sf + 64 * 65; LAS float* Of = St + 64 * 65; LAS float* Kd = Of + 64 * 65;
    const f16* RQ = (const f16*)(F.ws + WS_RQ); const f16* RK = (const f16*)(F.ws + WS_RK); const f16* RV = (const f16*)(F.ws + WS_RV); f16* GM = (f16*)(F.dout + DO_GM);
    const float* rc = (const float*)(F.ws + WS_ROPE); const float* rs = rc + 4096 * 32;
    const float lg = log2f(1.f - exp2f(-5.f - (float)h));
    const int tid = F.tid, i = tid >> 3, cg = tid & 7;
    for (int e = tid; e < 64 * 65; e += NTHREADS) St[e] = 0.f;
    if (tid < 64) Kd[tid] = exp2f(lg * (float)(63 - tid));
    const float g64 = exp2f(lg * 64.f);
    for (int n = 0; n < 64; ++n) {
        const size_t row = (size_t)b * SEQ + 64 * n + i; const int pos = 64 * n + i;
        const h8 qv = *(const h8*)(RQ + row * 512 + h * 64 + 8 * cg), kv = *(const h8*)(RK + row * 512 + h * 64 + 8 * cg), vv = *(const h8*)(RV + row * 512 + h * 64 + 8 * cg);
        const h8 gv = *(const h8*)(GM + row * 1024 + h * 64 + 8 * cg);
        const float* cp = rc + pos * 32 + 8 * (cg & 3); const float* sp = rs + pos * 32 + 8 * (cg & 3);
#pragma unroll
        for (int j = 0; j < 8; ++j) {
            const float q = (float)qv[j], k = (float)kv[j]; const float pq = sx(q, 4, F.lane), pk = sx(k, 4, F.lane); const float c = cp[j], s = sp[j];
            const float qo = (cg < 4) ? (q * c - pq * s) : (q * c + pq * s), ko = (cg < 4) ? (k * c - pk * s) : (k * c + pk * s);
            Qf[i * 65 + 8 * cg + j] = qo; Kf[i * 65 + 8 * cg + j] = ko * 0.125f; Vf[i * 65 + 8 * cg + j] = (float)vv[j];
        }
        __syncthreads();
#pragma unroll 1
        for (int jj = 0; jj < 8; ++jj) { const int j = cg + 8 * jj; float s = 0.f;
            for (int d = 0; d < 64; ++d) s += Qf[i * 65 + d] * Kf[j * 65 + d];
            const int dd = i > j ? i - j : j - i; Sf[i * 65 + j] = s * exp2f(lg * (float)dd); }
        __syncthreads();
        float ns[8];
        const float qd = exp2f(lg * (float)(i + 1));
#pragma unroll 1
        for (int ee = 0; ee < 8; ++ee) { const int e = cg + 8 * ee; float s1 = 0.f, s2 = 0.f, s3 = 0.f;
            for (int j = 0; j < 64; ++j) s1 += Sf[i * 65 + j] * Vf[j * 65 + e];
            for (int d = 0; d < 64; ++d) s2 += Qf[i * 65 + d] * St[d * 65 + e];
            Of[i * 65 + e] = s1 + qd * s2;
            for (int j = 0; j < 64; ++j) s3 += Kf[j * 65 + i] * Kd[j] * Vf[j * 65 + e];
            ns[ee] = g64 * St[i * 65 + e] + s3; }
        __syncthreads();
#pragma unroll
        for (int ee = 0; ee < 8; ++ee) St[i * 65 + cg + 8 * ee] = ns[ee];
        float ov[8]; float s = 0.f;
#pragma unroll
        for (int j = 0; j < 8; ++j) { ov[j] = Of[i * 65 + 8 * cg + j]; s += ov[j]; }
        s += sx(s, 1, F.lane); s += sx(s, 2, F.lane); s += sx(s, 4, F.lane);
        const float mu = s * (1.f / 64.f); float q = 0.f;
#pragma unroll
        for (int j = 0; j < 8; ++j) { ov[j] -= mu; q += ov[j] * ov[j]; }
        q += sx(q, 1, F.lane); q += sx(q, 2, F.lane); q += sx(q, 4, F.lane);
        const float rstd = 1.f / sqrtf(q * (1.f / 64.f) + 1e-5f);
        float ro[8];
#pragma unroll
        for (int j = 0; j < 8; ++j) { const float g = (float)gv[j]; ro[j] = ov[j] * rstd * (g / (1.f + __expf(-g))); }
        u32x4 w; w.x = pk2h(ro[0], ro[1]); w.y = pk2h(ro[2], ro[3]); w.z = pk2h(ro[4], ro[5]); w.w = pk2h(ro[6], ro[7]);
        *(u32x4*)(GM + row * 1024 + h * 64 + 8 * cg) = w;
        __syncthreads();
    }
}


constexpr int NSEGR = 2, RSPLIT = 40;
__device__ __forceinline__ void p_retention(const FrameU& F0, int unit) {
    const Frame F = relaunder(F0);
    constexpr int LD = 72;
    LAS f16* Qs = (LAS f16*)F.lds; LAS f16* Ks = Qs + 64 * LD; LAS f16* Kdt = Ks + 64 * LD; LAS f16* Vt = Kdt + 64 * LD; LAS f16* Ss = Vt + 64 * LD; LAS f16* Stt = Ss + 64 * LD;
    LAS float* Os = (LAS float*)(Stt + 2 * 64 * LD);
    const int bh = unit / NSEGR, seg = unit - bh * NSEGR, b = bh >> 3, h = bh & 7;
    const int n_lo = seg == 0 ? 0 : RSPLIT, n_hi = seg == 0 ? RSPLIT : 64;
    const f16* RQ = (const f16*)(F.ws + WS_RQ); const f16* RK = (const f16*)(F.ws + WS_RK); const f16* RV = (const f16*)(F.ws + WS_RV); f16* GM = (f16*)(F.dout + DO_GM);
    const float* rc = (const float*)(F.ws + WS_ROPE); const float* rs = rc + 4096 * 32;
    const float lg = log2f(1.f - exp2f(-5.f - (float)h));
    const int tid = F.tid, lane = F.lane, wave = F.wave;
    const int i = tid >> 3, cg = tid & 7;
    const int r16 = lane & 15, g = lane >> 4, rb = wave & 3, cbp = wave >> 2;
    const float g64 = exp2f(lg * 64.f), kdec = exp2f(lg * (float)(63 - i)) * 0.125f;
    float dec[2][4], qd[4];
#pragma unroll
    for (int ii = 0; ii < 4; ++ii) { const int ri = 16 * rb + 4 * g + ii; qd[ii] = exp2f(lg * (float)(ri + 1));
#pragma unroll
        for (int cb = 0; cb < 2; ++cb) { const int cj = 16 * (2 * cbp + cb) + r16; dec[cb][ii] = exp2f(lg * (float)(ri > cj ? ri - cj : cj - ri)); } }
    f32x4 st[2] = {(f32x4){0.f, 0.f, 0.f, 0.f}, (f32x4){0.f, 0.f, 0.f, 0.f}};
    const size_t rowb = (size_t)b * SEQ + i; const int colh = h * 64 + 8 * cg;
    h8 qv, kv, vv, gv; f32x4 c0, c1, s0, s1;
#define RLOAD(n, full) do { const size_t row_ = rowb + 64 * (n); kv = *(const h8*)(RK + row_ * 512 + colh); vv = *(const h8*)(RV + row_ * 512 + colh); \
        if (full) { qv = *(const h8*)(RQ + row_ * 512 + colh); gv = *(const h8*)(GM + row_ * 1024 + colh); } \
        const float* cp_ = rc + (size_t)(64 * (n) + i) * 32 + 8 * (cg & 3); const float* sp_ = rs + (size_t)(64 * (n) + i) * 32 + 8 * (cg & 3); \
        c0 = *(const f32x4*)cp_; c1 = *(const f32x4*)(cp_ + 4); s0 = *(const f32x4*)sp_; s1 = *(const f32x4*)(sp_ + 4); } while (0)
#define RSTAGE(full) do { float cs_[8] = {c0.x, c0.y, c0.z, c0.w, c1.x, c1.y, c1.z, c1.w}, sn_[8] = {s0.x, s0.y, s0.z, s0.w, s1.x, s1.y, s1.z, s1.w}; float ko_[8], qo_[8]; \
        _Pragma("unroll") for (int j_ = 0; j_ < 8; ++j_) { const float k_ = (float)kv[j_], pk_ = sx(k_, 4, F.lane); ko_[j_] = (cg < 4) ? (k_ * cs_[j_] - pk_ * sn_[j_]) : (k_ * cs_[j_] + pk_ * sn_[j_]); \
            if (full) { const float q_ = (float)qv[j_], pq_ = sx(q_, 4, F.lane); qo_[j_] = (cg < 4) ? (q_ * cs_[j_] - pq_ * sn_[j_]) : (q_ * cs_[j_] + pq_ * sn_[j_]); } } \
        _Pragma("unroll") for (int j_ = 0; j_ < 8; ++j_) { Kdt[(8 * cg + j_) * LD + i] = (f16)(ko_[j_] * kdec); Vt[(8 * cg + j_) * LD + i] = vv[j_]; } \
        if (full) { u32x4 wq_, wk_; wq_.x = pk2h(qo_[0], qo_[1]); wq_.y = pk2h(qo_[2], qo_[3]); wq_.z = pk2h(qo_[4], qo_[5]); wq_.w = pk2h(qo_[6], qo_[7]); \
            wk_.x = pk2h(ko_[0] * 0.125f, ko_[1] * 0.125f); wk_.y = pk2h(ko_[2] * 0.125f, ko_[3] * 0.125f); wk_.z = pk2h(ko_[4] * 0.125f, ko_[5] * 0.125f); wk_.w = pk2h(ko_[6] * 0.125f, ko_[7] * 0.125f); \
            *(LAS u32x4*)(Qs + i * LD + 8 * cg) = wq_; *(LAS u32x4*)(Ks + i * LD + 8 * cg) = wk_; } } while (0)
#define FRAG(P, row, ks) (*(const LAS h8*)((P) + (row) * LD + 32 * (ks) + 8 * g))
    if (n_lo > 0) RLOAD(0, false);
    for (int n = 0; n < n_lo; ++n) {
        RSTAGE(false);
        if (n + 1 < n_lo) RLOAD(n + 1, false);
        __syncthreads();
#pragma unroll
        for (int cb = 0; cb < 2; ++cb) { const int colb = 16 * (2 * cbp + cb) + r16; f32x4 a = st[cb] * g64;
#pragma unroll
            for (int ks = 0; ks < 2; ++ks) a = __builtin_amdgcn_mfma_f32_16x16x32_f16(FRAG(Kdt, 16 * rb + r16, ks), FRAG(Vt, colb, ks), a, 0, 0, 0);
            st[cb] = a; }
        __syncthreads();
    }
    int cur = 0;
#pragma unroll
    for (int cb = 0; cb < 2; ++cb) { const int colb = 16 * (2 * cbp + cb) + r16; u32x2 w; w.x = pk2h(st[cb][0], st[cb][1]); w.y = pk2h(st[cb][2], st[cb][3]); *(LAS u32x2*)(Stt + colb * LD + 16 * rb + 4 * g) = w; }
    RLOAD(n_lo, true);
    for (int n = n_lo; n < n_hi; ++n) {
        RSTAGE(true);
        const h8 gcur = gv; const size_t orow = rowb + 64 * n;
        if (n + 1 < n_hi) RLOAD(n + 1, true);
        __syncthreads();
        h8 aq[2]; aq[0] = FRAG(Qs, 16 * rb + r16, 0); aq[1] = FRAG(Qs, 16 * rb + r16, 1);
#pragma unroll
        for (int cb = 0; cb < 2; ++cb) { const int colb = 16 * (2 * cbp + cb) + r16; f32x4 sacc = (f32x4){0.f, 0.f, 0.f, 0.f};
#pragma unroll
            for (int ks = 0; ks < 2; ++ks) sacc = __builtin_amdgcn_mfma_f32_16x16x32_f16(aq[ks], FRAG(Ks, colb, ks), sacc, 0, 0, 0);
#pragma unroll
            for (int ii = 0; ii < 4; ++ii) Ss[(16 * rb + 4 * g + ii) * LD + colb] = (f16)(sacc[ii] * dec[cb][ii]); }
        __syncthreads();
        LAS f16* Sc = Stt + cur * 64 * LD; LAS f16* Sn = Stt + (cur ^ 1) * 64 * LD;
        h8 as[2], akd[2]; as[0] = FRAG(Ss, 16 * rb + r16, 0); as[1] = FRAG(Ss, 16 * rb + r16, 1); akd[0] = FRAG(Kdt, 16 * rb + r16, 0); akd[1] = FRAG(Kdt, 16 * rb + r16, 1);
#pragma unroll
        for (int cb = 0; cb < 2; ++cb) { const int colb = 16 * (2 * cbp + cb) + r16;
            f32x4 ai = (f32x4){0.f, 0.f, 0.f, 0.f}, ac = (f32x4){0.f, 0.f, 0.f, 0.f}, a = st[cb] * g64;
#pragma unroll
            for (int ks = 0; ks < 2; ++ks) { const h8 bv = FRAG(Vt, colb, ks), bs = FRAG(Sc, colb, ks);
                ai = __builtin_amdgcn_mfma_f32_16x16x32_f16(as[ks], bv, ai, 0, 0, 0);
                ac = __builtin_amdgcn_mfma_f32_16x16x32_f16(aq[ks], bs, ac, 0, 0, 0);
                a = __builtin_amdgcn_mfma_f32_16x16x32_f16(akd[ks], bv, a, 0, 0, 0); }
            st[cb] = a;
#pragma unroll
            for (int ii = 0; ii < 4; ++ii) Os[(16 * rb + 4 * g + ii) * 68 + colb] = ai[ii] + qd[ii] * ac[ii];
            u32x2 w; w.x = pk2h(a[0], a[1]); w.y = pk2h(a[2], a[3]); *(LAS u32x2*)(Sn + colb * LD + 16 * rb + 4 * g) = w; }
        cur ^= 1;
        __syncthreads();
        {
            const f32x4 o0 = *(const LAS f32x4*)(Os + i * 68 + 8 * cg), o1 = *(const LAS f32x4*)(Os + i * 68 + 8 * cg + 4);
            float ov[8] = {o0.x, o0.y, o0.z, o0.w, o1.x, o1.y, o1.z, o1.w}; float s = 0.f;
#pragma unroll
            for (int j = 0; j < 8; ++j) s += ov[j];
            s += sx(s, 1, F.lane); s += sx(s, 2, F.lane); s += sx(s, 4, F.lane);
            const float mu = s * (1.f / 64.f); float q = 0.f;
#pragma unroll
            for (int j = 0; j < 8; ++j) { ov[j] -= mu; q += ov[j] * ov[j]; }
            q += sx(q, 1, F.lane); q += sx(q, 2, F.lane); q += sx(q, 4, F.lane);
            const float rstd = 1.f / sqrtf(q * (1.f / 64.f) + 1e-5f);
            float ro[8];
#pragma unroll
            for (int j = 0; j < 8; ++j) { const float gg = (float)gcur[j]; ro[j] = ov[j] * rstd * (gg / (1.f + __expf(-gg))); }
            u32x4 w; w.x = pk2h(ro[0], ro[1]); w.y = pk2h(ro[2], ro[3]); w.z = pk2h(ro[4], ro[5]); w.w = pk2h(ro[6], ro[7]);
            *(u32x4*)(GM + orow * 1024 + colh) = w;
        }
    }
    __syncthreads();
#undef RLOAD
#undef RSTAGE
#undef FRAG
}

constexpr size_t DO_KVT = 128 * MiB;
constexpr int RLD = 72;
template <int OFF> __device__ __forceinline__ h4 rtr(unsigned vb) { h4 r; asm volatile("ds_read_b64_tr_b16 %0, %1 offset:%2" : "=&v"(r) : "v"(vb), "i"(OFF) : "memory"); return r; }
#define RPK(L, H) (h8){L[0], L[1], L[2], L[3], H[0], H[1], H[2], H[3]}
__device__ __forceinline__ void rtr_settle(h4& a, h4& b, h4& c, h4& d) { asm volatile("s_waitcnt lgkmcnt(0)" : "+v"(a), "+v"(b), "+v"(c), "+v"(d) : : "memory"); }
#define RPKF(o) (u32x4){pk2h(o[0], o[1]), pk2h(o[2], o[3]), pk2h(o[4], o[5]), pk2h(o[6], o[7])}
__device__ __forceinline__ void p_ret_kv(const FrameU& F0, int gw, int ngw) {
    const Frame F = relaunder(F0);
    const int lane = F.lane, r16 = lane & 15, g = lane >> 4;
    LAS f16* Kd = (LAS f16*)(F.lds + F.wave * (2 * 64 * RLD * 2)); LAS f16* Vs = Kd + 64 * RLD;
    const f16* RK = (const f16*)(F.ws + WS_RK); const f16* RV = (const f16*)(F.ws + WS_RV); f16* KVT = (f16*)(F.dout + DO_KVT);
    const float* rc = (const float*)(F.ws + WS_ROPE);
    const unsigned trb = (unsigned)(((8 * g + (r16 >> 2)) * RLD + 4 * (lane & 3)) * 2);
    const unsigned kb = (unsigned)(size_t)Kd + trb, vb = (unsigned)(size_t)Vs + trb;
    const unsigned lo_v = (unsigned)(((lane >> 3) * 512 + 8 * (lane & 7)) * 2), lo_f = (unsigned)((r16 * 512 + 8 * g) * 2), lo_t = (unsigned)((r16 * 32 + 8 * g) * 4), lo_o = (unsigned)((r16 * 64 + 4 * g) * 2);
#pragma unroll 1
    for (int item = gw; item < 8192; item += ngw) {
        const int bh = item >> 6, n = item & 63, b = bh >> 3, h = bh & 7;
        const float lg = log2f(1.f - exp2f(-5.f - (float)h));
        const size_t row0 = (size_t)b * SEQ + 64 * n;
        const char* vbase = (const char*)(RV + row0 * 512 + h * 64); const char* kbase = (const char*)(RK + row0 * 512 + h * 64);
        const char* cbase = (const char*)(rc + (size_t)(64 * n) * 32); const char* sbase = cbase + 4096 * 32 * 4;
        h8 vv[8];
#pragma unroll
        for (int k = 0; k < 8; ++k) vv[k] = *(const h8*)(vbase + lo_v + k * 8192);
#pragma unroll
        for (int rb = 0; rb < 4; ++rb) { const int ri = 16 * rb + r16;
            const h8 k0 = *(const h8*)(kbase + lo_f + rb * 16384), k1 = *(const h8*)(kbase + lo_f + rb * 16384 + 64);
            const f32x4 c0 = *(const f32x4*)(cbase + lo_t + rb * 2048), c1 = *(const f32x4*)(cbase + lo_t + rb * 2048 + 16), s0 = *(const f32x4*)(sbase + lo_t + rb * 2048), s1 = *(const f32x4*)(sbase + lo_t + rb * 2048 + 16);
            const float cs[8] = {c0.x, c0.y, c0.z, c0.w, c1.x, c1.y, c1.z, c1.w}, sn[8] = {s0.x, s0.y, s0.z, s0.w, s1.x, s1.y, s1.z, s1.w};
            const float kd = exp2f(lg * (float)(63 - ri)) * 0.125f;
            float o0[8], o1[8];
#pragma unroll
            for (int j = 0; j < 8; ++j) { const float a = (float)k0[j], c = (float)k1[j]; o0[j] = (a * cs[j] - c * sn[j]) * kd; o1[j] = (c * cs[j] + a * sn[j]) * kd; }
            *(LAS u32x4*)(Kd + ri * RLD + 8 * g) = RPKF(o0); *(LAS u32x4*)(Kd + ri * RLD + 32 + 8 * g) = RPKF(o1); }
#pragma unroll
        for (int k = 0; k < 8; ++k) *(LAS h8*)(Vs + (8 * k + (lane >> 3)) * RLD + 8 * (lane & 7)) = vv[k];
        LDS_WAIT();
        h8 af[4][2], bf[4][2];
        {   h4 ar[4][4], br[4][4];
#pragma unroll
            for (int x = 0; x < 4; ++x) {
                ar[x][0] = rtr<0>(kb + 32 * x); ar[x][1] = rtr<4 * RLD * 2>(kb + 32 * x); ar[x][2] = rtr<32 * RLD * 2>(kb + 32 * x); ar[x][3] = rtr<36 * RLD * 2>(kb + 32 * x);
                br[x][0] = rtr<0>(vb + 32 * x); br[x][1] = rtr<4 * RLD * 2>(vb + 32 * x); br[x][2] = rtr<32 * RLD * 2>(vb + 32 * x); br[x][3] = rtr<36 * RLD * 2>(vb + 32 * x); }
#pragma unroll
            for (int x = 0; x < 4; ++x) { rtr_settle(ar[x][0], ar[x][1], ar[x][2], ar[x][3]); rtr_settle(br[x][0], br[x][1], br[x][2], br[x][3]); }
            __builtin_amdgcn_sched_barrier(0);
#pragma unroll
            for (int x = 0; x < 4; ++x) { af[x][0] = RPK(ar[x][0], ar[x][1]); af[x][1] = RPK(ar[x][2], ar[x][3]); bf[x][0] = RPK(br[x][0], br[x][1]); bf[x][1] = RPK(br[x][2], br[x][3]); } }
        char* out = (char*)(KVT + (size_t)item * 4096);
#pragma unroll
        for (int db = 0; db < 4; ++db)
#pragma unroll
            for (int eb = 0; eb < 4; ++eb) { f32x4 acc = {0.f, 0.f, 0.f, 0.f};
                acc = __builtin_amdgcn_mfma_f32_16x16x32_f16(af[db][0], bf[eb][0], acc, 0, 0, 0); acc = __builtin_amdgcn_mfma_f32_16x16x32_f16(af[db][1], bf[eb][1], acc, 0, 0, 0);
                u32x2 w; w.x = pk2h(acc[0], acc[1]); w.y = pk2h(acc[2], acc[3]); *(u32x2*)(out + lo_o + eb * 2048 + db * 32) = w; }
    }
}
__device__ __forceinline__ void p_ret_scan(const FrameU& F0, int gw, int ngw) {
    const Frame F = relaunder(F0);
    f16* KVT = (f16*)(F.dout + DO_KVT);
#pragma unroll 1
    for (int slot = gw * 64 + F.lane; slot < 128 * 1024; slot += ngw * 64) {
        const int bh = slot >> 10, e4 = slot & 1023, h = bh & 7;
        const float g64 = exp2f(64.f * log2f(1.f - exp2f(-5.f - (float)h)));
        f16* p = KVT + (size_t)bh * (64 * 4096) + e4 * 4;
        f32x4 acc = {0.f, 0.f, 0.f, 0.f};
#pragma unroll 1
        for (int n0 = 0; n0 < 64; n0 += 16) {
            h4 v[16];
#pragma unroll
            for (int k = 0; k < 16; ++k) v[k] = *(const h4*)(p + (size_t)(n0 + k) * 4096);
#pragma unroll
            for (int k = 0; k < 16; ++k) { u32x2 w; w.x = pk2h(acc[0], acc[1]); w.y = pk2h(acc[2], acc[3]); *(u32x2*)(p + (size_t)(n0 + k) * 4096) = w;
                acc[0] = acc[0] * g64 + (float)v[k][0]; acc[1] = acc[1] * g64 + (float)v[k][1]; acc[2] = acc[2] * g64 + (float)v[k][2]; acc[3] = acc[3] * g64 + (float)v[k][3]; }
        }
    }
}
__device__ __forceinline__ void ret_out_item(const unsigned char* wsb, unsigned char* doutb, LAS f16* Vs, const int lane_in, const int item) {
    int lane = lane_in; asm volatile("" : "+v"(lane));
    const int r16 = lane & 15, g = lane >> 4;
    const f16* RQ = (const f16*)(wsb + WS_RQ); const f16* RK = (const f16*)(wsb + WS_RK); const f16* RV = (const f16*)(wsb + WS_RV); f16* GM = (f16*)(doutb + DO_GM); const f16* KVT = (const f16*)(doutb + DO_KVT);
    const float* rc = (const float*)(wsb + WS_ROPE);
    const unsigned vb = (unsigned)(size_t)Vs + (unsigned)(((4 * g + (r16 >> 2)) * RLD + 4 * (lane & 3)) * 2);
    const unsigned lo_v = (unsigned)(((lane >> 3) * 512 + 8 * (lane & 7)) * 2), lo_f = (unsigned)((r16 * 512 + 8 * g) * 2), lo_t = (unsigned)((r16 * 32 + 8 * g) * 4), lo_s = (unsigned)((r16 * 64 + 8 * g) * 2), lo_g = (unsigned)((r16 * 1024 + 4 * g) * 2);
    {
        const int bh = item >> 6, n = item & 63, b = bh >> 3, h = bh & 7;
        const float lg = log2f(1.f - exp2f(-5.f - (float)h));
        const size_t row0 = (size_t)b * SEQ + 64 * n;
        const char* vbase = (const char*)(RV + row0 * 512 + h * 64); const char* kbase = (const char*)(RK + row0 * 512 + h * 64); const char* qbase = (const char*)(RQ + row0 * 512 + h * 64);
        const char* cbase = (const char*)(rc + (size_t)(64 * n) * 32); const char* sbase = cbase + 4096 * 32 * 4;
        const char* stb = (const char*)(KVT + (size_t)item * 4096); char* gbase = (char*)(GM + row0 * 1024 + h * 64);
        h8 P[4][2], qf[4][2], sf[4][2]; h4 gq[4][4];
        {
            h8 vv[8];
#pragma unroll
            for (int k = 0; k < 8; ++k) vv[k] = *(const h8*)(vbase + lo_v + k * 8192);
            h8 kf[4][2];
#pragma unroll
            for (int rb = 0; rb < 4; ++rb) {
                const h8 k0 = *(const h8*)(kbase + lo_f + rb * 16384), k1 = *(const h8*)(kbase + lo_f + rb * 16384 + 64), q0 = *(const h8*)(qbase + lo_f + rb * 16384), q1 = *(const h8*)(qbase + lo_f + rb * 16384 + 64);
                const f32x4 c0 = *(const f32x4*)(cbase + lo_t + rb * 2048), c1 = *(const f32x4*)(cbase + lo_t + rb * 2048 + 16), s0 = *(const f32x4*)(sbase + lo_t + rb * 2048), s1 = *(const f32x4*)(sbase + lo_t + rb * 2048 + 16);
                const float cs[8] = {c0.x, c0.y, c0.z, c0.w, c1.x, c1.y, c1.z, c1.w}, sn[8] = {s0.x, s0.y, s0.z, s0.w, s1.x, s1.y, s1.z, s1.w};
                float o0[8], o1[8], p0[8], p1[8];
#pragma unroll
                for (int j = 0; j < 8; ++j) { const float a = (float)k0[j], c = (float)k1[j]; o0[j] = (a * cs[j] - c * sn[j]) * 0.125f; o1[j] = (c * cs[j] + a * sn[j]) * 0.125f;
                    const float x = (float)q0[j], y = (float)q1[j]; p0[j] = x * cs[j] - y * sn[j]; p1[j] = y * cs[j] + x * sn[j]; }
                kf[rb][0] = __builtin_bit_cast(h8, RPKF(o0)); kf[rb][1] = __builtin_bit_cast(h8, RPKF(o1)); qf[rb][0] = __builtin_bit_cast(h8, RPKF(p0)); qf[rb][1] = __builtin_bit_cast(h8, RPKF(p1)); }
#pragma unroll
            for (int k = 0; k < 8; ++k) *(LAS h8*)(Vs + (8 * k + (lane >> 3)) * RLD + 8 * (lane & 7)) = vv[k];
            asm volatile("" ::: "memory");
#pragma unroll
            for (int eb = 0; eb < 4; ++eb)
#pragma unroll
                for (int ks = 0; ks < 2; ++ks) sf[eb][ks] = *(const h8*)(stb + lo_s + eb * 2048 + ks * 64);
#pragma unroll
            for (int ib = 0; ib < 4; ++ib)
#pragma unroll
                for (int eb = 0; eb < 4; ++eb) gq[ib][eb] = *(const h4*)(gbase + lo_g + ib * 32768 + 32 * eb);
            int cdl = r16 - 4 * g; asm volatile("" : "+v"(cdl));
#pragma unroll
            for (int ib = 0; ib < 4; ++ib)
#pragma unroll
                for (int ks = 0; ks < 2; ++ks) { float pv[8];
#pragma unroll
                    for (int t = 0; t < 2; ++t) { const int jb = 2 * ks + t; f32x4 s = {0.f, 0.f, 0.f, 0.f};
                        s = __builtin_amdgcn_mfma_f32_16x16x32_f16(kf[jb][0], qf[ib][0], s, 0, 0, 0); s = __builtin_amdgcn_mfma_f32_16x16x32_f16(kf[jb][1], qf[ib][1], s, 0, 0, 0);
#pragma unroll
                        for (int ii = 0; ii < 4; ++ii) { const int dl = 16 * (ib - jb) + cdl - ii; pv[4 * t + ii] = s[ii] * exp2f(lg * (float)(dl < 0 ? -dl : dl)); } }
                    P[ib][ks] = __builtin_bit_cast(h8, RPKF(pv)); }
        }
        LDS_WAIT();
        h8 vf[4][2];
        {   h4 vr[4][4];
#pragma unroll
            for (int eb = 0; eb < 4; ++eb) { vr[eb][0] = rtr<0>(vb + 32 * eb); vr[eb][1] = rtr<16 * RLD * 2>(vb + 32 * eb); vr[eb][2] = rtr<32 * RLD * 2>(vb + 32 * eb); vr[eb][3] = rtr<48 * RLD * 2>(vb + 32 * eb); }
#pragma unroll
            for (int eb = 0; eb < 4; ++eb) rtr_settle(vr[eb][0], vr[eb][1], vr[eb][2], vr[eb][3]);
            __builtin_amdgcn_sched_barrier(0);
#pragma unroll
            for (int eb = 0; eb < 4; ++eb) { vf[eb][0] = RPK(vr[eb][0], vr[eb][1]); vf[eb][1] = RPK(vr[eb][2], vr[eb][3]); } }
#pragma unroll
        for (int ib = 0; ib < 4; ++ib) {
            char* gp = gbase + lo_g + ib * 32768;
            const float qd = exp2f(lg * (float)(16 * ib + r16 + 1));
            f32x4 O[4]; float sm = 0.f;
#pragma unroll
            for (int eb = 0; eb < 4; ++eb) { f32x4 a = {0.f, 0.f, 0.f, 0.f};
                a = __builtin_amdgcn_mfma_f32_16x16x32_f16(sf[eb][0], qf[ib][0], a, 0, 0, 0); a = __builtin_amdgcn_mfma_f32_16x16x32_f16(sf[eb][1], qf[ib][1], a, 0, 0, 0);
                a = a * qd;
                a = __builtin_amdgcn_mfma_f32_16x16x32_f16(vf[eb][0], P[ib][0], a, 0, 0, 0); a = __builtin_amdgcn_mfma_f32_16x16x32_f16(vf[eb][1], P[ib][1], a, 0, 0, 0);
                O[eb] = a; sm += (a[0] + a[1]) + (a[2] + a[3]); }
            sm += sx(sm, 16, lane); sm += sx(sm, 32, lane);
            const float mu = sm * (1.f / 64.f); float q = 0.f;
#pragma unroll
            for (int eb = 0; eb < 4; ++eb)
#pragma unroll
                for (int ii = 0; ii < 4; ++ii) { O[eb][ii] -= mu; q += O[eb][ii] * O[eb][ii]; }
            q += sx(q, 16, lane); q += sx(q, 32, lane);
            const float rstd = 1.f / sqrtf(q * (1.f / 64.f) + 1e-5f);
#pragma unroll
            for (int eb = 0; eb < 4; ++eb) { float ro[4];
#pragma unroll
                for (int ii = 0; ii < 4; ++ii) { const float gg = (float)gq[ib][eb][ii]; ro[ii] = O[eb][ii] * rstd * (gg / (1.f + __expf(-gg))); }
                u32x2 w; w.x = pk2h(ro[0], ro[1]); w.y = pk2h(ro[2], ro[3]); *(u32x2*)(gp + 32 * eb) = w; }
        }
    }
}
__device__ __forceinline__ void p_ret_out(const FrameU& F0, int gw, int ngw) {
    const Frame F = relaunder(F0);
    LAS f16* Vs = (LAS f16*)(F.lds + F.wave * (64 * RLD * 2));
#pragma unroll 1
    for (int item = gw; item < 8192; item += ngw) ret_out_item(F.ws, F.dout, Vs, F.lane, item);
}
#undef RPK
#undef RPKF

__device__ __forceinline__ unsigned wave_max_u(unsigned v) {
#define MX_(c, rm) { const unsigned t_ = (unsigned)__builtin_amdgcn_update_dpp(0, (int)v, c, rm, 0xf, false); v = v > t_ ? v : t_; }
    MX_(0x111, 0xf) MX_(0x112, 0xf) MX_(0x114, 0xf) MX_(0x118, 0xf) MX_(0x142, 0xa) MX_(0x143, 0xc)
#undef MX_
    return (unsigned)__builtin_amdgcn_readlane((int)v, 63);
}
__device__ __forceinline__ float wave_max_f(float v) {
#define MX_(c, rm) { const float t_ = __int_as_float(__builtin_amdgcn_update_dpp((int)0xFF800000, __float_as_int(v), c, rm, 0xf, false)); v = fmaxf(v, t_); }
    MX_(0x111, 0xf) MX_(0x112, 0xf) MX_(0x114, 0xf) MX_(0x118, 0xf) MX_(0x142, 0xa) MX_(0x143, 0xc)
#undef MX_
    return __int_as_float(__builtin_amdgcn_readlane(__float_as_int(v), 63));
}
__device__ __forceinline__ int lbin_clamp2(int b) { b = b < 0 ? 0 : b; return b > 2303 ? 2303 : b; }
__device__ __forceinline__ int lbin_clamp(int b) { b = b < 0 ? 0 : b; return b > 2047 ? 2047 : b; }
__device__ __forceinline__ float k2f(unsigned k) { const unsigned b = k ^ ((unsigned)((int)(~k) >> 31) | 0x80000000u); return __uint_as_float(b); }
__device__ __forceinline__ unsigned fkey(float v) { const unsigned b = __float_as_uint(v); return b ^ ((unsigned)((int)b >> 31) | 0x80000000u); }
#ifndef TK_RANK_MAX
#define TK_RANK_MAX 64
#endif
#ifndef TK_PROBE_SEC
#define TK_PROBE_SEC 0
#endif
#define TK_MARK(sec) do { if (TK_PROBE_SEC) { const unsigned long long t_ = __builtin_amdgcn_s_memrealtime(); if (TK_PROBE_SEC == (sec)) tk_acc += t_ - tk_t; tk_t = t_; } } while (0)
__device__ __forceinline__ unsigned long long p_topk(const FrameU& F0) {
    const Frame F = relaunder(F0);
    unsigned long long tk_acc = 0ull, tk_t = TK_PROBE_SEC ? __builtin_amdgcn_s_memrealtime() : 0ull;
    unsigned z0_ = 0u; asm volatile("" : "+v"(z0_)); const u32x4 zq_ = {z0_, z0_, z0_, z0_};
    LAS float* sc = (LAS float*)F.lds;
    LAS float* wqa = (LAS float*)(F.lds + 131072);
    const f16* QIDX = (const f16*)(F.dout + DO_QIDX); const f16* MISC = (const f16*)(F.ws + WS_MISC); const f16* IKC = (const f16*)(F.ws + WS_IKC); unsigned* MASK = (unsigned*)(F.dout + DO_MASK);
    const int tid = F.tid, lane = F.lane, wave = F.wave;
    const int m = lane & 31, hi = lane >> 5;
    const int am = m >> 3, ag = (m >> 2) & 1, ajj = m & 3;
    for (int cu = blockIdx.x; cu < 1024; cu += F.G) {
        const int kq = cu & 255, sel = cu >> 8, b = kq & 15, j = kq >> 4;
        const int c = sel == 0 ? j : (sel == 1 ? 31 - j : (sel == 2 ? 32 + j : 63 - j));
        const int N = 64 * (c + 1), tc0 = b * SEQ + 64 * c, NTe = c < 2 ? 4 : ((c + 2) & ~1), nb = N >> 5, ni = N >> 6;
        if (c < 4) {
#pragma unroll 1
            for (int q = wave; q < 64; q += NWAVES) { unsigned long long* mrow = (unsigned long long*)(MASK + (size_t)(tc0 + q) * 128); if (lane < NTe) mrow[lane] = lane < (c + 1) ? ~0ull : 0ull; }
            continue;
        }
        wqa[tid] = (float)MISC[(size_t)(tc0 + (tid >> 3)) * 256 + 160 + (tid & 7)];
        h8 Af[2][2];
#define TK_LOADA(sub) do { _Pragma("unroll") for (int ti = 0; ti < 2; ++ti) { const int q_ = 8 * (sub) + 4 * ti + 2 * ag + (am >> 1), hd_ = 4 * (am & 1) + ajj; \
            _Pragma("unroll") for (int ks = 0; ks < 2; ++ks) Af[ti][ks] = *(const h8*)(QIDX + (size_t)(tc0 + q_) * 256 + hd_ * 32 + 16 * ks + 8 * hi); } } while (0)
        TK_LOADA(0);
        __syncthreads();
        TK_MARK(5);
#pragma unroll 1
        for (int sub = 0; sub < 8; ++sub) {
            {
                float wv[2][16];
#pragma unroll
                for (int ti = 0; ti < 2; ++ti)
#pragma unroll
                    for (int rg = 0; rg < 16; ++rg) wv[ti][rg] = wqa[(8 * sub + 4 * ti + 2 * hi + (rg >> 3)) * 8 + (rg & 7)];
                const f16* kbase = IKC + (size_t)b * SEQ * 32 + m * 32 + 8 * hi;
                int kb = wave; h8 B0 = {}, B1 = {};
                if (kb < nb) { const f16* kp = kbase + (size_t)kb * 1024; B0 = *(const h8*)kp; B1 = *(const h8*)(kp + 16); }
                while (kb < nb) {
                    const int kn = kb + NWAVES; h8 n0 = {}, n1 = {};
                    if (kn < nb) { const f16* kp = kbase + (size_t)kn * 1024; n0 = *(const h8*)kp; n1 = *(const h8*)(kp + 16); }
                    f32x16 a0 = {}, a1 = {};
                    a0 = __builtin_amdgcn_mfma_f32_32x32x16_f16(Af[0][0], B0, a0, 0, 0, 0); a0 = __builtin_amdgcn_mfma_f32_32x32x16_f16(Af[0][1], B1, a0, 0, 0, 0);
                    a1 = __builtin_amdgcn_mfma_f32_32x32x16_f16(Af[1][0], B0, a1, 0, 0, 0); a1 = __builtin_amdgcn_mfma_f32_32x32x16_f16(Af[1][1], B1, a1, 0, 0, 0);
                    float s00 = 0.f, s01 = 0.f, s10 = 0.f, s11 = 0.f;
#pragma unroll
                    for (int rg = 0; rg < 8; ++rg) { s00 += wv[0][rg] * fmaxf(a0[rg], 0.f); s01 += wv[0][8 + rg] * fmaxf(a0[8 + rg], 0.f); s10 += wv[1][rg] * fmaxf(a1[rg], 0.f); s11 += wv[1][8 + rg] * fmaxf(a1[8 + rg], 0.f); }
                    const int key = kb * 32 + m;
                    sc[(2 * hi) * 4096 + key] = s00 + 0.f; sc[(2 * hi + 1) * 4096 + key] = s01 + 0.f; sc[(4 + 2 * hi) * 4096 + key] = s10 + 0.f; sc[(5 + 2 * hi) * 4096 + key] = s11 + 0.f;
                    B0 = n0; B1 = n1; kb = kn;
                }
            }
            if (sub < 7) TK_LOADA(sub + 1);
            TK_MARK(1);
            __syncthreads();
            {
                unsigned long long* mrow = (unsigned long long*)(MASK + (size_t)(tc0 + 8 * sub + wave) * 128);
                const LAS float* s = sc + wave * 4096;
                float f[64];
#pragma unroll
                for (int blk = 0; blk < 4; ++blk) {
                    if ((blk + 1) * 16 <= ni) {
#pragma unroll
                        for (int ii = 0; ii < 16; ++ii) f[blk * 16 + ii] = s[(blk * 16 + ii) * 64 + lane];
                    } else if (blk * 16 < ni) {
                        int rem = ni - blk * 16; asm volatile("" : "+v"(rem));
#pragma unroll
                        for (int ii = 0; ii < 16; ++ii) { const float v = s[(blk * 16 + ii) * 64 + lane]; f[blk * 16 + ii] = (ii < rem) ? v : __builtin_nanf(""); }
                    } else {
#pragma unroll
                        for (int ii = 0; ii < 16; ++ii) f[blk * 16 + ii] = __builtin_nanf("");
                    }
                }
                __syncthreads();
                TK_MARK(2);
                LAS unsigned* hist = (LAS unsigned*)F.lds + wave * 2560;
                LAS float* mlist = (LAS float*)(hist + 2304);
                float vmx = -INFINITY, vmnn = -INFINITY;
#pragma unroll
                for (int blk = 0; blk < 4; ++blk) if (blk * 16 < ni) {
#pragma unroll
                    for (int ii = 0; ii < 16; ++ii) { const float v = f[blk * 16 + ii]; vmx = fmaxf(vmx, v); vmnn = fmaxf(vmnn, -v); } }
                vmx = wave_max_f(vmx); vmnn = wave_max_f(vmnn);
                const float vlo = -vmnn, span = vmx - vlo;
                const float scl = (span > 0.f && span < 3.0e38f) ? 2301.5f / span : 0.f;
#define LBIN(x) lbin_clamp2((int)fmaf((x) - vlo, scl, 1.0f))
#pragma unroll
                for (int q_ = 0; q_ < 9; ++q_) *(LAS u32x4*)(hist + q_ * 256 + lane * 4) = zq_;
#pragma unroll
                for (int blk = 0; blk < 4; ++blk) if (blk * 16 < ni) {
#pragma unroll
                    for (int ii = 0; ii < 16; ++ii) __hip_atomic_fetch_add(hist + LBIN(f[blk * 16 + ii]), 1u, __ATOMIC_RELAXED, __HIP_MEMORY_SCOPE_WORKGROUP); }
                LDS_WAIT();
                int d1, krem;
                {
                    unsigned cb_[36];
#pragma unroll
                    for (int q_ = 0; q_ < 9; ++q_) { const u32x4 t_ = *(const LAS u32x4*)(hist + lane * 36 + q_ * 4); cb_[q_ * 4] = t_.x; cb_[q_ * 4 + 1] = t_.y; cb_[q_ * 4 + 2] = t_.z; cb_[q_ * 4 + 3] = t_.w; }
                    int tl_ = 0;
#pragma unroll
                    for (int q_ = 0; q_ < 36; ++q_) tl_ += (int)cb_[q_];
                    const int inc_ = wave_incl_scan(tl_), tot_ = __builtin_amdgcn_readlane(inc_, 63), Sx_ = tot_ - inc_;
                    const bool mine_ = (Sx_ < 256) && (256 <= Sx_ + tl_);
                    const unsigned long long bm_ = __ballot(mine_); const int src_ = bm_ ? (__ffsll((long long)bm_) - 1) : 0;
                    int acc_ = Sx_, dd_ = 0, gt_ = 0; bool fnd_ = false;
#pragma unroll
                    for (int q_ = 35; q_ >= 0; --q_) { const int c_ = (int)cb_[q_]; if (!fnd_ && acc_ + c_ >= 256) { dd_ = q_; gt_ = acc_; fnd_ = true; } acc_ += c_; }
                    dd_ += lane * 36; d1 = shfl_i(dd_, src_); krem = 256 - shfl_i(gt_, src_);
                }
                int mcnt = 0;
                const unsigned long long lt_mask = (1ull << lane) - 1ull;
                float scl2 = scl; asm volatile("" : "+v"(scl2));
#define LBINB(x) lbin_clamp2((int)fmaf((x) - vlo, scl2, 1.0f))
#pragma unroll
                for (int blk = 0; blk < 4; ++blk) if (blk * 16 < ni) {
#pragma unroll
                    for (int ii = 0; ii < 16; ++ii) { float v = f[blk * 16 + ii]; asm volatile("" : "+v"(v));
                        const bool isin = LBINB(v) == d1; const unsigned long long bm = __ballot(isin);
                        if (__builtin_expect(bm != 0ull, 0)) { const int pos = mcnt + __popcll(bm & lt_mask); if (isin && pos < 64) mlist[pos] = v; mcnt += __popcll(bm); } } }
#undef LBIN
#undef LBINB
                float thr; int need, ceq;
                if (__builtin_expect(mcnt <= TK_RANK_MAX, 1)) {
                    LDS_WAIT();
                    const float x = (lane < mcnt) ? mlist[lane] : __builtin_nanf("");
                    int cgt = 0, cge = 0;
#pragma unroll 1
                    for (int t = 0; t < mcnt; ++t) { const float y = mlist[t]; cgt += (y > x) ? 1 : 0; cge += (y >= x) ? 1 : 0; }
                    const bool holder = (lane < mcnt) && (cgt < krem) && (krem <= cge);
                    const unsigned long long bmh = __ballot(holder); const int srch = bmh ? (__ffsll((long long)bmh) - 1) : 0;
                    thr = __int_as_float(shfl_i(__float_as_int(x), srch)); need = krem - shfl_i(cgt, srch); ceq = shfl_i(cge - cgt, srch);
                } else {
                    unsigned tk = 0u;
#pragma unroll 1
                    for (int bit = 31; bit >= 0; --bit) { const unsigned cand = tk | (1u << bit); const float cf = k2f(cand); int cnt = 0;
#pragma unroll
                        for (int i = 0; i < 64; ++i) cnt += (f[i] >= cf) ? 1 : 0;
                        cnt = __builtin_amdgcn_readlane(wave_incl_scan(cnt), 63); if (cnt >= 256) tk = cand; }
                    const float tf = k2f(tk); int cg = 0, ce = 0;
#pragma unroll
                    for (int i = 0; i < 64; ++i) { cg += (f[i] > tf) ? 1 : 0; ce += (f[i] == tf) ? 1 : 0; }
                    cg = __builtin_amdgcn_readlane(wave_incl_scan(cg), 63); ce = __builtin_amdgcn_readlane(wave_incl_scan(ce), 63);
                    thr = k2f(tk); need = 256 - cg; ceq = ce;
                }
                TK_MARK(3);
                unsigned wlo = 0u, whi = 0u;
                if (need == ceq) {
#pragma unroll
                    for (int blk = 0; blk < 4; ++blk) if (blk * 16 < ni) {
#pragma unroll
                        for (int ii = 0; ii < 16; ++ii) { const int i = blk * 16 + ii; const unsigned long long bs = __ballot(f[i] >= thr);
                            asm volatile("s_nop 1\n\tv_writelane_b32 %0, %2, %4\n\tv_writelane_b32 %1, %3, %4" : "+v"(wlo), "+v"(whi) : "s"((unsigned)bs), "s"((unsigned)(bs >> 32)), "n"(i)); } }
                } else {
                    int tbf = 0;
#pragma unroll
                    for (int blk = 0; blk < 4; ++blk) if (blk * 16 < ni) {
#pragma unroll
                        for (int ii = 0; ii < 16; ++ii) { const int i = blk * 16 + ii; const float v = f[i]; const bool gtb = v > thr, eq = (v == thr);
                            const unsigned long long beq = __ballot(eq); const int rank = tbf + __popcll(beq & lt_mask);
                            const unsigned long long bs = __ballot(gtb || (eq && rank < need)); tbf += __popcll(beq);
                            asm volatile("s_nop 1\n\tv_writelane_b32 %0, %2, %4\n\tv_writelane_b32 %1, %3, %4" : "+v"(wlo), "+v"(whi) : "s"((unsigned)bs), "s"((unsigned)(bs >> 32)), "n"(i)); } }
                }
                if (lane < NTe) { u32x2 w2; w2.x = wlo; w2.y = whi; *(u32x2*)(mrow + lane) = w2; }
            }
            __syncthreads();
            TK_MARK(4);
        }
#undef TK_LOADA
    }
    return tk_acc;
}

__device__ __forceinline__ void p_dsa_attn_simple(const FrameU& F0) {
    const Frame F = relaunder(F0);
    f16* OLAT = (f16*)(F.ws + WS_H); const f16* CKVN = (const f16*)(F.ws + WS_CKVN); const unsigned* MASK = (const unsigned*)(F.dout + DO_MASK); const float* tb = (const float*)(F.ws + WS_TB);
    const int gw = blockIdx.x * NWAVES + F.wave, NGW = F.G * NWAVES, lane = F.lane;
    for (int task = gw; task < T * 8; task += NGW) {
        const int t = task >> 3, h = task & 7, b = t >> 12, tp = t & 4095, c = tp >> 6, N = 64 * (c + 1);
        h2* qp = (h2*)(OLAT + (size_t)t * 1024 + h * 128) + lane; const h2 qv = *qp; const float q0 = qv[0], q1 = qv[1];
        const unsigned* mrow = MASK + (size_t)t * 128;
        float m = -1e30f, ls = 0.f, o0 = 0.f, o1 = 0.f;
        for (int w = 0; w < N / 32; ++w) {
            unsigned bits = __builtin_amdgcn_readfirstlane(mrow[w]);
            while (bits) { const int bit = __builtin_ctz(bits); bits &= bits - 1u; const int s = 32 * w + bit;
                const h2 cv = *((const h2*)(CKVN + (size_t)(b * SEQ + s) * 128) + lane); const float c0 = cv[0], c1 = cv[1];
                const float part = wave_sum(q0 * c0 + q1 * c1, F.lane);
                const int rel = s - tp, ri = rel < -192 ? 0 : rel + 192;
                const float logit = part + tb[ri * 8 + h];
                const float mn = fmaxf(m, logit), al = __expf(m - mn), p = __expf(logit - mn);
                ls = ls * al + p; o0 = o0 * al + p * c0; o1 = o1 * al + p * c1; m = mn; }
        }
        const float inv = 1.f / ls;
        *(unsigned*)qp = pk2h(o0 * inv, o1 * inv);
    }
}


__device__ __forceinline__ void p_dsa_attn(const FrameU& F0, const float* relb) {
    const Frame F = relaunder(F0);
    f16* OLAT = (f16*)(F.ws + WS_H); const f16* CKVN = (const f16*)(F.ws + WS_CKVN); const unsigned long long* MASK = (const unsigned long long*)(F.dout + DO_MASK); const float* tb = (const float*)(F.ws + WS_TB);
    LAS float* tbl = (LAS float*)(F.lds + 69632);
    for (int e = F.tid; e < 4096; e += NTHREADS) { const int rel = (e >> 3) - 320, h = e & 7; int ri = rel + 192; ri = ri < 0 ? 0 : ri; tbl[e] = (ri < 256 ? tb[ri * 8 + h] : relb[t5_bucket(rel) * 8 + h]) - tb[h]; }
    for (int idx = blockIdx.x; idx < 2048; idx += F.G) {
        const int kq = idx & 255, r = idx >> 8, b = kq & 15, j = kq >> 4, sel = r >> 1, half = r & 1;
        const int c = sel == 0 ? j : (sel == 1 ? 31 - j : (sel == 2 ? 32 + j : 63 - j));
        const int NTe = c < 2 ? 4 : ((c + 2) & ~1), tq0 = 64 * c + 32 * half; const size_t t0 = (size_t)b * SEQ + tq0;
        __syncthreads();
        att::dsa_attn_unit(OLAT + t0 * 1024, CKVN + (size_t)b * SEQ * 128, MASK + t0 * 64, NTe, tq0, tbl, F.ldsg, F.wave);
    }
}


__device__ __forceinline__ unsigned long long p_dsa_attn_gw(const FrameU& F0, const float* relb, unsigned* ctr) {
    unsigned long long acc_ = 0ull;
    const Frame F = relaunder(F0);
    f16* OLAT = (f16*)(F.ws + WS_H); const f16* CKVN = (const f16*)(F.ws + WS_CKVN); const unsigned long long* MASK = (const unsigned long long*)(F.dout + DO_MASK);
    LAS float* tbl = (LAS float*)(F.lds + 8 * att::GW_BYTES);
    for (int e = F.tid; e < 2048; e += NTHREADS) { const int rel = (e >> 3) - 128, h = e & 7; tbl[e] = (e >> 3) == 0 ? 0.f : relb[t5_bucket(rel) * 8 + h] - relb[15 * 8 + h]; }
    __syncthreads();
    LAS unsigned char* wl = F.lds + F.wave * att::GW_BYTES;
    unsigned* qctr = ctr + 64 * (blockIdx.x & 7);
    constexpr bool RIA = RET_IN_ATTN && RET_SPLIT3 && !RET_SIMPLE;
    constexpr int NATT = ATT16 ? 4096 : 2048, PER = ATT16 ? 4 : 2, QN = NATT + (RIA ? 1024 : 0);
#define Q_PULL(v) do { if (F.lane == 0) v = (int)__hip_atomic_fetch_add(qctr, 1u, __ATOMIC_RELAXED, __HIP_MEMORY_SCOPE_AGENT); } while (0)
#define Q_DEC(it, ai, isret) do { ai = (it); isret = false; if (RIA) { const int qq_ = (it) / (PER + 1), rr_ = (it) - (PER + 1) * qq_; isret = rr_ == PER; ai = isret ? qq_ : PER * qq_ + rr_; } } while (0)
#if ATT16
    int item = 0, nxt = 0, nx2 = 0;
    Q_PULL(item); item = __builtin_amdgcn_readfirstlane(item); Q_PULL(nxt); nxt = __builtin_amdgcn_readfirstlane(nxt);
    att::Pre16 pre;
#define Q_PRE(P, an_) do { const int c2 = 63 - ((an_) >> 6), b2 = (blockIdx.x & 7) + 8 * (((an_) >> 5) & 1), tq2 = 64 * c2 + 32 * (((an_) >> 4) & 1) + 2 * ((an_) & 15); const size_t tw2 = (size_t)b2 * SEQ + tq2; \
        att::pre16_load(P, OLAT + tw2 * 1024, MASK + tw2 * 64, c2 + 1, F.lane); } while (0)
    { int a0; bool r0; Q_DEC(item, a0, r0); if (item < QN && !r0) Q_PRE(pre, a0); }
    while (item < QN) {
        Q_PULL(nx2);
        int ai, an; bool isret, nret; Q_DEC(item, ai, isret); Q_DEC(nxt, an, nret);
        const bool npre = nxt < QN && !nret;
        if (isret) {
            ret_out_item(F.ws, F.dout, (LAS f16*)wl, F.lane, (((blockIdx.x & 7) + 8 * (ai >> 9)) * 8) * 64 + (ai & 511));
            if (npre) Q_PRE(pre, an);
        } else {
            const int c = 63 - (ai >> 6), b = (blockIdx.x & 7) + 8 * ((ai >> 5) & 1), tq = 64 * c + 32 * ((ai >> 4) & 1) + 2 * (ai & 15); const size_t tw = (size_t)b * SEQ + tq;
            att::Pre16 pn = pre;
            if (npre) Q_PRE(pn, an);
            acc_ += att::dsa_attn_wave16(OLAT + tw * 1024, CKVN + (size_t)b * SEQ * 128, pre, c + 1, tq, tbl, wl, F.lane);
            pre = pn;
        }
        item = nxt; nxt = __builtin_amdgcn_readfirstlane(nx2);
    }
#undef Q_PRE
#else
    int item = 0, nxt = 0;
    Q_PULL(item); item = __builtin_amdgcn_readfirstlane(item);
    while (item < QN) {
        Q_PULL(nxt);
        int ai; bool isret; Q_DEC(item, ai, isret);
        if (isret) {
            ret_out_item(F.ws, F.dout, (LAS f16*)wl, F.lane, (((blockIdx.x & 7) + 8 * (ai >> 9)) * 8) * 64 + (ai & 511));
        } else {
            const int c = 63 - (ai >> 5), b = (blockIdx.x & 7) + 8 * ((ai >> 4) & 1), half = (ai >> 3) & 1, wg = ai & 7;
            const int tq = 64 * c + 32 * half + 4 * wg; const size_t tw = (size_t)b * SEQ + tq;
            acc_ += att::dsa_attn_wave32(OLAT + tw * 1024, CKVN + (size_t)b * SEQ * 128, MASK + tw * 64, c + 1, tq, tbl, wl, F.lane);
        }
        item = __builtin_amdgcn_readfirstlane(nxt);
    }
#endif
#undef Q_PULL
#undef Q_DEC
    __syncthreads();
    return acc_;
}

constexpr int PH_PRO = 0, PH_PER_LAYER = 11, PH_FINAL = 1 + DEPTH * PH_PER_LAYER, NPHASES = PH_FINAL + 1;
#ifndef PG8_SP2
#define PG8_SP2 true
#endif
#ifndef PG8_ALIGN
#define PG8_ALIGN true
#endif

__global__ void __launch_bounds__(NTHREADS, 2) mega_fwd(Args args) {
    extern __shared__ __attribute__((aligned(16))) unsigned char lds[];
    KArgs kp = (KArgs)__builtin_amdgcn_kernarg_segment_ptr();
    asm volatile("" : "+s"(kp));
    FrameU F;
    F.lds = (LAS unsigned char*)lds; F.ldsg = (char*)lds; F.ws = args.ws; F.dout = (unsigned char*)args.out; F.G = gridDim.x; F.wave0 = __builtin_amdgcn_readfirstlane(threadIdx.x >> 6);
    volatile LAS unsigned* MISCW = (volatile LAS unsigned*)(F.lds + LDSCTL_OFF);
    if (threadIdx.x < 64) MISCW[threadIdx.x] = 0u;
    __syncthreads();
    unsigned* ctl = (unsigned*)(args.ws + WS_CTL);
    XcdBarrier bar; bar.bar = ctl + CW_BAR; bar.x = 0; bar.st = MISCW + 8; bar.wave = F.wave0;
    const int lo = args.ph_lo, hi = args.ph_hi;
    if (hi - lo > 1) bar = xcd_barrier_post(ctl + CW_BAR, MISCW + 8, F.wave0);
#ifndef PHMASK
#define PHMASK 0xFFFF
#endif
#define HAS(p) ((PHMASK >> (p)) & 1)
#define IN(k) (lo <= (k) && (k) < hi)
#ifndef PROBE_MASK
#define PROBE_MASK 0
#endif
#ifndef PROBE_MULT
#define PROBE_MULT 8
#endif
    unsigned long long pr_acc = 0ull, pr_prev = PROBE_MASK ? __builtin_amdgcn_s_memrealtime() : 0ull;
#define SEAM_T(k, bit) do { if (IN(k) && IN((k) + 1)) xcd_barrier(bar); if (PROBE_MASK) { const unsigned long long t_ = __builtin_amdgcn_s_memrealtime(); if ((PROBE_MASK >> (bit)) & 1) pr_acc += t_ - pr_prev; pr_prev = t_; } } while (0)
#define SEAM(k) SEAM_T(k, (k) == PH_PRO ? 11 : ((k) - 1) % PH_PER_LAYER)
    const int NGW = F.G * NWAVES;
#define GW (blockIdx.x * NWAVES + F.wave0)
    unsigned char* ws0 = args.ws;
    float* xout0 = args.out;
#define PHASE_PTRS GAS unsigned char* wsg_ = (GAS unsigned char*)ws0; GAS float* xog_ = (GAS float*)xout0; asm volatile("" : "+s"(wsg_), "+s"(xog_)); unsigned char* ws = (unsigned char*)wsg_; float* xout = (float*)xog_; unsigned char* dob = (unsigned char*)xog_; (void)dob; unsigned char* wl = ws + WS_W + (size_t)l * W_LAYER; (void)wl; (void)xout; int bx_ = blockIdx.x, gg_ = F.G; asm volatile("" : "+s"(bx_), "+s"(gg_)); (void)bx_; (void)gg_;

    if (HAS(11) && IN(PH_PRO)) { const unsigned long long p_ = p_prologue(F, kp); if (PRO_PROBE_SEC) pr_acc += p_; }
    SEAM(PH_PRO);

    for (int l = 0; l < DEPTH; ++l) {
        const int P0 = 1 + l * PH_PER_LAYER;

        if (HAS(1) && IN(P0 + 1)) { PHASE_PTRS
            {
              pg8::Order<1> S; S.init(T, NZ, gg_, bx_);
              pg8::EpiF16<0> E{};
              E.base[0] = (f16*)(ws + WS_RQ); E.ld[0] = 512; E.lo[0] = 0;
              E.base[1] = (f16*)(ws + WS_RK); E.ld[1] = 512; E.lo[1] = 2;
              E.base[2] = (f16*)(ws + WS_RV); E.ld[2] = 512; E.lo[2] = 4;
              E.base[3] = (f16*)(dob + DO_GM); E.ld[3] = 1024; E.lo[3] = 6;
              E.base[4] = (f16*)(ws + WS_CQ); E.ld[4] = 256; E.lo[4] = 8;
              E.base[5] = (f16*)(ws + WS_MISC); E.ld[5] = 256; E.lo[5] = 9;
              E.base[6] = (f16*)(dob + DO_GM) + 512; E.ld[6] = 1024; E.lo[6] = 10;
              E.base[7] = (f16*)(ws + WS_GATES); E.ld[7] = 3072; E.lo[7] = 12; E.nd = 8; E.ss = (const f16*)(ws + WS_SS1);
              pg8::gemm_phase<pg8::EpiF16<0>, 1, PG8_ALIGN, PG8_SP2>(F.lds, (const f16*)(ws + WS_X16), nullptr, nullptr, (const f16*)(wl + W_IN), nullptr, nullptr, DM, 0, 0, DM, DM, S, E, F.wave0); }
            {
              pg8::Order<1> S; S.init(BATCH * MEMLEN, 1024, gg_, bx_);
              pg8::EpiF16<0> E{}; E.base[0] = (f16*)(ws + WS_MKV); E.ld[0] = 1024; E.lo[0] = 0; E.nd = 1;
              pg8::gemm_phase<pg8::EpiF16<0>, 1, PG8_ALIGN, PG8_SP2>(F.lds, (const f16*)(ws + WS_MEMN), nullptr, nullptr, (const f16*)(wl + W_MKV), nullptr, nullptr, DM, 0, 0, DM, DM, S, E, F.wave0); }
        }
        SEAM(P0 + 1);
        if (HAS(2) && IN(P0 + 2)) { PHASE_PTRS
#if RET_SIMPLE
            if (F.G >= 256) { if (blockIdx.x >= 128) p_dsa_norms(F, kp, l, GW - 128 * NWAVES, (F.G - 128) * NWAVES); }
            else p_dsa_norms(F, kp, l, GW, NGW);
            for (int u = blockIdx.x; u < 128; u += F.G) p_retention_simple(F, u);
#elif RET_SPLIT3
            p_ret_kv(F, GW, NGW);
            p_dsa_norms(F, kp, l, GW, NGW);
#else
            p_dsa_norms(F, kp, l, GW, NGW);
            for (int u = blockIdx.x; u < 128 * NSEGR; u += F.G) p_retention(F, u);
#endif
        }
        SEAM(P0 + 2);
        if (HAS(3) && IN(P0 + 3)) { PHASE_PTRS
#if RET_SPLIT3 && !RET_SIMPLE
            p_ret_scan(F, GW, NGW);
#endif
            pg8::Order<1> S; S.init(T, 1280, gg_, bx_);
            pg8::EpiF16<0> E{}; E.base[0] = (f16*)(ws + WS_H); E.ld[0] = 1024; E.lo[0] = 0; E.base[1] = (f16*)(dob + DO_QIDX); E.ld[1] = 256; E.lo[1] = 4; E.nd = 2;
            pg8::gemm_phase<pg8::EpiF16<0>, 1, PG8_ALIGN, PG8_SP2>(F.lds, (const f16*)(ws + WS_CQ), nullptr, nullptr, (const f16*)(wl + W_DQ), nullptr, nullptr, 256, 0, 0, 256, 256, S, E, F.wave0);
        }
        SEAM(P0 + 3);
        if (HAS(4) && IN(P0 + 4)) {
#if RET_SPLIT3 && !RET_SIMPLE && !RET_IN_ATTN
            p_ret_out(F, GW, NGW); __syncthreads();
#endif
            const unsigned long long tk_ = p_topk(F); if (TK_PROBE_SEC) pr_acc += tk_; }
        SEAM(P0 + 4);
        if (HAS(5) && IN(P0 + 5)) { PHASE_PTRS
#if DSA_SIMPLE
            p_dsa_attn_simple(F);
#else
#if DSA_GATHER
            { const unsigned long long a_ = p_dsa_attn_gw(F, INP(kp, I_RELBIAS), (unsigned*)(ws + WS_CTL) + CW_ATTQ + 512 * l); if (ATT_PROBE_SEC) pr_acc += a_; }
#else
            p_dsa_attn(F, INP(kp, I_RELBIAS));
#endif
#endif
            f16* GM = (f16*)(dob + DO_GM); const f16* MKV = (const f16*)(ws + WS_MKV);
            for (int u = blockIdx.x; u < BATCH * 4 * 16; u += F.G) {
                const int b = u >> 6, h = (u >> 4) & 3, qb = u & 15;
                f16* q = GM + (size_t)(b * SEQ + qb * 256) * 1024 + 512 + h * 128; const f16* k = MKV + (size_t)(b * MEMLEN) * 1024 + h * 128;
                __syncthreads();
                att::attn_dense_body<1024, 1024, 1024>(q, k, k + 512, q, MEMLEN, F.ldsg, 0.088388347648318440f, F.wave0);
            }
        }
        SEAM(P0 + 5);
        if (HAS(6) && IN(P0 + 6)) { PHASE_PTRS
            const f16* GM = (const f16*)(dob + DO_GM); const f16* WRM = (const f16*)(wl + W_RM);

            pg8::Order<3> S; S.init(T, 1024, gg_, bx_);
            pg8::EpiMerge E{(const f16*)(ws + WS_GATES), (f16*)(dob + DO_MERGED)};
            pg8::gemm_phase<pg8::EpiMerge, 3, PG8_ALIGN, PG8_SP2>(F.lds, GM, (const f16*)(ws + WS_H), GM + 512, WRM, (const f16*)(wl + W_VO), WRM + 512, 512, 1024, 512, 1024, 1024, S, E, F.wave0);
        }
        SEAM(P0 + 6);
        if (HAS(7) && IN(P0 + 7)) { PHASE_PTRS

            pg8::Order<1> S; S.init(T, DM, gg_, bx_);
            pg8::EpiRes E{(f16*)(ws + WS_X16), (f16*)(ws + WS_SS2), (LAS float*)(F.lds + 131072)};
            pg8::gemm_phase<pg8::EpiRes, 1, PG8_ALIGN, PG8_SP2>(F.lds, (const f16*)(dob + DO_MERGED), nullptr, nullptr, (const f16*)(wl + W_OUT), nullptr, nullptr, DM, 0, 0, DM, DM, S, E, F.wave0);
        }
        SEAM(P0 + 7);
        if (HAS(9) && IN(P0 + 9)) { PHASE_PTRS

            pg8::Order<1> S; S.init(T, FF, gg_, bx_);
            pg8::EpiF16<1, false> E{}; E.base[0] = (f16*)(ws + WS_HID); E.ld[0] = FF; E.lo[0] = 0; E.nd = 1; E.ss = (const f16*)(ws + WS_SS2);
            pg8::gemm_phase<pg8::EpiF16<1, false>, 1, PG8_ALIGN, PG8_SP2>(F.lds, (const f16*)(ws + WS_X16), nullptr, nullptr, (const f16*)(wl + W_FF1), nullptr, nullptr, DM, 0, 0, DM, DM, S, E, F.wave0);
        }
        SEAM(P0 + 9);
        if (HAS(10) && IN(P0 + 10)) { PHASE_PTRS

            pg8::Order<1> S; S.init(T, DM, gg_, bx_);
            if (l + 1 < DEPTH) norm_rows_f16(F, INP(kp, I_MEM), INP(kp, I_MEMNORM) + (l + 1) * DM, (f16*)(ws + WS_MEMN), BATCH * MEMLEN, GW, NGW);
            pg8::EpiRes E{(f16*)(ws + WS_X16), (l + 1 < DEPTH) ? (f16*)(ws + WS_SS1) : (f16*)nullptr, (LAS float*)(F.lds + 131072)};
            pg8::gemm_phase<pg8::EpiRes, 1, PG8_ALIGN, PG8_SP2>(F.lds, (const f16*)(ws + WS_HID), nullptr, nullptr, (const f16*)(wl + W_FF2), nullptr, nullptr, FF, 0, 0, FF, FF, S, E, F.wave0);
        }
        SEAM(P0 + 10);
    }
    if ((PROBE_MASK || TK_PROBE_SEC || ATT_PROBE_SEC || PRO_PROBE_SEC) && blockIdx.x == 0 && F.wave0 == 0) { const unsigned long long t0_ = __builtin_amdgcn_s_memrealtime(); while (__builtin_amdgcn_s_memrealtime() - t0_ < pr_acc * PROBE_MULT) __builtin_amdgcn_s_sleep(8); }
    if (HAS(12) && IN(PH_FINAL)) { const int l = 0; PHASE_PTRS norm_rows_final(F, (const f16*)(ws + WS_X16), xout, INP(kp, I_FINALNORM), T, GW, NGW); }
#undef IN
#undef SEAM
}

extern "C" void kernel_launch(void* const* d_in, const int* in_sizes, int n_in, void* d_out, int out_size, void* d_ws, size_t ws_size, hipStream_t stream) {
    static int grid = 0;
    if (grid == 0) {
        if (n_in != 21 || in_sizes[0] != T * DM || out_size != T * DM || ws_size < WS_END) {
            fprintf(stderr, "kernel_launch: shape mismatch (n_in %d, in0 %d, out %d, ws %zu < %zu); nothing launched\n", n_in, n_in > 0 ? in_sizes[0] : -1, out_size, ws_size, (size_t)WS_END); grid = -1; return; }
        int dev = 0, cus = 0;
        if (hipGetDevice(&dev) != hipSuccess || hipDeviceGetAttribute(&cus, hipDeviceAttributeMultiprocessorCount, dev) != hipSuccess) { grid = -1; return; }
        if (hipFuncSetAttribute((const void*)mega_fwd, hipFuncAttributeMaxDynamicSharedMemorySize, LDS_BYTES) != hipSuccess) { fprintf(stderr, "kernel_launch: hipFuncSetAttribute failed\n"); grid = -1; return; }
        int per_cu = 0;
        if (hipOccupancyMaxActiveBlocksPerMultiprocessor(&per_cu, (const void*)mega_fwd, NTHREADS, LDS_BYTES) != hipSuccess || per_cu < 1)
            fprintf(stderr, "kernel_launch: note: occupancy query reports %d workgroups per CU\n", per_cu);
        (void)hipGetLastError();
        grid = cus;
    }
    if (grid < 0) return;
    (void)hipMemsetAsync((char*)d_ws + WS_CTL, 0, CTL_ZERO_BYTES, stream);
    Args a{};
    for (int i = 0; i < 21; ++i) a.in[i] = (const float*)d_in[i];
    a.out = (float*)d_out; a.ws = (unsigned char*)d_ws;
#if MK_SPLIT
    for (int p = 0; p < NPHASES; ++p) { a.ph_lo = p; a.ph_hi = p + 1; hipLaunchKernelGGL(mega_fwd, dim3(grid), dim3(NTHREADS), LDS_BYTES, stream, a); }
#else
    a.ph_lo = 0; a.ph_hi = NPHASES; hipLaunchKernelGGL(mega_fwd, dim3(grid), dim3(NTHREADS), LDS_BYTES, stream, a);
#endif
    const hipError_t le = hipPeekAtLastError();
    if (le != hipSuccess) fprintf(stderr, "kernel_launch: launch failed: %s\n", hipGetErrorName(le));
}
```

```cpp
#include <hip/hip_runtime.h>
#include <cstdio>
#include <cstdint>

#ifndef DSA_GATHER
#define DSA_GATHER 1
#endif
#ifndef DSA_SIMPLE
#define DSA_SIMPLE 0
#endif
#ifndef RET_SIMPLE
#define RET_SIMPLE 0
#endif
#ifndef MK_SPLIT
#define MK_SPLIT 0
#endif
#ifndef RET_SPLIT3
#define RET_SPLIT3 1
#endif
#ifndef RET_IN_ATTN
#define RET_IN_ATTN 1
#endif
#ifndef ATT16
#define ATT16 1
#endif
#ifndef P2_DYN
#define P2_DYN 1
#endif

#define GAS __attribute__((address_space(1)))
#define LAS __attribute__((address_space(3)))
typedef _Float16 f16;
typedef _Float16 h8 __attribute__((ext_vector_type(8)));
typedef _Float16 h4 __attribute__((ext_vector_type(4)));
typedef _Float16 h2 __attribute__((ext_vector_type(2)));
typedef float f32x2 __attribute__((ext_vector_type(2)));
typedef float f32x4 __attribute__((ext_vector_type(4)));
typedef float f32x8 __attribute__((ext_vector_type(8)));
typedef float f32x16 __attribute__((ext_vector_type(16)));
typedef unsigned u32x4 __attribute__((ext_vector_type(4)));
typedef unsigned u32x2 __attribute__((ext_vector_type(2)));

constexpr int BATCH = 16, SEQ = 4096, DM = 1024, T = BATCH * SEQ, DEPTH = 2;
constexpr int NIN = 6056, NZ = 6144, FF = 4096, MEMLEN = 256;
constexpr int NWAVES = 8, NTHREADS = 512;

constexpr size_t MiB = 1u << 20;
constexpr size_t WS_CTL = 0, CTL_ZERO_BYTES = 1 * MiB;
constexpr size_t WS_ROPE = 1 * MiB;
constexpr size_t WS_TB = 2 * MiB;
constexpr size_t WS_W = 3 * MiB, W_LAYER = 37 * MiB;
constexpr size_t W_IN = 0, W_DQ = 12 * MiB, W_MKV = 13 * MiB, W_RM = 15 * MiB, W_VO = 17 * MiB, W_OUT = 19 * MiB, W_FF1 = 21 * MiB, W_FF2 = 29 * MiB;
constexpr size_t WS_MEMN = 77 * MiB, WS_MKV = 85 * MiB;
constexpr size_t WS_H = 221 * MiB;
constexpr size_t WS_RQ = 349 * MiB;
constexpr size_t WS_RK = 413 * MiB;
constexpr size_t WS_RV = 477 * MiB;
constexpr size_t WS_X16 = 93 * MiB;
constexpr size_t DO_GM = 0;
constexpr size_t DO_MERGED = 128 * MiB;
constexpr size_t WS_CQ = 541 * MiB;
constexpr size_t WS_MISC = 573 * MiB;
constexpr size_t WS_GATES = 605 * MiB;
constexpr size_t WS_CKVN = 989 * MiB;
constexpr size_t WS_HID = 221 * MiB;
constexpr size_t WS_IKC = 1005 * MiB;
constexpr size_t WS_SS1 = 1009 * MiB;
constexpr size_t WS_SS2 = 1013 * MiB;
constexpr size_t WS_END = 1017 * MiB;
constexpr size_t DO_QIDX = 192 * MiB, DO_MASK = 224 * MiB;

constexpr int LDS_BYTES = 163840;
constexpr int LDSCTL_OFF = LDS_BYTES - 256;

#define XB_TMO      128
#define XB_XCNT(j)  (256  + 64 * (j))
#define XB_XSUB(j)  (1280 + 64 * (j))
#define XB_XGEN(j)  (2304 + 64 * (j))
#define XB_TOP      3328
#define XB_TOPGEN   3392
#define XCD_BAR_WORDS 3456
#define XB_SPIN_CAP (1u << 21)
constexpr int CW_BAR = 4096;
constexpr int CW_P2Q = 20480;
constexpr int CW_ATTQ = 16384;

__device__ __forceinline__ unsigned xb_ld(unsigned* p)              { return __hip_atomic_load(p, __ATOMIC_RELAXED, __HIP_MEMORY_SCOPE_AGENT); }
__device__ __forceinline__ unsigned xb_add(unsigned* p, unsigned v) { return __hip_atomic_fetch_add(p, v, __ATOMIC_RELAXED, __HIP_MEMORY_SCOPE_AGENT); }
__device__ __forceinline__ unsigned xb_xcc_id() { return (unsigned)__builtin_amdgcn_s_getreg((3 << 11) | 20) & 0xFu; }
#define XB_SPIN(cond, bar) do { unsigned _sp = 0; while (cond) { __builtin_amdgcn_s_sleep(1); \
    if ((++_sp & 255u) == 0u) { if (xb_ld(&(bar)[XB_TMO])) break; if (_sp > XB_SPIN_CAP) { atomicAdd(&(bar)[XB_TMO], 1u); break; } } } } while (0)

struct XcdBarrier { unsigned* bar; unsigned x; volatile LAS unsigned* st; int wave; };

__device__ __forceinline__ int lane_now();
__device__ __forceinline__ bool xb_leader(int wave) { return wave == 0 && lane_now() == 0; }
__device__ __forceinline__ XcdBarrier xcd_barrier_post(unsigned* bar, volatile LAS unsigned* st, int wave) {
    XcdBarrier b; b.bar = bar; b.x = xb_xcc_id(); b.st = st; b.wave = wave;
    if (xb_leader(wave)) (void)xb_add(&bar[XB_XCNT(b.x)], 1u);
    return b;
}
__device__ __forceinline__ void xcd_barrier_complete(unsigned* bar, unsigned x, unsigned& nloc, unsigned& nx) {
    const unsigned G = gridDim.x * gridDim.y * gridDim.z;
    unsigned sum, cnt, mine, sp = 0u;
    for (;;) {
        sum = 0u; cnt = 0u; mine = 0u;
#pragma unroll
        for (unsigned j = 0; j < 16; ++j) { const unsigned c = xb_ld(&bar[XB_XCNT(j)]); sum += c; cnt += (c > 0u) ? 1u : 0u; mine = (j == x) ? c : mine; }
        if (sum == G) break;
        __builtin_amdgcn_s_sleep(1);
        if ((++sp & 255u) == 0u) { if (xb_ld(&bar[XB_TMO])) break; if (sp > XB_SPIN_CAP) { atomicAdd(&bar[XB_TMO], 1u); break; } }
    }
    nloc = mine > 0u ? mine : 1u; nx = cnt > 0u ? cnt : 1u;
}
__device__ __forceinline__ void xcd_barrier(const XcdBarrier& b0) {
    asm volatile("s_waitcnt vmcnt(0)" ::: "memory");
    __syncthreads();
    XcdBarrier b = b0; { GAS unsigned* p_ = (GAS unsigned*)b0.bar; unsigned x_ = b0.x; asm volatile("" : "+s"(p_), "+s"(x_)); b.bar = (unsigned*)p_; b.x = x_; }
    if (xb_leader(b.wave)) {
        unsigned* bar = b.bar;
        __builtin_amdgcn_s_waitcnt(0);
        unsigned nloc = b.st[0], nx = b.st[1];
        if (nloc == 0u) { xcd_barrier_complete(bar, b.x, nloc, nx); b.st[0] = nloc; b.st[1] = nx; }
        const unsigned old = xb_add(&bar[XB_XSUB(b.x)], 1u);
        const unsigned gen = old / nloc;
        if (old + 1u == (gen + 1u) * nloc) {
            __builtin_amdgcn_fence(__ATOMIC_RELEASE, "agent");
            asm volatile("s_waitcnt vmcnt(0)" ::: "memory");
            const unsigned og = xb_add(&bar[XB_TOP], 1u);
            const unsigned tg = og / nx;
            if (og + 1u == (tg + 1u) * nx) xb_add(&bar[XB_TOPGEN], 1u);
            else XB_SPIN(xb_ld(&bar[XB_TOPGEN]) == tg, bar);
            __builtin_amdgcn_fence(__ATOMIC_ACQUIRE, "agent");
            xb_add(&bar[XB_XGEN(b.x)], 1u);
            asm volatile("s_waitcnt vmcnt(0)" ::: "memory");
        } else {
            XB_SPIN(xb_ld(&bar[XB_XGEN(b.x)]) == gen, bar);
            __builtin_amdgcn_fence(__ATOMIC_ACQUIRE, "agent");
            asm volatile("s_waitcnt vmcnt(0)" ::: "memory");
        }
    }
    __syncthreads();
}

__device__ __forceinline__ int lane_now() { int l; asm volatile("v_mbcnt_lo_u32_b32 %0, -1, 0\n\tv_mbcnt_hi_u32_b32 %0, -1, %0" : "=v"(l)); return l; }
__device__ __forceinline__ int tid_of(int wave) { return wave * 64 + lane_now(); }
__device__ __forceinline__ unsigned pk2h(float lo, float hi) { const h2 p = __builtin_convertvector((f32x2){lo, hi}, h2); return __builtin_bit_cast(unsigned, p); }
__device__ __forceinline__ float sx(float v, int o, int lane) { return __int_as_float(__builtin_amdgcn_ds_bpermute((lane ^ o) << 2, __float_as_int(v))); }
__device__ __forceinline__ int shfl_i(int v, int src) { return __builtin_amdgcn_ds_bpermute(src << 2, v); }
__device__ __forceinline__ float wave_sum(float v, int lane) {
#pragma unroll
    for (int o = 1; o < 64; o <<= 1) v += sx(v, o, lane);
    return v;
}
__device__ __forceinline__ int wave_incl_scan(int v) {
    v += __builtin_amdgcn_update_dpp(0, v, 0x111, 0xf, 0xf, false); v += __builtin_amdgcn_update_dpp(0, v, 0x112, 0xf, 0xf, false);
    v += __builtin_amdgcn_update_dpp(0, v, 0x114, 0xf, 0xf, false); v += __builtin_amdgcn_update_dpp(0, v, 0x118, 0xf, 0xf, false);
    v += __builtin_amdgcn_update_dpp(0, v, 0x142, 0xa, 0xf, false); v += __builtin_amdgcn_update_dpp(0, v, 0x143, 0xc, 0xf, false);
    return v;
}
#define LDS_WAIT() asm volatile("s_waitcnt lgkmcnt(0)" ::: "memory")

namespace pg8 {
constexpr int BM = 256, BK = 64, HALF = 128, HTB = HALF * BK * 2, STAGE_BYTES = 8 * HTB, NXCD = 8, WGM = 8;
__host__ __device__ __forceinline__ int lds_byte(int r, int c) { const int st = (r >> 4) * 2 + (c >> 5), rr = r & 15, cc = c & 31, ob = rr * 64 + cc * 2; return st * 1024 + (ob ^ (((ob >> 9) & 1) << 5)); }
__host__ __device__ __forceinline__ void stage_rc(int b, int& R, int& C) { const int st = b / 1024, sb = b % 1024, swz = sb ^ (((sb >> 9) & 1) << 5); R = (st >> 1) * 16 + swz / 64; C = (st & 1) * 32 + (swz % 64) / 2; }
__host__ __device__ __forceinline__ int perm32(int rho) { const int n = rho >> 4, i = rho & 15; return 8 * (i >> 2) + 4 * n + (i & 3); }

struct Unit { int pm, pn, seg; };

template <int NSEG> struct Order {
    int nM, nN, nwg, G, c;
    __device__ void init(int M, int N, int G_, int c_) { nM = M / BM; nN = N / BM; nwg = nM * nN; G = G_; c = c_; }
    __device__ bool next(int i, Unit& u) const {
        const int ti = i / NSEG; u.seg = i - ti * NSEG;
        const long L = (long)ti * G + c; if (L >= nwg) return false;
        int wgid = (int)L; { const int q = nwg / NXCD, r = nwg % NXCD, xcd = wgid % NXCD, off = wgid / NXCD; wgid = (xcd < r ? xcd * (q + 1) : r * (q + 1) + (xcd - r) * q) + off; }
        const int nig = WGM * nN, gid = wgid / nig, fm = gid * WGM, gsz = (nM - fm) < WGM ? (nM - fm) : WGM;
        u.pm = fm + ((wgid % nig) % gsz); u.pn = (wgid % nig) / gsz; return true;
    }
};
__device__ __forceinline__ unsigned long long pick3(int seg, unsigned long long v0, unsigned long long v1, unsigned long long v2) {
    const unsigned long long m1 = (unsigned long long)0 - (unsigned long long)(seg == 1), m2 = (unsigned long long)0 - (unsigned long long)(seg == 2);
    return v0 + ((v1 - v0) & m1) + ((v2 - v0) & m2);
}

template <int ACT  , bool PF = true  > struct EpiF16 {
    static constexpr bool PERM = true;
    f16* base[8]; int ld[8]; int lo[8]; int nd;
    const f16* ss;
    struct Pre { h2 pa[2][2]; };
    __device__ __forceinline__ void prefetch(Pre& p, const Unit& u, int wr, int wc, int fr, int fq) const {
        if (PF && ss) { const int row0 = u.pm * BM + wr * 64 + fr;
#pragma unroll
            for (int ai = 0; ai < 2; ++ai)
#pragma unroll
                for (int mm = 0; mm < 2; ++mm) { h2 v; v.x = ss[(size_t)(row0 + ai * HALF + (2 * mm) * 16) * 4 + fq]; v.y = ss[(size_t)(row0 + ai * HALF + (2 * mm + 1) * 16) * 4 + fq]; p.pa[ai][mm] = v; } }
    }
    __device__ __forceinline__ void operator()(f32x4 (&acc)[2][2][4][2], const Unit& u, int wr, int wc, int fr, int fq, const Pre& pre_in) const {
        Pre pre = pre_in;
        if (!PF && ss) { const int row0_ = u.pm * BM + wr * 64 + fr;
#pragma unroll
            for (int ai = 0; ai < 2; ++ai)
#pragma unroll
                for (int mm = 0; mm < 2; ++mm) { h2 v; v.x = ss[(size_t)(row0_ + ai * HALF + (2 * mm) * 16) * 4 + fq]; v.y = ss[(size_t)(row0_ + ai * HALF + (2 * mm + 1) * 16) * 4 + fq]; pre.pa[ai][mm] = v; } }
        f16* b = base[0]; int l = ld[0]; int t0 = lo[0];
#pragma unroll
        for (int i = 1; i < 8; ++i) if (i < nd && u.pn >= lo[i]) { b = base[i]; l = ld[i]; t0 = lo[i]; }
        const int row0 = u.pm * BM + wr * 64 + fr, col0 = (u.pn - t0) * BM + wc * 32 + 8 * fq;
        const int lane_ = fr + 16 * fq;
#pragma unroll
        for (int ai = 0; ai < 2; ++ai) {
            float rs[4] = {1.f, 1.f, 1.f, 1.f};
            if (ss) {
#pragma unroll
                for (int m = 0; m < 4; ++m) { float t = (m & 1) ? (float)pre.pa[ai][m >> 1].y : (float)pre.pa[ai][m >> 1].x; t += sx(t, 16, lane_); t += sx(t, 32, lane_); rs[m] = __builtin_amdgcn_rsqf(t * (1.f / 1024.f) + 1e-6f); }
            }
#pragma unroll
            for (int m = 0; m < 4; ++m) { f16* rowp = b + (size_t)(row0 + ai * HALF + m * 16) * l + col0;
#pragma unroll
                for (int bj = 0; bj < 2; ++bj) { f32x4 v0 = acc[ai][bj][m][0] * rs[m], v1 = acc[ai][bj][m][1] * rs[m];
                    if (ACT == 1) {
#pragma unroll
                        for (int j = 0; j < 4; ++j) { const float a = fmaxf(v0[j], 0.f), c = fmaxf(v1[j], 0.f); v0[j] = a * a; v1[j] = c * c; } }
                    u32x4 w; w.x = pk2h(v0[0], v0[1]); w.y = pk2h(v0[2], v0[3]); w.z = pk2h(v1[0], v1[1]); w.w = pk2h(v1[2], v1[3]);
                    *(u32x4*)(rowp + bj * HALF) = w; } }
        }
    }
};
struct EpiRes {
    static constexpr bool PERM = true;
    f16* x; f16* ssw; LAS float* comb;
    struct Pre {}; __device__ __forceinline__ void prefetch(Pre&, const Unit&, int, int, int, int) const {}
    __device__ __forceinline__ void operator()(f32x4 (&acc)[2][2][4][2], const Unit& u, int wr, int wc, int fr, int fq, const Pre&) const {
        const int row0 = u.pm * BM + wr * 64 + fr, col0 = u.pn * BM + wc * 32 + 8 * fq;
        const int lane_ = fr + 16 * fq;
        h8 rb[2][2];
#define ER_LOAD(g, s_) do { const size_t off_ = (size_t)(row0 + ((g) >> 2) * HALF + ((g) & 3) * 16) * 1024 + col0; rb[s_][0] = *(const h8*)(x + off_); rb[s_][1] = *(const h8*)(x + off_ + HALF); } while (0)
        ER_LOAD(0, 0);
#pragma unroll
        for (int g = 0; g < 8; ++g) { const int ai = g >> 2, m = g & 3, sl = g & 1;
            if (g + 1 < 8) ER_LOAD(g + 1, sl ^ 1);
            asm volatile("" ::: "memory");
            const size_t off = (size_t)(row0 + ai * HALF + m * 16) * 1024 + col0; float sq = 0.f;
#pragma unroll
            for (int bj = 0; bj < 2; ++bj) { const h8 r = rb[sl][bj]; float o[8];
#pragma unroll
                for (int j = 0; j < 4; ++j) { o[j] = (float)r[j] + acc[ai][bj][m][0][j]; o[4 + j] = (float)r[4 + j] + acc[ai][bj][m][1][j]; }
                u32x4 w; w.x = pk2h(o[0], o[1]); w.y = pk2h(o[2], o[3]); w.z = pk2h(o[4], o[5]); w.w = pk2h(o[6], o[7]); *(u32x4*)(x + off + bj * HALF) = w;
                if (ssw) sq += ((o[0] * o[0] + o[1] * o[1]) + (o[2] * o[2] + o[3] * o[3])) + ((o[4] * o[4] + o[5] * o[5]) + (o[6] * o[6] + o[7] * o[7])); }
            if (ssw) { sq += sx(sq, 16, lane_); sq += sx(sq, 32, lane_); if (fq == 0) comb[(wr * 64 + ai * HALF + m * 16 + fr) * 4 + wc] = sq; }
        }
#undef ER_LOAD
        if (ssw) {
            asm volatile("s_waitcnt lgkmcnt(0)" ::: "memory"); __builtin_amdgcn_s_barrier(); asm volatile("" ::: "memory");
            const int wid_ = wr * 4 + wc;
            if (lane_ < 32) { const int r = wid_ * 32 + lane_; const f32x4 p = *(const LAS f32x4*)(comb + r * 4); ssw[(size_t)(u.pm * BM + r) * 4 + u.pn] = (f16)((p.x + p.y) + (p.z + p.w)); }
        }
    }
};
struct EpiMerge {
    static constexpr bool PERM = true;
    const f16* gates; f16* out;
    struct Pre {}; __device__ __forceinline__ void prefetch(Pre&, const Unit&, int, int, int, int) const {}
    __device__ __forceinline__ void operator()(f32x4 (&acc)[2][2][4][2], const Unit& u, int wr, int wc, int fr, int fq, const Pre&) const {
        const int row0 = u.pm * BM + wr * 64 + fr, col0 = u.pn * BM + wc * 32 + 8 * fq;
        const int ga = (u.seg == 0 ? 0 : (u.seg == 1 ? 1024 : 2048)), gb = (u.seg == 0 ? 1024 : 2048);
        h8 xa[2][2], xb[2][2];
#define EM_LOAD(g, s_) do { const f16* gp_ = gates + (size_t)(row0 + ((g) >> 2) * HALF + ((g) & 3) * 16) * 3072 + col0; \
            xa[s_][0] = *(const h8*)(gp_ + ga); xa[s_][1] = *(const h8*)(gp_ + ga + HALF); xb[s_][0] = *(const h8*)(gp_ + gb); xb[s_][1] = *(const h8*)(gp_ + gb + HALF); } while (0)
        EM_LOAD(0, 0);
#pragma unroll
        for (int g = 0; g < 8; ++g) { const int ai = g >> 2, m = g & 3, sl = g & 1;
            if (g + 1 < 8) EM_LOAD(g + 1, sl ^ 1);
            asm volatile("" ::: "memory");
            const int row = row0 + ai * HALF + m * 16;
#pragma unroll
            for (int bj = 0; bj < 2; ++bj) {
                float f[8];
                if (u.seg < 2) {
#pragma unroll
                    for (int j = 0; j < 8; ++j) { const float a = fminf(fmaxf((float)xa[sl][bj][j], -30.f), 30.f), b = fminf(fmaxf((float)xb[sl][bj][j], -30.f), 30.f);
                        f[j] = (1.f + __expf(-b)) * __builtin_amdgcn_rcpf(1.f + __expf(-a)); }
                } else {
#pragma unroll
                    for (int j = 0; j < 8; ++j) { const float a = fminf(fmaxf((float)xa[sl][bj][j], -30.f), 30.f); f[j] = __builtin_amdgcn_rcpf(1.f + __expf(-a)); }
                }
                f32x4 v0 = acc[ai][bj][m][0], v1 = acc[ai][bj][m][1];
#pragma unroll
                for (int j = 0; j < 4; ++j) { v0[j] *= f[j]; v1[j] *= f[4 + j]; }
                if (u.seg < 2) { acc[ai][bj][m][0] = v0; acc[ai][bj][m][1] = v1; }
                else { u32x4 w; w.x = pk2h(v0[0], v0[1]); w.y = pk2h(v0[2], v0[3]); w.z = pk2h(v1[0], v1[1]); w.w = pk2h(v1[2], v1[3]);
                    *(u32x4*)(out + (size_t)row * 1024 + col0 + bj * HALF) = w; } }
        }
#undef EM_LOAD
    }
};

template <class Epi, int NSEG, bool ALIGN_EPI, bool SP2>
__device__ __forceinline__ void gemm_phase(LAS unsigned char* lds, const f16* gA0, const f16* gA1, const f16* gA2, const f16* gB0, const f16* gB1, const f16* gB2,
                                           const int gK0, const int gK1, const int gK2, const int g_lda, const int g_ldb, const Order<NSEG>& S, const Epi& E, const int wave_in) {
    const unsigned long long uA0 = (unsigned long long)gA0, uA1 = (unsigned long long)gA1, uA2 = (unsigned long long)gA2, uB0 = (unsigned long long)gB0, uB1 = (unsigned long long)gB1, uB2 = (unsigned long long)gB2;
#define SEG_A(u) ((const char*)(NSEG > 1 ? pick3((u).seg, uA0, uA1, uA2) : uA0) + (size_t)(u).pm * (size_t)(BM * 2) * g_lda)
#define SEG_B(u) ((const char*)(NSEG > 1 ? pick3((u).seg, uB0, uB1, uB2) : uB0) + (size_t)(u).pn * (size_t)(BM * 2) * g_ldb)
#define SEG_K(u) (NSEG > 1 ? (int)pick3((u).seg, (unsigned long long)gK0, (unsigned long long)gK1, (unsigned long long)gK2) : gK0)
    const int tid_ = tid_of(wave_in);
    const int tid = tid_, wid = __builtin_amdgcn_readfirstlane(tid >> 6), lane = tid & 63, wr = wid >> 2, wc = wid & 3, fr = lane & 15, fq = lane >> 4;
    unsigned voffA[2], voffB[2];
#pragma unroll
    for (int i = 0; i < 2; ++i) { int R, C; stage_rc(tid * 16 + i * 8192, R, C); const int Rb = Epi::PERM ? ((R & ~31) + perm32(R & 31)) : R;
        voffA[i] = (unsigned)(R * g_lda + C) * 2u; voffB[i] = (unsigned)(Rb * g_ldb + C) * 2u; }
    const size_t kstep = (size_t)(BK * 2);
    const size_t hstepA = (size_t)HALF * g_lda * 2, hstepB = (size_t)HALF * g_ldb * 2;
    const unsigned ldsw = (unsigned)wid * 1024u;
    const int aoff = lds_byte(wr * 64 + fr, fq * 8), boff = lds_byte(wc * 32 + fr, fq * 8);
#define PG8_SA(b, h) (((b) * 2 + (h)) * HTB)
#define PG8_SB(b, h) ((4 + (b) * 2 + (h)) * HTB)
#define PG8_STAGE(bufoff, gbase, voff) do { _Pragma("unroll") for (int _i = 0; _i < 2; ++_i) \
        __builtin_amdgcn_global_load_lds((const unsigned*)((const char*)(gbase) + (voff)[_i]), (LAS unsigned*)(lds + (bufoff) + ldsw + _i * 8192), 16, 0, 0); } while (0)
#define PG8_LDA(dst, b, h) do { _Pragma("unroll") for (int m = 0; m < 4; ++m) _Pragma("unroll") for (int k = 0; k < 2; ++k) dst[m][k] = *(const LAS h8*)(lds + PG8_SA(b, h) + aoff + m * 2048 + k * 1024); } while (0)
#define PG8_LDB(dst, b, h) do { _Pragma("unroll") for (int n = 0; n < 2; ++n) _Pragma("unroll") for (int k = 0; k < 2; ++k) dst[n][k] = *(const LAS h8*)(lds + PG8_SB(b, h) + boff + n * 2048 + k * 1024); } while (0)
#define PG8_MMA(ai, bj, At, Bt) do { __builtin_amdgcn_s_setprio(1); _Pragma("unroll") for (int m = 0; m < 4; ++m) _Pragma("unroll") for (int n = 0; n < 2; ++n) _Pragma("unroll") for (int k = 0; k < 2; ++k) \
        acc[ai][bj][m][n] = __builtin_amdgcn_mfma_f32_16x16x32_f16(Bt[n][k], At[m][k], acc[ai][bj][m][n], 0, 0, 0); __builtin_amdgcn_s_setprio(0); } while (0)
#define PG8_WAIT_V(n) asm volatile("s_waitcnt vmcnt(" #n ")" ::: "memory")
#define PG8_WAIT_L(n) asm volatile("s_waitcnt lgkmcnt(" #n ")" ::: "memory")
#define PG8_BAR __builtin_amdgcn_s_barrier()
#define PG8_SCHED __builtin_amdgcn_sched_barrier(0)
    Unit cur, nxt; int ui = 0;
    if (!S.next(0, cur)) return;
    f32x4 acc[2][2][4][2];
#pragma unroll
    for (int a = 0; a < 2; ++a)
#pragma unroll
        for (int b = 0; b < 2; ++b)
#pragma unroll
            for (int m = 0; m < 4; ++m)
#pragma unroll
                for (int n = 0; n < 2; ++n) acc[a][b][m][n] = (f32x4){0.f, 0.f, 0.f, 0.f};
    h8 At[4][2], B0[2][2], B1[2][2];
    typename Epi::Pre pre;
    const char* cA = SEG_A(cur); const char* cB = SEG_B(cur);
    if constexpr (SP2) {
        PG8_STAGE(PG8_SB(0, 0), cB, voffB); PG8_STAGE(PG8_SB(0, 1), cB + hstepB, voffB); PG8_STAGE(PG8_SA(0, 0), cA, voffA); PG8_STAGE(PG8_SA(0, 1), cA + hstepA, voffA);
        if (wr == 1) PG8_BAR;
        PG8_WAIT_V(2); PG8_BAR;
        PG8_STAGE(PG8_SB(1, 0), cB + kstep, voffB); PG8_STAGE(PG8_SA(1, 0), cA + kstep, voffA); PG8_STAGE(PG8_SB(1, 1), cB + hstepB + kstep, voffB);
        PG8_WAIT_V(6); PG8_BAR;
    } else {
        PG8_STAGE(PG8_SB(0, 0), cB, voffB); PG8_STAGE(PG8_SA(0, 0), cA, voffA); PG8_STAGE(PG8_SB(0, 1), cB + hstepB, voffB); PG8_STAGE(PG8_SA(0, 1), cA + hstepA, voffA);
        if (wr == 1) PG8_BAR;
        PG8_WAIT_V(4); PG8_BAR;
        PG8_STAGE(PG8_SB(1, 0), cB + kstep, voffB); PG8_STAGE(PG8_SA(1, 0), cA + kstep, voffA); PG8_STAGE(PG8_SB(1, 1), cB + hstepB + kstep, voffB);
        PG8_WAIT_V(6); PG8_BAR;
    }
    for (;;) {
        const bool has_next = S.next(ui + 1, nxt);
        const int nt = SEG_K(cur) / BK;
        E.prefetch(pre, cur, wr, wc, fr, fq);
        const char* nA = has_next ? SEG_A(nxt) : cA; const char* nB = has_next ? SEG_B(nxt) : cB;
#pragma unroll 1
        for (int t = 0; t < nt; t += 2) {
            const bool last = (t == nt - 2);
            const char* a1 = cA + (size_t)(t + 1) * kstep;
            const char* a2 = last ? nA : cA + (size_t)(t + 2) * kstep; const char* b2 = last ? nB : cB + (size_t)(t + 2) * kstep;
            const char* a3 = a2 + kstep; const char* b3 = b2 + kstep;
            if constexpr (SP2) {
            PG8_LDB(B0, 0, 0); PG8_LDB(B1, 0, 1); PG8_SCHED; PG8_LDA(At, 0, 0); PG8_STAGE(PG8_SA(1, 1), a1 + hstepA, voffA);
            PG8_WAIT_V(8); PG8_WAIT_L(0); PG8_BAR; PG8_MMA(0, 0, At, B0); PG8_MMA(0, 1, At, B1); PG8_BAR; PG8_SCHED;
            PG8_LDA(At, 0, 1); PG8_STAGE(PG8_SB(0, 0), b2, voffB); PG8_STAGE(PG8_SB(0, 1), b2 + hstepB, voffB); PG8_STAGE(PG8_SA(0, 0), a2, voffA);
            PG8_WAIT_V(8); PG8_WAIT_L(0); PG8_BAR; PG8_MMA(1, 0, At, B0); PG8_MMA(1, 1, At, B1); PG8_BAR; PG8_SCHED;
            PG8_LDB(B0, 1, 0); PG8_LDB(B1, 1, 1); PG8_SCHED; PG8_LDA(At, 1, 0); PG8_STAGE(PG8_SA(0, 1), a2 + hstepA, voffA);
            PG8_WAIT_V(8); PG8_WAIT_L(0); PG8_BAR; PG8_MMA(0, 0, At, B0); PG8_MMA(0, 1, At, B1); PG8_BAR; PG8_SCHED;
            PG8_LDA(At, 1, 1); PG8_STAGE(PG8_SB(1, 0), b3, voffB); PG8_STAGE(PG8_SB(1, 1), b3 + hstepB, voffB); PG8_STAGE(PG8_SA(1, 0), a3, voffA);
            PG8_WAIT_V(8); PG8_WAIT_L(0); PG8_BAR; PG8_MMA(1, 0, At, B0); PG8_MMA(1, 1, At, B1); PG8_BAR; PG8_SCHED;
            } else {
            PG8_LDB(B0, 0, 0); PG8_SCHED; PG8_LDA(At, 0, 0); PG8_STAGE(PG8_SA(1, 1), a1 + hstepA, voffA);
            PG8_WAIT_L(8); PG8_BAR; PG8_WAIT_L(0); PG8_MMA(0, 0, At, B0); PG8_BAR; PG8_SCHED;
            PG8_LDB(B1, 0, 1); PG8_STAGE(PG8_SB(0, 0), b2, voffB);
            PG8_BAR; PG8_WAIT_L(0); PG8_MMA(0, 1, At, B1); PG8_BAR;
            PG8_LDA(At, 0, 1); PG8_STAGE(PG8_SA(0, 0), a2, voffA);
            PG8_BAR; PG8_WAIT_L(0); PG8_MMA(1, 0, At, B0); PG8_BAR; PG8_SCHED;
            PG8_STAGE(PG8_SB(0, 1), b2 + hstepB, voffB);
            PG8_WAIT_V(6); PG8_BAR; PG8_MMA(1, 1, At, B1); PG8_BAR;
            PG8_LDB(B0, 1, 0); PG8_SCHED; PG8_LDA(At, 1, 0); PG8_STAGE(PG8_SA(0, 1), a2 + hstepA, voffA);
            PG8_WAIT_L(8); PG8_BAR; PG8_WAIT_L(0); PG8_MMA(0, 0, At, B0); PG8_BAR; PG8_SCHED;
            PG8_LDB(B1, 1, 1); PG8_STAGE(PG8_SB(1, 0), b3, voffB);
            PG8_BAR; PG8_WAIT_L(0); PG8_MMA(0, 1, At, B1); PG8_BAR;
            PG8_LDA(At, 1, 1); PG8_STAGE(PG8_SA(1, 0), a3, voffA);
            PG8_BAR; PG8_WAIT_L(0); PG8_MMA(1, 0, At, B0); PG8_BAR; PG8_SCHED;
            PG8_STAGE(PG8_SB(1, 1), b3 + hstepB, voffB);
            PG8_WAIT_V(6); PG8_BAR; PG8_MMA(1, 1, At, B1); PG8_BAR;
            }
        }
        if constexpr (ALIGN_EPI) { if (wr == 0) PG8_BAR; }
        E(acc, cur, wr, wc, fr, fq, pre);
        if (!has_next) break;
        if (NSEG == 1 || cur.seg == NSEG - 1) {
#pragma unroll
        for (int a = 0; a < 2; ++a)
#pragma unroll
            for (int b = 0; b < 2; ++b)
#pragma unroll
                for (int m = 0; m < 4; ++m)
#pragma unroll
                    for (int n = 0; n < 2; ++n) acc[a][b][m][n] = (f32x4){0.f, 0.f, 0.f, 0.f};
        }
        cur = nxt; cA = nA; cB = nB; ++ui;
        if constexpr (ALIGN_EPI) { if (wr == 1) PG8_BAR; }
    }
    PG8_WAIT_V(0);
    if constexpr (!ALIGN_EPI) { if (wr == 0) PG8_BAR; }
    PG8_BAR;
#undef SEG_A
#undef SEG_B
#undef SEG_K
#undef PG8_SA
#undef PG8_SB
#undef PG8_STAGE
#undef PG8_LDA
#undef PG8_LDB
#undef PG8_MMA
#undef PG8_WAIT_V
#undef PG8_WAIT_L
#undef PG8_BAR
#undef PG8_SCHED
}
}

namespace att {
constexpr int D = 128, NW = 8, QBLK = 32, KVBLK = 64;
constexpr float THR = 8.f;
constexpr size_t SHM_V = KVBLK * D * 2, SHM_K = KVBLK * D * 2, SHM_ATTN = 2 * SHM_V + 2 * SHM_K + NW * 64 * 4;
#define KSWZ(row, colB) ((row) * 256 + ((colB) ^ (((row) & 7) << 4)))
#define SBAR() __builtin_amdgcn_sched_barrier(0)
__device__ __forceinline__ int crow(int r, int hi) { return (r & 3) + 8 * (r >> 2) + 4 * hi; }
__device__ __forceinline__ unsigned cvtpk(float lo, float hi) { return pk2h(lo, hi); }

template <int SCALE_NUM> struct ScaleC { };
__device__ __forceinline__ void partialSM(f32x16& p0, f32x16& p1, float& m_reg, float& mn, float& alpha, const float SCALE) {
  const float C = SCALE * 1.4426950408889634f;
  float pmax = p0[0];
#pragma unroll
  for (int r = 1; r < 16; ++r) pmax = fmaxf(pmax, p0[r]);
#pragma unroll
  for (int r = 0; r < 16; ++r) pmax = fmaxf(pmax, p1[r]);
  { auto rr = __builtin_amdgcn_permlane32_swap(__float_as_uint(pmax), __float_as_uint(pmax), false, false);
    pmax = fmaxf(__uint_as_float(rr[0]), __uint_as_float(rr[1])); }
  if (__builtin_expect(__all(pmax - m_reg <= THR / SCALE), 1)) { mn = m_reg; alpha = 1.f; }
  else { mn = fmaxf(m_reg, pmax); alpha = __builtin_amdgcn_exp2f((m_reg - mn) * C); m_reg = mn; }
  float mnC = -mn * C;
#pragma unroll
  for (int r = 0; r < 16; ++r) p0[r] = fmaf(p0[r], C, mnC);
#pragma unroll
  for (int r = 0; r < 16; ++r) p1[r] = fmaf(p1[r], C, mnC);
#pragma unroll
  for (int r = 0; r < 16; ++r) p0[r] = __builtin_amdgcn_exp2f(p0[r]);
}
__device__ __forceinline__ void finishSM(f32x16& p0, f32x16& p1, float alpha, float& l_reg, h8& pa0, h8& pa1, h8& pa2, h8& pa3) {
#pragma unroll
  for (int r = 0; r < 16; ++r) p1[r] = __builtin_amdgcn_exp2f(p1[r]);
  float ps = 0;
#pragma unroll
  for (int r = 0; r < 16; ++r) ps += p0[r];
#pragma unroll
  for (int r = 0; r < 16; ++r) ps += p1[r];
  { auto rr = __builtin_amdgcn_permlane32_swap(__float_as_uint(ps), __float_as_uint(ps), false, false);
    ps = __uint_as_float(rr[0]) + __uint_as_float(rr[1]); }
  l_reg = l_reg * alpha + ps;
#define PK4(P, BASE, OUT) do { unsigned a0 = cvtpk(P[BASE + 0], P[BASE + 1]), a1 = cvtpk(P[BASE + 2], P[BASE + 3]);   \
    unsigned b0 = cvtpk(P[BASE + 4], P[BASE + 5]), b1 = cvtpk(P[BASE + 6], P[BASE + 7]);                              \
    auto r0 = __builtin_amdgcn_permlane32_swap(a0, b0, false, false); auto r1 = __builtin_amdgcn_permlane32_swap(a1, b1, false, false); \
    u32x4 w = {r0[0], r1[0], r0[1], r1[1]}; OUT = __builtin_bit_cast(h8, w); } while (0)
  PK4(p0, 0, pa0); PK4(p0, 8, pa1); PK4(p1, 0, pa2); PK4(p1, 8, pa3);
#undef PK4
}
__device__ __forceinline__ void qkt(f32x16& p0, f32x16& p1, const char* Ks, const h8* qr, int r32, int hi) {
  p0 = f32x16{}; p1 = f32x16{};
#pragma unroll
  for (int d0 = 0; d0 < 8; ++d0) { int cb = (d0 * 16 + hi * 8) * 2;
    h8 b0 = *reinterpret_cast<const h8*>(Ks + KSWZ(r32, cb));
    h8 b1 = *reinterpret_cast<const h8*>(Ks + KSWZ(32 + r32, cb));
    p0 = __builtin_amdgcn_mfma_f32_32x32x16_f16(b0, qr[d0], p0, 0, 0, 0);
    p1 = __builtin_amdgcn_mfma_f32_32x32x16_f16(b1, qr[d0], p1, 0, 0, 0); }
}
__device__ __forceinline__ int v_st(int k, int c) { const int kk = (k & ~0xC) | ((k & 4) << 1) | ((k & 8) >> 1); return ((kk >> 3) * 4 + (c >> 5)) * 512 + ((kk & 7) * 32 + (c & 31)) * 2; }
__device__ __forceinline__ int v_rd_base(int lane) { return ((lane & 3) << 3) | (((lane >> 2) & 3) << 6) | (((lane >> 4) & 1) << 5) | (((lane >> 5) & 1) << 8); }
constexpr int v_rd_off(int d0, int ks, int half) { return d0 * 512 + ks * 4096 + half * 2048; }
template <int OFF> __device__ __forceinline__ h4 tr_read(int vb) {
  h4 r; asm volatile("ds_read_b64_tr_b16 %0, %1 offset:%2" : "=&v"(r) : "v"(vb), "i"(OFF) : "memory"); return r;
}
template <int D0> __device__ __forceinline__ void pv_one(f32x16& od, int vb, h8 pa0, h8 pa1, h8 pa2, h8 pa3) {
  const h4 l0 = tr_read<v_rd_off(D0, 0, 0)>(vb), h0 = tr_read<v_rd_off(D0, 0, 1)>(vb), l1 = tr_read<v_rd_off(D0, 1, 0)>(vb), h1 = tr_read<v_rd_off(D0, 1, 1)>(vb);
  const h4 l2 = tr_read<v_rd_off(D0, 2, 0)>(vb), h2_ = tr_read<v_rd_off(D0, 2, 1)>(vb), l3 = tr_read<v_rd_off(D0, 3, 0)>(vb), h3 = tr_read<v_rd_off(D0, 3, 1)>(vb);
  asm volatile("s_waitcnt lgkmcnt(0)" ::: "memory"); SBAR();
#define PK(L, H) (h8){L[0], L[1], L[2], L[3], H[0], H[1], H[2], H[3]}
  od = __builtin_amdgcn_mfma_f32_32x32x16_f16(pa0, PK(l0, h0), od, 0, 0, 0);
  od = __builtin_amdgcn_mfma_f32_32x32x16_f16(pa1, PK(l1, h1), od, 0, 0, 0);
  od = __builtin_amdgcn_mfma_f32_32x32x16_f16(pa2, PK(l2, h2_), od, 0, 0, 0);
  od = __builtin_amdgcn_mfma_f32_32x32x16_f16(pa3, PK(l3, h3), od, 0, 0, 0);
#undef PK
}
__device__ __forceinline__ void pv_d0(f32x16* o, int vb, h8 pa0, h8 pa1, h8 pa2, h8 pa3) {
  pv_one<0>(o[0], vb, pa0, pa1, pa2, pa3); pv_one<1>(o[1], vb, pa0, pa1, pa2, pa3); pv_one<2>(o[2], vb, pa0, pa1, pa2, pa3); pv_one<3>(o[3], vb, pa0, pa1, pa2, pa3);
}
template <int LDQ, int LDK, int LDO>
__device__ __forceinline__ void attn_dense_body(const f16* __restrict__ Qb, const f16* __restrict__ Kh, const f16* __restrict__ Vh, f16* Ob, int seq, char* lds, const float SCALE, const int wave_in) {
  const int tid_ = tid_of(wave_in);
  const int tid = tid_, wid = tid >> 6, lane = tid & 63, r32 = lane & 31, hi = lane >> 5;
  char* V_lds = lds; char* K_lds = lds + 2 * SHM_V;
  float* ws = (float*)(lds + 2 * SHM_V + 2 * SHM_K) + wid * 64; float* li_l = ws; float* al_l = ws + 32;
  float m_reg = -1e30f, l_reg = 0; f32x16 o[4] = {}; h8 qr[8];
  const f16* Qw = Qb + (long)(wid * QBLK + r32) * LDQ + hi * 8;
#pragma unroll
  for (int d0 = 0; d0 < 8; ++d0) qr[d0] = *reinterpret_cast<const h8*>(Qw + d0 * 16);
  const int sr = tid >> 4, sc = (tid & 15) * 8, vst0 = v_st(sr, sc), vst1 = v_st(32 + sr, sc);
  const int vb0 = (int)(uintptr_t)V_lds + v_rd_base(lane);
  struct { h8 vs0, vs1, ks0, ks1; } sr_[2];
#define SLOAD(i, k0) do { sr_[i].vs0 = *(const h8*)(&Vh[(long)((k0) + sr) * LDK + sc]); sr_[i].vs1 = *(const h8*)(&Vh[(long)((k0) + 32 + sr) * LDK + sc]); \
    sr_[i].ks0 = *(const h8*)(&Kh[(long)((k0) + sr) * LDK + sc]); sr_[i].ks1 = *(const h8*)(&Kh[(long)((k0) + 32 + sr) * LDK + sc]); } while (0)
#define SWRITE(b, i) do { *(h8*)(V_lds + (b) * SHM_V + vst0) = sr_[i].vs0;          \
    *(h8*)(V_lds + (b) * SHM_V + vst1) = sr_[i].vs1; int kc = sc * 2;               \
    *(h8*)(K_lds + (b) * SHM_K + KSWZ(sr, kc)) = sr_[i].ks0;                       \
    *(h8*)(K_lds + (b) * SHM_K + KSWZ(32 + sr, kc)) = sr_[i].ks1; } while (0)
#define SWAIT() asm volatile("s_waitcnt vmcnt(4)" ::: "memory")
#define RESC(a) do { if (__any((a) < 1.f)) { if (hi == 0) al_l[r32] = (a); asm volatile("s_waitcnt lgkmcnt(0)" ::: "memory"); \
    _Pragma("unroll") for (int d = 0; d < 4; ++d) _Pragma("unroll") for (int r = 0; r < 16; ++r) o[d][r] *= al_l[crow(r, hi)]; } } while (0)
  f32x16 pA0, pA1, pB0, pB1; float mnA, mnB, alA, alB; h8 pa0, pa1, pa2, pa3; const int NT = seq / KVBLK;
  constexpr int SE = 0, SO = 1;
  SLOAD(SE, 0); asm volatile("s_waitcnt vmcnt(0)" ::: "memory"); SWRITE(0, SE); __syncthreads();
  qkt(pA0, pA1, K_lds, qr, r32, hi); partialSM(pA0, pA1, m_reg, mnA, alA, SCALE);
  SLOAD(SO, KVBLK); if (2 < NT) SLOAD(SE, 2 * KVBLK);
  SWAIT(); SWRITE(1, SO); __syncthreads();
  for (int j = 1; j + 1 < NT; j += 2) {
    SBAR(); qkt(pB0, pB1, K_lds + SHM_K, qr, r32, hi);
    finishSM(pA0, pA1, alA, l_reg, pa0, pa1, pa2, pa3); SBAR();
    SLOAD(SO, (j + 2) * KVBLK); SBAR();
    pv_d0(o, vb0, pa0, pa1, pa2, pa3); partialSM(pB0, pB1, m_reg, mnB, alB, SCALE);
    __syncthreads(); SWAIT(); SWRITE(0, SE);
    RESC(alB); __syncthreads();
    SBAR(); qkt(pA0, pA1, K_lds, qr, r32, hi);
    finishSM(pB0, pB1, alB, l_reg, pa0, pa1, pa2, pa3); SBAR();
    if (j + 3 < NT) SLOAD(SE, (j + 3) * KVBLK); SBAR();
    pv_d0(o, vb0 + (int)SHM_V, pa0, pa1, pa2, pa3); partialSM(pA0, pA1, m_reg, mnA, alA, SCALE);
    __syncthreads(); SWAIT(); SWRITE(1, SO);
    RESC(alA); __syncthreads();
  }
  SBAR(); qkt(pB0, pB1, K_lds + SHM_K, qr, r32, hi);
  finishSM(pA0, pA1, alA, l_reg, pa0, pa1, pa2, pa3); SBAR();
  pv_d0(o, vb0, pa0, pa1, pa2, pa3); partialSM(pB0, pB1, m_reg, mnB, alB, SCALE);
  __syncthreads(); RESC(alB);
  finishSM(pB0, pB1, alB, l_reg, pa0, pa1, pa2, pa3); SBAR();
  pv_d0(o, vb0 + (int)SHM_V, pa0, pa1, pa2, pa3);
  if (hi == 0) li_l[r32] = l_reg; asm volatile("s_waitcnt lgkmcnt(0)" ::: "memory");
  float rli[16];
#pragma unroll
  for (int r = 0; r < 16; ++r) rli[r] = __builtin_amdgcn_rcpf(li_l[crow(r, hi)]);
  f16* Ow = Ob + (long)(wid * QBLK) * LDO;
#pragma unroll
  for (int r = 0; r < 16; ++r) { int orow = crow(r, hi);
#pragma unroll
    for (int d0 = 0; d0 < 4; ++d0) Ow[(long)orow * LDO + d0 * 32 + r32] = (f16)(o[d0][r] * rli[r]); }
#undef SLOAD
#undef SWRITE
#undef SWAIT
#undef RESC
}

__device__ __forceinline__ void nearbias(f32x16& p0, f32x16& p1, const LAS float* tp) {
#pragma unroll
  for (int q = 0; q < 4; ++q) {
#pragma unroll
    for (int r = 4 * q; r < 4 * q + 4; ++r) { const int c = (r & 3) + 8 * (r >> 2); p0[r] += tp[c * 8]; p1[r] += tp[(c + 32) * 8]; }
    SBAR();
  }
}
__device__ __forceinline__ void finishSM_m(f32x16& p0, f32x16& p1, float alpha, float& l_reg, h8& pa0, h8& pa1, h8& pa2, h8& pa3, const unsigned long long mw, const int hi) {
  const unsigned mlo = (unsigned)mw >> (4 * hi), mhi = (unsigned)(mw >> 32) >> (4 * hi);
  float ps = 0;
#pragma unroll
  for (int q = 0; q < 4; ++q) {
#pragma unroll
    for (int r = 4 * q; r < 4 * q + 4; ++r) { const int c = (r & 3) + 8 * (r >> 2);
      const int t0 = ((int)(mlo << (31 - c))) >> 31, t1 = ((int)(mhi << (31 - c))) >> 31;
      p0[r] = __int_as_float(__float_as_int(p0[r]) & t0); p1[r] = __int_as_float(__float_as_int(__builtin_amdgcn_exp2f(p1[r])) & t1); ps += p0[r] + p1[r]; }
    SBAR();
  }
  { auto rr = __builtin_amdgcn_permlane32_swap(__float_as_uint(ps), __float_as_uint(ps), false, false);
    ps = __uint_as_float(rr[0]) + __uint_as_float(rr[1]); }
  l_reg = l_reg * alpha + ps;
#define PK4(P, BASE, OUT) do { unsigned a0 = cvtpk(P[BASE + 0], P[BASE + 1]), a1 = cvtpk(P[BASE + 2], P[BASE + 3]);   \
    unsigned b0 = cvtpk(P[BASE + 4], P[BASE + 5]), b1 = cvtpk(P[BASE + 6], P[BASE + 7]);                              \
    auto r0 = __builtin_amdgcn_permlane32_swap(a0, b0, false, false); auto r1 = __builtin_amdgcn_permlane32_swap(a1, b1, false, false); \
    u32x4 w = {r0[0], r1[0], r0[1], r1[1]}; OUT = __builtin_bit_cast(h8, w); } while (0)
  PK4(p0, 0, pa0); PK4(p0, 8, pa1); PK4(p1, 0, pa2); PK4(p1, 8, pa3);
#undef PK4
}
__device__ __forceinline__ void dsa_attn_unit(f16* Qb, const f16* __restrict__ Kh, const unsigned long long* __restrict__ M, const int NT, const int tq0, const LAS float* tbl, char* lds, const int wave_in) {
  constexpr int LDQ = 128, LDK = 128, LDO = 128; const float SCALE = 1.f;
  __builtin_assume(NT >= 4);
  const int tid_ = tid_of(wave_in);
  const int tid = tid_, wid = tid >> 6, lane = tid & 63, r32 = lane & 31, hi = lane >> 5;
  char* V_lds = lds; char* K_lds = lds + 2 * SHM_V;
  float* ws = (float*)(lds + 2 * SHM_V + 2 * SHM_K) + wid * 64; float* li_l = ws; float* al_l = ws + 32;
  float m_reg = -1e30f, l_reg = 0; f32x16 o[4] = {}; h8 qr[8];
  const f16* Qw = Qb + (long)(wid * QBLK + r32) * LDQ + hi * 8;
#pragma unroll
  for (int d0 = 0; d0 < 8; ++d0) qr[d0] = *reinterpret_cast<const h8*>(Qw + d0 * 16);
  const int qi = wid * 4 + (r32 >> 3), head = r32 & 7, tpos = tq0 + qi;
  const unsigned long long* Mq = M + (size_t)qi * 64;
  const LAS float* tbh = tbl + (4 * hi - tpos + 320) * 8 + head;
  const int sr = tid >> 4, sc = (tid & 15) * 8, vst0 = v_st(sr, sc), vst1 = v_st(32 + sr, sc);
  const int vb0 = (int)(uintptr_t)V_lds + v_rd_base(lane);
  struct { h8 ks0, ks1; } sr_[1];
#define SLOAD(i, k0) do { sr_[i].ks0 = *(const h8*)(&Kh[(long)((k0) + sr) * LDK + sc]); sr_[i].ks1 = *(const h8*)(&Kh[(long)((k0) + 32 + sr) * LDK + sc]); } while (0)
#define SWRITE(b, i) do { *(h8*)(V_lds + (b) * SHM_V + vst0) = sr_[i].ks0; *(h8*)(V_lds + (b) * SHM_V + vst1) = sr_[i].ks1; int kc = sc * 2; \
    *(h8*)(K_lds + (b) * SHM_K + KSWZ(sr, kc)) = sr_[i].ks0; *(h8*)(K_lds + (b) * SHM_K + KSWZ(32 + sr, kc)) = sr_[i].ks1; } while (0)
#define RESC(a) do { if (__any((a) < 1.f)) { if (hi == 0) al_l[r32] = (a); asm volatile("s_waitcnt lgkmcnt(0)" ::: "memory"); \
    _Pragma("unroll") for (int d = 0; d < 4; ++d) _Pragma("unroll") for (int r = 0; r < 16; ++r) o[d][r] *= al_l[crow(r, hi)]; } } while (0)
#define NEAR(j) (64 * (j) > tq0 - 191)
  f32x16 pA0, pA1, pB0, pB1; float mnA, mnB, alA, alB; h8 pa0, pa1, pa2, pa3;
  constexpr int SE = 0, SO = 0;
  unsigned long long mA = Mq[0], mB = Mq[1];
  SLOAD(SE, 0); SWRITE(0, SE); __syncthreads();
  qkt(pA0, pA1, K_lds, qr, r32, hi); if (NEAR(0)) nearbias(pA0, pA1, tbh);
  partialSM(pA0, pA1, m_reg, mnA, alA, SCALE);
  SLOAD(SO, KVBLK);
  SWRITE(1, SO); __syncthreads();
  for (int j = 1; j + 1 < NT; j += 2) {
    SBAR(); qkt(pB0, pB1, K_lds + SHM_K, qr, r32, hi);
    finishSM_m(pA0, pA1, alA, l_reg, pa0, pa1, pa2, pa3, mA, hi); mA = Mq[j + 1]; SBAR();
    SLOAD(SE, (j + 1) * KVBLK); SBAR();
    pv_d0(o, vb0, pa0, pa1, pa2, pa3);
    if (NEAR(j)) nearbias(pB0, pB1, tbh + 512 * j);
    partialSM(pB0, pB1, m_reg, mnB, alB, SCALE);
    __syncthreads(); SWRITE(0, SE);
    RESC(alB); __syncthreads();
    SBAR(); qkt(pA0, pA1, K_lds, qr, r32, hi);
    finishSM_m(pB0, pB1, alB, l_reg, pa0, pa1, pa2, pa3, mB, hi); mB = Mq[j + 2]; SBAR();
    SLOAD(SO, (j + 2) * KVBLK); SBAR();
    pv_d0(o, vb0 + (int)SHM_V, pa0, pa1, pa2, pa3);
    if (NEAR(j + 1)) nearbias(pA0, pA1, tbh + 512 * (j + 1));
    partialSM(pA0, pA1, m_reg, mnA, alA, SCALE);
    __syncthreads(); SWRITE(1, SO);
    RESC(alA); __syncthreads();
  }
  SBAR(); qkt(pB0, pB1, K_lds + SHM_K, qr, r32, hi);
  finishSM_m(pA0, pA1, alA, l_reg, pa0, pa1, pa2, pa3, mA, hi); SBAR();
  pv_d0(o, vb0, pa0, pa1, pa2, pa3);
  if (NEAR(NT - 1)) nearbias(pB0, pB1, tbh + 512 * (NT - 1));
  partialSM(pB0, pB1, m_reg, mnB, alB, SCALE);
  __syncthreads(); RESC(alB);
  finishSM_m(pB0, pB1, alB, l_reg, pa0, pa1, pa2, pa3, mB, hi); SBAR();
  pv_d0(o, vb0 + (int)SHM_V, pa0, pa1, pa2, pa3);
  if (hi == 0) li_l[r32] = l_reg; asm volatile("s_waitcnt lgkmcnt(0)" ::: "memory");
  float rli[16];
#pragma unroll
  for (int r = 0; r < 16; ++r) rli[r] = __builtin_amdgcn_rcpf(li_l[crow(r, hi)]);
  f16* Ow = Qb + (long)(wid * QBLK) * LDO;
#pragma unroll
  for (int r = 0; r < 16; ++r) { int orow = crow(r, hi);
#pragma unroll
    for (int d0 = 0; d0 < 4; ++d0) Ow[(long)orow * LDO + d0 * 32 + r32] = (f16)(o[d0][r] * rli[r]); }
#undef SLOAD
#undef SWRITE
#undef RESC
#undef NEAR
}

__device__ __forceinline__ unsigned off_b(unsigned row, unsigned ch) { return 256u * row + 16u * (ch ^ (((row & 3u) << 2) | ((row >> 2) & 3u))); }
template <int OFF> __device__ __forceinline__ h4 tr_read_o(unsigned vb) { h4 r; asm volatile("ds_read_b64_tr_b16 %0, %1 offset:%2" : "=&v"(r) : "v"(vb), "i"(OFF) : "memory"); return r; }
constexpr int GW_TILE = 16384, GW_ULIST = 2176, GW_QM = 544, GW_SCR = 256, GW_BYTES = GW_TILE + GW_ULIST + GW_QM + GW_SCR;
template <int C> __device__ __forceinline__ void pv_gw(f32x16& od, const unsigned (&tva)[2][4], h8 pa0, h8 pa1, h8 pa2, h8 pa3) {
  const h4 a0 = tr_read_o<0>(tva[0][C]), a1 = tr_read_o<0>(tva[1][C]), b0 = tr_read_o<4096>(tva[0][C]), b1 = tr_read_o<4096>(tva[1][C]);
  const h4 c0 = tr_read_o<8192>(tva[0][C]), c1 = tr_read_o<8192>(tva[1][C]), d0 = tr_read_o<12288>(tva[0][C]), d1 = tr_read_o<12288>(tva[1][C]);
  asm volatile("s_waitcnt lgkmcnt(0)" ::: "memory"); SBAR();
#define PK(L, H) (h8){L[0], L[1], L[2], L[3], H[0], H[1], H[2], H[3]}
  od = __builtin_amdgcn_mfma_f32_32x32x16_f16(pa0, PK(a0, a1), od, 0, 0, 0);
  od = __builtin_amdgcn_mfma_f32_32x32x16_f16(pa1, PK(b0, b1), od, 0, 0, 0);
  od = __builtin_amdgcn_mfma_f32_32x32x16_f16(pa2, PK(c0, c1), od, 0, 0, 0);
  od = __builtin_amdgcn_mfma_f32_32x32x16_f16(pa3, PK(d0, d1), od, 0, 0, 0);
#undef PK
}
__device__ __forceinline__ void dsa_attn_wave(f16* Qw, const f16* __restrict__ Kb, const unsigned long long* __restrict__ Mw, const int nw, const int tpos0, const LAS float* tbl, LAS unsigned char* wl, const int lane) {
  const int r32 = lane & 31, hi = lane >> 5;
  LAS unsigned char* tile = wl; LAS unsigned short* ulist = (LAS unsigned short*)(wl + GW_TILE); LAS unsigned* qm = (LAS unsigned*)(wl + GW_TILE + GW_ULIST);
  LAS float* al_l = (LAS float*)(wl + GW_TILE + GW_ULIST + GW_QM); LAS float* li_l = al_l + 32;
  h8 qr[8]; { const f16* Qp = Qw + (long)r32 * 128 + hi * 8;
#pragma unroll
    for (int d0 = 0; d0 < 8; ++d0) qr[d0] = *reinterpret_cast<const h8*>(Qp + d0 * 16); }
  const int qi = r32 >> 3, head = r32 & 7, tpos = tpos0 + qi;
  unsigned long long m0 = 0ull, m1 = 0ull, m2 = 0ull, m3 = 0ull;
  if (lane < nw) { m0 = Mw[lane]; m1 = Mw[64 + lane]; m2 = Mw[128 + lane]; m3 = Mw[192 + lane]; }
  unsigned long long u = (m0 | m1) | (m2 | m3);
  const int cnt = __popcll(u), incl = wave_incl_scan(cnt); int pos = incl - cnt; const int U = __builtin_amdgcn_readlane(incl, 63);
  qm[lane] = 0u; qm[lane + 64] = 0u; if (lane < 8) qm[lane + 128] = 0u;
  asm volatile("s_waitcnt lgkmcnt(0)" ::: "memory");
  while (u) { const int b = __builtin_ctzll(u); u &= u - 1ull; ulist[pos] = (unsigned short)(64 * lane + b); const unsigned bit = 1u << (pos & 31); const int w = pos >> 5;
    if ((m0 >> b) & 1ull) __hip_atomic_fetch_or(qm + w, bit, __ATOMIC_RELAXED, __HIP_MEMORY_SCOPE_WORKGROUP);
    if ((m1 >> b) & 1ull) __hip_atomic_fetch_or(qm + 34 + w, bit, __ATOMIC_RELAXED, __HIP_MEMORY_SCOPE_WORKGROUP);
    if ((m2 >> b) & 1ull) __hip_atomic_fetch_or(qm + 68 + w, bit, __ATOMIC_RELAXED, __HIP_MEMORY_SCOPE_WORKGROUP);
    if ((m3 >> b) & 1ull) __hip_atomic_fetch_or(qm + 102 + w, bit, __ATOMIC_RELAXED, __HIP_MEMORY_SCOPE_WORKGROUP);
    ++pos; }
  const int NTu = (U + 63) >> 6;
  if (U + lane < 64 * NTu) ulist[U + lane] = 0;
  asm volatile("s_waitcnt lgkmcnt(0)" ::: "memory");
  const unsigned tb_ = (unsigned)(uintptr_t)tile;
  unsigned ka[8];
#pragma unroll
  for (int d0 = 0; d0 < 8; ++d0) ka[d0] = off_b((unsigned)r32, (unsigned)(2 * d0 + hi));
  unsigned tva[2][4]; { const unsigned blk = (lane >> 4) & 1, q = (lane & 15) >> 2, p = lane & 3;
#pragma unroll
    for (int t_ = 0; t_ < 2; ++t_)
#pragma unroll
      for (int c = 0; c < 4; ++c) tva[t_][c] = tb_ + off_b(8u * hi + 4u * t_ + q, 4u * c + 2u * blk + (p >> 1)) + 8u * (p & 1); }
  const int srow = lane >> 4, sch = lane & 15;
#define GW_DMA(t) do { _Pragma("unroll") for (int i_ = 0; i_ < 16; ++i_) { const int key_ = ulist[64 * (t) + 4 * i_ + srow]; const int ch_ = sch ^ ((srow << 2) | (i_ & 3)); \
      __builtin_amdgcn_global_load_lds((const unsigned*)(Kb + (size_t)key_ * 128 + 8 * ch_), (LAS unsigned*)(tile + (i_ >> 3) * 8192 + 1024 * (i_ & 7)), 16, 0, 0); } } while (0)
  float m_reg = -1e30f, l_reg = 0.f; f32x16 o[4] = {};
  GW_DMA(0);
#pragma unroll 1
  for (int t = 0; t < NTu; ++t) {
    asm volatile("s_waitcnt vmcnt(0)" ::: "memory");
    f32x16 p0 = f32x16{}, p1 = f32x16{};
#pragma unroll
    for (int d0 = 0; d0 < 8; ++d0) { const h8 b0 = *(const LAS h8*)(tile + ka[d0]), b1 = *(const LAS h8*)(tile + 8192 + ka[d0]);
      p0 = __builtin_amdgcn_mfma_f32_32x32x16_f16(b0, qr[d0], p0, 0, 0, 0); p1 = __builtin_amdgcn_mfma_f32_32x32x16_f16(b1, qr[d0], p1, 0, 0, 0); }
    const int klast = __builtin_amdgcn_readfirstlane((int)ulist[(64 * t + 63 < U) ? 64 * t + 63 : U - 1]);
    if (klast > tpos0 - 128) {
      const LAS unsigned short* kp = ulist + 64 * t + 4 * hi;
#pragma unroll
      for (int q4 = 0; q4 < 4; ++q4) {
#pragma unroll
        for (int r = 4 * q4; r < 4 * q4 + 4; ++r) { const int c = (r & 3) + 8 * (r >> 2); int i0 = (int)kp[c] - tpos + 128, i1 = (int)kp[c + 32] - tpos + 128;
          i0 = i0 < 0 ? 0 : (i0 > 255 ? 255 : i0); i1 = i1 < 0 ? 0 : (i1 > 255 ? 255 : i1); p0[r] += tbl[i0 * 8 + head]; p1[r] += tbl[i1 * 8 + head]; }
        SBAR(); }
    }
    float mn, alpha; partialSM(p0, p1, m_reg, mn, alpha, 1.f);
    if (__any(alpha < 1.f)) { if (hi == 0) al_l[r32] = alpha; asm volatile("s_waitcnt lgkmcnt(0)" ::: "memory");
#pragma unroll
      for (int d = 0; d < 4; ++d)
#pragma unroll
        for (int r = 0; r < 16; ++r) o[d][r] *= al_l[crow(r, hi)]; }
    const u32x2 mwv = *(const LAS u32x2*)(qm + qi * 34 + 2 * t);
    h8 pa0, pa1, pa2, pa3;
    finishSM_m(p0, p1, alpha, l_reg, pa0, pa1, pa2, pa3, ((unsigned long long)mwv.y << 32) | mwv.x, hi);
    pv_gw<0>(o[0], tva, pa0, pa1, pa2, pa3); pv_gw<1>(o[1], tva, pa0, pa1, pa2, pa3); pv_gw<2>(o[2], tva, pa0, pa1, pa2, pa3); pv_gw<3>(o[3], tva, pa0, pa1, pa2, pa3);
    asm volatile("s_waitcnt lgkmcnt(0)" ::: "memory");
    if (t + 1 < NTu) GW_DMA(t + 1);
  }
#undef GW_DMA
  if (hi == 0) li_l[r32] = l_reg; asm volatile("s_waitcnt lgkmcnt(0)" ::: "memory");
  float rli[16];
#pragma unroll
  for (int r = 0; r < 16; ++r) rli[r] = __builtin_amdgcn_rcpf(li_l[crow(r, hi)]);
#pragma unroll
  for (int r = 0; r < 16; ++r) { const int orow = crow(r, hi);
#pragma unroll
    for (int d0 = 0; d0 < 4; ++d0) Qw[(long)orow * 128 + d0 * 32 + r32] = (f16)(o[d0][r] * rli[r]); }
}

__device__ __forceinline__ void partialSM32(f32x16& p0, float& m_reg, float& mn, float& alpha) {
  constexpr float C = 1.4426950408889634f;
  float pmax = p0[0];
#pragma unroll
  for (int r = 1; r < 16; ++r) pmax = fmaxf(pmax, p0[r]);
  { auto rr = __builtin_amdgcn_permlane32_swap(__float_as_uint(pmax), __float_as_uint(pmax), false, false);
    pmax = fmaxf(__uint_as_float(rr[0]), __uint_as_float(rr[1])); }
  if (__builtin_expect(__all(pmax - m_reg <= THR), 1)) { mn = m_reg; alpha = 1.f; }
  else { mn = fmaxf(m_reg, pmax); alpha = __builtin_amdgcn_exp2f((m_reg - mn) * C); m_reg = mn; }
  const float mnC = -mn * C;
#pragma unroll
  for (int r = 0; r < 16; ++r) p0[r] = __builtin_amdgcn_exp2f(fmaf(p0[r], C, mnC));
}
__device__ __forceinline__ void finishSM32_m(f32x16& p0, float alpha, float& l_reg, h8& pa0, h8& pa1, const unsigned mw, const int hi) {
  const unsigned mlo = mw >> (4 * hi);
  float ps = 0;
#pragma unroll
  for (int r = 0; r < 16; ++r) { const int c = (r & 3) + 8 * (r >> 2); const int t0 = ((int)(mlo << (31 - c))) >> 31; p0[r] = __int_as_float(__float_as_int(p0[r]) & t0); ps += p0[r]; }
  { auto rr = __builtin_amdgcn_permlane32_swap(__float_as_uint(ps), __float_as_uint(ps), false, false);
    ps = __uint_as_float(rr[0]) + __uint_as_float(rr[1]); }
  l_reg = l_reg * alpha + ps;
#define PK4(P, BASE, OUT) do { unsigned a0 = cvtpk(P[BASE + 0], P[BASE + 1]), a1 = cvtpk(P[BASE + 2], P[BASE + 3]);   \
    unsigned b0 = cvtpk(P[BASE + 4], P[BASE + 5]), b1 = cvtpk(P[BASE + 6], P[BASE + 7]);                              \
    auto r0 = __builtin_amdgcn_permlane32_swap(a0, b0, false, false); auto r1 = __builtin_amdgcn_permlane32_swap(a1, b1, false, false); \
    u32x4 w = {r0[0], r1[0], r0[1], r1[1]}; OUT = __builtin_bit_cast(h8, w); } while (0)
  PK4(p0, 0, pa0); PK4(p0, 8, pa1);
#undef PK4
}
template <int C, int BO> __device__ __forceinline__ void pv_gw32(f32x16& od, const unsigned (&tvb)[2][4], h8 pa0, h8 pa1) {
  const h4 a0 = tr_read_o<BO>(tvb[0][C]), a1 = tr_read_o<BO>(tvb[1][C]), b0 = tr_read_o<BO + 4096>(tvb[0][C]), b1 = tr_read_o<BO + 4096>(tvb[1][C]);
  asm volatile("s_waitcnt lgkmcnt(0)" ::: "memory"); SBAR();
#define PK(L, H) (h8){L[0], L[1], L[2], L[3], H[0], H[1], H[2], H[3]}
  od = __builtin_amdgcn_mfma_f32_32x32x16_f16(pa0, PK(a0, a1), od, 0, 0, 0);
  od = __builtin_amdgcn_mfma_f32_32x32x16_f16(pa1, PK(b0, b1), od, 0, 0, 0);
#undef PK
}
#ifndef ATT_PROBE_SEC
#define ATT_PROBE_SEC 0
#endif
#define AT_MARK(sec) do { if (ATT_PROBE_SEC) { const unsigned long long t_ = __builtin_amdgcn_s_memrealtime(); if (ATT_PROBE_SEC == (sec)) at_acc += t_ - at_t; at_t = t_; } } while (0)
__device__ __forceinline__ unsigned long long dsa_attn_wave32(f16* Qw, const f16* __restrict__ Kb, const unsigned long long* __restrict__ Mw, const int nw, const int tpos0, const LAS float* tbl, LAS unsigned char* wl, const int lane) {
  unsigned long long at_acc = 0ull, at_t = ATT_PROBE_SEC ? __builtin_amdgcn_s_memrealtime() : 0ull;
  const int r32 = lane & 31, hi = lane >> 5;
  LAS unsigned char* tile = wl; LAS unsigned short* ulist = (LAS unsigned short*)(wl + GW_TILE); LAS unsigned* qm = (LAS unsigned*)(wl + GW_TILE + GW_ULIST);
  LAS float* al_l = (LAS float*)(wl + GW_TILE + GW_ULIST + GW_QM); LAS float* li_l = al_l + 32;
  h8 qr[8]; { const f16* Qp = Qw + (long)r32 * 128 + hi * 8;
#pragma unroll
    for (int d0 = 0; d0 < 8; ++d0) qr[d0] = *reinterpret_cast<const h8*>(Qp + d0 * 16); }
  const int qi = r32 >> 3, head = r32 & 7, tpos = tpos0 + qi;
  unsigned long long m0 = 0ull, m1 = 0ull, m2 = 0ull, m3 = 0ull;
  if (lane < nw) { m0 = Mw[lane]; m1 = Mw[64 + lane]; m2 = Mw[128 + lane]; m3 = Mw[192 + lane]; }
  unsigned long long u = (m0 | m1) | (m2 | m3);
  const int cnt = __popcll(u), incl = wave_incl_scan(cnt); int pos = incl - cnt; const int U = __builtin_amdgcn_readlane(incl, 63);
  qm[lane] = 0u; qm[lane + 64] = 0u; if (lane < 8) qm[lane + 128] = 0u;
  asm volatile("s_waitcnt lgkmcnt(0)" ::: "memory");
  while (u) { const int b = __builtin_ctzll(u); u &= u - 1ull; ulist[pos] = (unsigned short)(64 * lane + b); const unsigned bit = 1u << (pos & 31); const int w = pos >> 5;
    if ((m0 >> b) & 1ull) __hip_atomic_fetch_or(qm + w, bit, __ATOMIC_RELAXED, __HIP_MEMORY_SCOPE_WORKGROUP);
    if ((m1 >> b) & 1ull) __hip_atomic_fetch_or(qm + 34 + w, bit, __ATOMIC_RELAXED, __HIP_MEMORY_SCOPE_WORKGROUP);
    if ((m2 >> b) & 1ull) __hip_atomic_fetch_or(qm + 68 + w, bit, __ATOMIC_RELAXED, __HIP_MEMORY_SCOPE_WORKGROUP);
    if ((m3 >> b) & 1ull) __hip_atomic_fetch_or(qm + 102 + w, bit, __ATOMIC_RELAXED, __HIP_MEMORY_SCOPE_WORKGROUP);
    ++pos; }
  const int NT = (U + 31) >> 5;
  if (lane < 32 && U + lane < 32 * NT) ulist[U + lane] = 0;
  asm volatile("s_waitcnt lgkmcnt(0)" ::: "memory");
  AT_MARK(1);
  const unsigned tb_ = (unsigned)(uintptr_t)tile;
  unsigned ka[8];
#pragma unroll
  for (int d0 = 0; d0 < 8; ++d0) ka[d0] = off_b((unsigned)r32, (unsigned)(2 * d0 + hi));
  unsigned tva[2][4]; { const unsigned blk = (lane >> 4) & 1, q = (lane & 15) >> 2, p = lane & 3;
#pragma unroll
    for (int t_ = 0; t_ < 2; ++t_)
#pragma unroll
      for (int c = 0; c < 4; ++c) tva[t_][c] = tb_ + off_b(8u * hi + 4u * t_ + q, 4u * c + 2u * blk + (p >> 1)) + 8u * (p & 1); }
  const int srow = lane >> 4, sch = lane & 15;
  const unsigned chx = (unsigned)(sch ^ (srow << 2)) * 16u;
#define GW_DMA32(t, bo_) do { _Pragma("unroll") for (int i_ = 0; i_ < 8; ++i_) { const unsigned key_ = ulist[32 * (t) + 4 * i_ + srow]; \
      __builtin_amdgcn_global_load_lds((const unsigned*)((const char*)Kb + (key_ * 256u + (chx ^ (unsigned)((i_ & 3) * 16)))), (LAS unsigned*)(tile + (bo_) + 1024 * i_), 16, 0, 0); } } while (0)
  float m_reg = -1e30f, l_reg = 0.f; f32x16 o[4] = {};
  GW_DMA32(0, 0);
#define GW_STEP(targ_, BO) do { const int t = (targ_); \
    AT_MARK(3); \
    if (t + 1 < NT) { GW_DMA32(t + 1, 8192 - BO); AT_MARK(4); asm volatile("s_waitcnt vmcnt(8)" ::: "memory"); } \
    else asm volatile("s_waitcnt vmcnt(0)" ::: "memory"); \
    AT_MARK(2); \
    f32x16 p0 = f32x16{}; \
_Pragma("unroll") \
    for (int d0 = 0; d0 < 8; ++d0) { const h8 b0 = *(const LAS h8*)(tile + BO + ka[d0]); p0 = __builtin_amdgcn_mfma_f32_32x32x16_f16(b0, qr[d0], p0, 0, 0, 0); } \
    const int klast = __builtin_amdgcn_readfirstlane((int)ulist[(32 * t + 31 < U) ? 32 * t + 31 : U - 1]); \
    if (klast > tpos0 - 128) { \
      const LAS unsigned short* kp = ulist + 32 * t + 4 * hi; \
_Pragma("unroll") \
      for (int q4 = 0; q4 < 4; ++q4) { \
_Pragma("unroll") \
        for (int r = 4 * q4; r < 4 * q4 + 4; ++r) { const int c = (r & 3) + 8 * (r >> 2); int i0 = (int)kp[c] - tpos + 128; i0 = i0 < 0 ? 0 : (i0 > 255 ? 255 : i0); p0[r] += tbl[i0 * 8 + head]; } \
        SBAR(); } \
    } \
    float mn, alpha; partialSM32(p0, m_reg, mn, alpha); \
    if (__any(alpha < 1.f)) { if (hi == 0) al_l[r32] = alpha; asm volatile("s_waitcnt lgkmcnt(0)" ::: "memory"); \
_Pragma("unroll") \
      for (int d = 0; d < 4; ++d) \
_Pragma("unroll") \
        for (int r = 0; r < 16; ++r) o[d][r] *= al_l[crow(r, hi)]; } \
    const unsigned mwv = qm[qi * 34 + t]; \
    h8 pa0, pa1; \
    finishSM32_m(p0, alpha, l_reg, pa0, pa1, mwv, hi); \
    pv_gw32<0, BO>(o[0], tva, pa0, pa1); pv_gw32<1, BO>(o[1], tva, pa0, pa1); pv_gw32<2, BO>(o[2], tva, pa0, pa1); pv_gw32<3, BO>(o[3], tva, pa0, pa1); \
    asm volatile("s_waitcnt lgkmcnt(0)" ::: "memory"); \
  } while (0)
#pragma unroll 1
  for (int tt = 0; tt < NT; tt += 2) {
    GW_STEP(tt, 0);
    if (tt + 1 < NT) GW_STEP(tt + 1, 8192);
  }
#undef GW_STEP
#undef GW_DMA32
  AT_MARK(3);
  if (hi == 0) li_l[r32] = l_reg; asm volatile("s_waitcnt lgkmcnt(0)" ::: "memory");
  float rli[16];
#pragma unroll
  for (int r = 0; r < 16; ++r) rli[r] = __builtin_amdgcn_rcpf(li_l[crow(r, hi)]);
#pragma unroll
  for (int r = 0; r < 16; ++r) { const int orow = crow(r, hi);
#pragma unroll
    for (int d0 = 0; d0 < 4; ++d0) Qw[(long)orow * 128 + d0 * 32 + r32] = (f16)(o[d0][r] * rli[r]); }
  AT_MARK(5);
  return at_acc;
}
__device__ __forceinline__ void tr_settle4(h4& a, h4& b, h4& c, h4& d) { asm volatile("s_waitcnt lgkmcnt(0)" : "+v"(a), "+v"(b), "+v"(c), "+v"(d) : : "memory"); }
__device__ __forceinline__ float xg_max(float v) {
  { auto rr = __builtin_amdgcn_permlane16_swap(__float_as_uint(v), __float_as_uint(v), false, false); v = fmaxf(__uint_as_float(rr[0]), __uint_as_float(rr[1])); }
  { auto rr = __builtin_amdgcn_permlane32_swap(__float_as_uint(v), __float_as_uint(v), false, false); v = fmaxf(__uint_as_float(rr[0]), __uint_as_float(rr[1])); }
  return v; }
__device__ __forceinline__ float xg_sum(float v) {
  { auto rr = __builtin_amdgcn_permlane16_swap(__float_as_uint(v), __float_as_uint(v), false, false); v = __uint_as_float(rr[0]) + __uint_as_float(rr[1]); }
  { auto rr = __builtin_amdgcn_permlane32_swap(__float_as_uint(v), __float_as_uint(v), false, false); v = __uint_as_float(rr[0]) + __uint_as_float(rr[1]); }
  return v; }
__device__ __forceinline__ float max3f(float a, float b, float c) { float r; asm("v_max3_f32 %0, %1, %2, %3" : "=v"(r) : "v"(a), "v"(b), "v"(c)); return r; }
__device__ __forceinline__ float max2f(float a, float b) { float r; asm("v_max_f32 %0, %1, %2" : "=v"(r) : "v"(a), "v"(b)); return r; }
__device__ __forceinline__ float xg_max_raw(float v) {
  { auto rr = __builtin_amdgcn_permlane16_swap(__float_as_uint(v), __float_as_uint(v), false, false); v = max2f(__uint_as_float(rr[0]), __uint_as_float(rr[1])); }
  { auto rr = __builtin_amdgcn_permlane32_swap(__float_as_uint(v), __float_as_uint(v), false, false); v = max2f(__uint_as_float(rr[0]), __uint_as_float(rr[1])); }
  return v; }
struct Pre16 { h8 q[4]; unsigned long long m0, m1; };
__device__ __forceinline__ void pre16_load(Pre16& p, const f16* Qw, const unsigned long long* __restrict__ Mw, const int nw, const int lane_in) {
  int lane = lane_in; asm volatile("" : "+v"(lane));
  const int r16 = lane & 15, g = lane >> 4; const f16* Qp = Qw + (long)r16 * 128 + g * 8;
#pragma unroll
  for (int ks = 0; ks < 4; ++ks) p.q[ks] = *reinterpret_cast<const h8*>(Qp + ks * 32);
  const int sh = nw <= 16 ? 2 : (nw <= 32 ? 1 : 0), wi = lane >> sh;
  p.m0 = 0ull; p.m1 = 0ull;
  if (wi < nw) { p.m0 = Mw[wi]; p.m1 = Mw[64 + wi]; }
}
__device__ __forceinline__ unsigned long long dsa_attn_wave16(f16* Qw, const f16* __restrict__ Kb, const Pre16& pre, const int nw, const int tpos0, const LAS float* tbl, LAS unsigned char* wl, const int lane_in) {
  int lane = lane_in; asm volatile("" : "+v"(lane));
  unsigned long long at_acc = 0ull, at_t = ATT_PROBE_SEC ? __builtin_amdgcn_s_memrealtime() : 0ull;
  constexpr float C = 1.4426950408889634f;
  const int r16 = lane & 15, g = lane >> 4;
  LAS unsigned char* tile = wl; LAS unsigned short* ulist = (LAS unsigned short*)(wl + GW_TILE); LAS unsigned* qm = (LAS unsigned*)(wl + GW_TILE + GW_ULIST);
  h8 qr[4];
#pragma unroll
  for (int ks = 0; ks < 4; ++ks) qr[ks] = pre.q[ks];
  const int qi = r16 >> 3, head = r16 & 7, tpos = tpos0 + qi;
  const int sh = nw <= 16 ? 2 : (nw <= 32 ? 1 : 0), wd = 64 >> sh, pc = lane & ((1 << sh) - 1), kbase = 64 * (lane >> sh) + pc * wd;
  const unsigned long long pm = sh ? ((1ull << wd) - 1ull) : ~0ull;
  const unsigned long long m0 = (pre.m0 >> (pc * wd)) & pm, m1 = (pre.m1 >> (pc * wd)) & pm;
  unsigned long long u = m0 | m1;
  const int cnt = __popcll(u), incl = wave_incl_scan(cnt); int pos = incl - cnt; const int U = __builtin_amdgcn_readlane(incl, 63);
  qm[lane] = 0u; if (lane < 8) qm[lane + 64] = 0u;
  asm volatile("s_waitcnt lgkmcnt(0)" ::: "memory");
  while (u) { const int b = __builtin_ctzll(u); u &= u - 1ull; ulist[pos] = (unsigned short)(kbase + b); const unsigned bit = 1u << (pos & 31); const int w = pos >> 5;
    if ((m0 >> b) & 1ull) __hip_atomic_fetch_or(qm + w, bit, __ATOMIC_RELAXED, __HIP_MEMORY_SCOPE_WORKGROUP);
    if ((m1 >> b) & 1ull) __hip_atomic_fetch_or(qm + 34 + w, bit, __ATOMIC_RELAXED, __HIP_MEMORY_SCOPE_WORKGROUP);
    ++pos; }
  const int NT = (U + 31) >> 5;
  if (lane < 32 && U + lane < 32 * NT) ulist[U + lane] = 0;
  asm volatile("s_waitcnt lgkmcnt(0)" ::: "memory");
  AT_MARK(1);
  const unsigned tb_ = (unsigned)(uintptr_t)tile;
  unsigned ka[2][4];
#pragma unroll
  for (int kb = 0; kb < 2; ++kb)
#pragma unroll
    for (int ks = 0; ks < 4; ++ks) ka[kb][ks] = off_b((unsigned)(16 * kb + r16), (unsigned)(4 * ks + g));
  unsigned tvb[8]; { const unsigned q = (lane & 15) >> 2, p = lane & 3;
#pragma unroll
    for (int db = 0; db < 8; ++db) tvb[db] = tb_ + off_b(4u * g + q, 2u * db + (p >> 1)) + 8u * (p & 1); }
  const int srow = lane >> 4, sch = lane & 15;
  const unsigned chx = (unsigned)(sch ^ (srow << 2)) * 16u;
#define GW_KEYS(t) do { _Pragma("unroll") for (int i_ = 0; i_ < 8; ++i_) kn[i_] = ulist[32 * (t) + 4 * i_ + srow]; } while (0)
#define GW_DMA32K(bo_) do { _Pragma("unroll") for (int i_ = 0; i_ < 8; ++i_) \
      __builtin_amdgcn_global_load_lds((const unsigned*)((const char*)Kb + ((unsigned)kn[i_] * 256u + (chx ^ (unsigned)((i_ & 3) * 16)))), (LAS unsigned*)(tile + (bo_) + 1024 * i_), 16, 0, 0); } while (0)
  unsigned short kn[8];
  float m_reg = -1e30f, l_reg = 0.f; f32x4 o[8];
#pragma unroll
  for (int db = 0; db < 8; ++db) o[db] = (f32x4){0.f, 0.f, 0.f, 0.f};
  GW_KEYS(0); GW_DMA32K(0); if (1 < NT) GW_KEYS(1);
#define GW_STEP(targ_, BO) do { const int t = (targ_); \
    AT_MARK(3); \
    if (t + 1 < NT) { GW_DMA32K(8192 - BO); AT_MARK(4); asm volatile("s_waitcnt vmcnt(8)" ::: "memory"); } \
    else asm volatile("s_waitcnt vmcnt(0)" ::: "memory"); \
    AT_MARK(2); \
    f32x4 s0 = (f32x4){0.f, 0.f, 0.f, 0.f}, s1 = (f32x4){0.f, 0.f, 0.f, 0.f}; \
_Pragma("unroll") \
    for (int ks = 0; ks < 4; ++ks) { const h8 a0 = *(const LAS h8*)(tile + BO + ka[0][ks]); const h8 a1 = *(const LAS h8*)(tile + BO + ka[1][ks]); \
      s0 = __builtin_amdgcn_mfma_f32_16x16x32_f16(a0, qr[ks], s0, 0, 0, 0); s1 = __builtin_amdgcn_mfma_f32_16x16x32_f16(a1, qr[ks], s1, 0, 0, 0); } \
    h4 v0[8], v1[8];                        \
_Pragma("unroll") \
    for (int db = 0; db < 8; ++db) { v0[db] = tr_read_o<BO>(tvb[db]); v1[db] = tr_read_o<BO + 4096>(tvb[db]); } \
    if (t + 2 < NT) GW_KEYS(t + 2); \
    const int klast = __builtin_amdgcn_readfirstlane((int)ulist[(32 * t + 31 < U) ? 32 * t + 31 : U - 1]); \
    if (klast > tpos0 - 128) { \
      const LAS unsigned short* kp = ulist + 32 * t + 4 * g; \
_Pragma("unroll") \
      for (int ii = 0; ii < 4; ++ii) { int i0 = (int)kp[ii] - tpos + 128; i0 = i0 < 0 ? 0 : (i0 > 255 ? 255 : i0); s0[ii] += tbl[i0 * 8 + head]; \
        int i1 = (int)kp[16 + ii] - tpos + 128; i1 = i1 < 0 ? 0 : (i1 > 255 ? 255 : i1); s1[ii] += tbl[i1 * 8 + head]; } \
    } \
    float pmax = max2f(max3f(s0[0], s0[1], s0[2]), max3f(s0[3], s1[0], max3f(s1[1], s1[2], s1[3])));     \
    float mn, alpha; \
    if (__builtin_expect(__all(pmax - m_reg <= THR), 1)) { mn = m_reg; alpha = 1.f; } \
    else { pmax = xg_max_raw(pmax); mn = max2f(m_reg, pmax); alpha = __builtin_amdgcn_exp2f((m_reg - mn) * C); m_reg = mn; \
_Pragma("unroll") \
      for (int db = 0; db < 8; ++db) o[db] = o[db] * alpha; } \
    const float mnC = -mn * C; \
    const unsigned mlo = qm[qi * 34 + t] >> (4 * g); \
    float ps = 0.f; \
_Pragma("unroll") \
    for (int ii = 0; ii < 4; ++ii) { \
      const int t0 = __builtin_amdgcn_sbfe((int)mlo, ii, 1), t1 = __builtin_amdgcn_sbfe((int)mlo, 16 + ii, 1); \
      s0[ii] = __int_as_float(__float_as_int(__builtin_amdgcn_exp2f(fmaf(s0[ii], C, mnC))) & t0); s1[ii] = __int_as_float(__float_as_int(__builtin_amdgcn_exp2f(fmaf(s1[ii], C, mnC))) & t1); \
      ps += s0[ii] + s1[ii]; } \
    l_reg = l_reg * alpha + ps;              \
    u32x4 pw; pw.x = cvtpk(s0[0], s0[1]); pw.y = cvtpk(s0[2], s0[3]); pw.z = cvtpk(s1[0], s1[1]); pw.w = cvtpk(s1[2], s1[3]); \
    const h8 pa = __builtin_bit_cast(h8, pw); \
_Pragma("unroll") \
    for (int db = 0; db < 8; db += 2) tr_settle4(v0[db], v1[db], v0[db + 1], v1[db + 1]); \
    SBAR(); \
_Pragma("unroll") \
    for (int db = 0; db < 8; ++db) o[db] = __builtin_amdgcn_mfma_f32_16x16x32_f16((h8){v0[db][0], v0[db][1], v0[db][2], v0[db][3], v1[db][0], v1[db][1], v1[db][2], v1[db][3]}, pa, o[db], 0, 0, 0); \
    asm volatile("s_waitcnt lgkmcnt(0)" ::: "memory"); \
  } while (0)
#pragma unroll 1
  for (int tt = 0; tt < NT; tt += 2) {
    GW_STEP(tt, 0);
    if (tt + 1 < NT) GW_STEP(tt + 1, 8192);
  }
#undef GW_STEP
#undef GW_DMA32K
#undef GW_KEYS
  AT_MARK(3);
  const float rl = __builtin_amdgcn_rcpf(xg_sum(l_reg));
#pragma unroll
  for (int db = 0; db < 8; ++db) { u32x2 w; w.x = cvtpk(o[db][0] * rl, o[db][1] * rl); w.y = cvtpk(o[db][2] * rl, o[db][3] * rl); *(u32x2*)(Qw + (long)r16 * 128 + 16 * db + 4 * g) = w; }
  AT_MARK(5);
  return at_acc;
}
}

struct Args { const float* in[21]; float* out; unsigned char* ws; int ph_lo, ph_hi; };
enum { I_X = 0, I_MEM, I_NORM1, I_WIN, I_QNORM, I_KVNORM, I_WUQ, I_WIQ, I_WUK, I_WUV, I_MEMNORM, I_WMEMKV, I_WRETO, I_WDSAO, I_WMEMO, I_WOUT, I_NORM2, I_WFF1, I_WFF2, I_RELBIAS, I_FINALNORM };

typedef const __attribute__((address_space(4))) Args* KArgs;
#define INP(a, i) ((const float*)(const GAS float*)((a)->in[i]))
struct FrameU { LAS unsigned char* lds; char* ldsg; unsigned char* ws; unsigned char* dout; int G, wave0; };
struct Frame { LAS unsigned char* lds; char* ldsg; unsigned char* ws; unsigned char* dout; int tid, lane, wave, G; };

__device__ __forceinline__ Frame relaunder(const FrameU& F0) { Frame F; F.lds = F0.lds; F.ldsg = F0.ldsg; F.G = F0.G; const int t = tid_of(F0.wave0);
    { GAS unsigned char* w = (GAS unsigned char*)F0.ws; GAS unsigned char* d = (GAS unsigned char*)F0.dout; asm volatile("" : "+s"(w), "+s"(d)); F.ws = (unsigned char*)w; F.dout = (unsigned char*)d; }
    F.tid = t; F.lane = t & 63; F.wave = F0.wave0; return F; }
__device__ __forceinline__ void norm_rows_f16(const FrameU& F0, const float* src, const float* gain, f16* dst, int rows, int w0, int wstride) {
    const Frame F = relaunder(F0);
    f32x4 g[4];
#pragma unroll
    for (int j = 0; j < 4; ++j) g[j] = ((const f32x4*)gain)[F.lane + 64 * j];
    for (int m = w0; m < rows; m += wstride) {
        const f32x4* xr = (const f32x4*)(src + (size_t)m * DM) + F.lane;
        f32x4 v[4]; float s = 0.f;
#pragma unroll
        for (int j = 0; j < 4; ++j) { v[j] = xr[64 * j]; s += (v[j].x * v[j].x + v[j].y * v[j].y) + (v[j].z * v[j].z + v[j].w * v[j].w); }
        const float rstd = 1.f / sqrtf(wave_sum(s, F.lane) * (1.f / DM) + 1e-6f);
        u32x2* o8 = (u32x2*)(dst + (size_t)m * DM) + F.lane;
#pragma unroll
        for (int j = 0; j < 4; ++j) { u32x2 w; w.x = pk2h(v[j].x * rstd * g[j].x, v[j].y * rstd * g[j].y); w.y = pk2h(v[j].z * rstd * g[j].z, v[j].w * rstd * g[j].w); o8[64 * j] = w; }
    }
}
__device__ __forceinline__ void cvt_rows_f16_ss(const FrameU& F0, const float* src, f16* dst, f16* ss, int rows, int w0, int wstride) {
    const Frame F = relaunder(F0);
    for (int m = w0; m < rows; m += wstride) {
        const f32x4* xr = (const f32x4*)(src + (size_t)m * DM) + F.lane;
        f32x4 v[4]; float s = 0.f;
#pragma unroll
        for (int j = 0; j < 4; ++j) { v[j] = xr[64 * j]; s += (v[j].x * v[j].x + v[j].y * v[j].y) + (v[j].z * v[j].z + v[j].w * v[j].w); }
        s = wave_sum(s, F.lane);
        u32x2* o8 = (u32x2*)(dst + (size_t)m * DM) + F.lane;
#pragma unroll
        for (int j = 0; j < 4; ++j) { u32x2 w; w.x = pk2h(v[j].x, v[j].y); w.y = pk2h(v[j].z, v[j].w); o8[64 * j] = w; }
        if (F.lane < 4) ss[(size_t)m * 4 + F.lane] = (f16)(s * 0.25f);
    }
}
__device__ __forceinline__ void norm_rows_final(const FrameU& F0, const f16* x16, float* x, const float* gain, int rows, int w0, int wstride) {
    const Frame F = relaunder(F0);
    f32x4 g[4];
#pragma unroll
    for (int j = 0; j < 4; ++j) g[j] = ((const f32x4*)gain)[F.lane + 64 * j];
    for (int m = w0; m < rows; m += wstride) {
        f32x4* xr = (f32x4*)(x + (size_t)m * DM) + F.lane; const h4* hr = (const h4*)(x16 + (size_t)m * DM) + F.lane;
        f32x4 v[4]; float s = 0.f;
#pragma unroll
        for (int j = 0; j < 4; ++j) { const h4 t = hr[64 * j]; v[j] = (f32x4){(float)t[0], (float)t[1], (float)t[2], (float)t[3]}; s += (v[j].x * v[j].x + v[j].y * v[j].y) + (v[j].z * v[j].z + v[j].w * v[j].w); }
        const float rstd = 1.f / sqrtf(wave_sum(s, F.lane) * (1.f / DM) + 1e-6f);
#pragma unroll
        for (int j = 0; j < 4; ++j) xr[64 * j] = v[j] * rstd * g[j];
    }
}

__device__ __forceinline__ void transpose_item(const float* src, int ldsrc, int nvalid, int k0, f16* WT, int ldk, int lane, LAS float* scr, const float* gain) {
#pragma unroll
    for (int i = 0; i < 8; ++i) { const int kk = 8 * i + (lane >> 3), n = (lane & 7) * 4; const float gk = gain ? gain[k0 + kk] : 1.f;
        f32x4 v = (f32x4){0.f, 0.f, 0.f, 0.f}; if (n < nvalid) v = *(const f32x4*)(src + (size_t)(k0 + kk) * ldsrc + n);
        scr[kk * 33 + n] = v.x * gk; scr[kk * 33 + n + 1] = v.y * gk; scr[kk * 33 + n + 2] = v.z * gk; scr[kk * 33 + n + 3] = v.w * gk; }
    LDS_WAIT(); asm volatile("" ::: "memory");
    const int c = lane & 7;
#pragma unroll
    for (int j = 0; j < 4; ++j) { const int n = (lane >> 3) + 8 * j; const LAS float* s = scr + (8 * c) * 33 + n;
        u32x4 o; o.x = pk2h(s[0 * 33], s[1 * 33]); o.y = pk2h(s[2 * 33], s[3 * 33]); o.z = pk2h(s[4 * 33], s[5 * 33]); o.w = pk2h(s[6 * 33], s[7 * 33]);
        *(u32x4*)(WT + (size_t)n * ldk + k0 + 8 * c) = o; }
    LDS_WAIT(); asm volatile("" ::: "memory");
}
struct TJob { const float* src; int ldsrc, K, ncols; f16* dst; int ldk; const float* gain; };
__device__ __forceinline__ TJob tjob(KArgs a, unsigned char* ws, int l, int j) {
    unsigned char* wl = ws + WS_W + (size_t)l * W_LAYER; TJob t;
    const float* w_in = INP(a, I_WIN) + (size_t)l * DM * NIN;
    switch (j) {
    case 0:  t = TJob{w_in, NIN, DM, 2464, (f16*)(wl + W_IN), DM, INP(a, I_NORM1) + l * DM}; break;
    case 1:  t = TJob{w_in + 2464, NIN, DM, 8, (f16*)(wl + W_IN) + (size_t)2464 * DM, DM, INP(a, I_NORM1) + l * DM}; break;
    case 2:  t = TJob{w_in, NIN, DM, 0, (f16*)(wl + W_IN) + (size_t)2496 * DM, DM, INP(a, I_NORM1) + l * DM}; break;
    case 3:  t = TJob{w_in, NIN, DM, 0, (f16*)(wl + W_IN) + (size_t)2528 * DM, DM, INP(a, I_NORM1) + l * DM}; break;
    case 4:  t = TJob{w_in + 2472, NIN, DM, 3584, (f16*)(wl + W_IN) + (size_t)2560 * DM, DM, INP(a, I_NORM1) + l * DM}; break;
    case 5:  t = TJob{INP(a, I_WIQ) + (size_t)l * 256 * 256, 256, 256, 256, (f16*)(wl + W_DQ) + (size_t)1024 * 256, 256, nullptr}; break;
    case 6:  t = TJob{INP(a, I_WMEMKV) + (size_t)l * DM * 1024, 1024, DM, 1024, (f16*)(wl + W_MKV), DM, nullptr}; break;
    case 7:  t = TJob{INP(a, I_WRETO) + (size_t)l * 512 * DM, DM, 512, 1024, (f16*)(wl + W_RM), 1024, nullptr}; break;
    case 8:  t = TJob{INP(a, I_WMEMO) + (size_t)l * 512 * DM, DM, 512, 1024, (f16*)(wl + W_RM) + 512, 1024, nullptr}; break;
    case 9:  t = TJob{INP(a, I_WOUT) + (size_t)l * DM * DM, DM, DM, 1024, (f16*)(wl + W_OUT), DM, nullptr}; break;
    case 10: t = TJob{INP(a, I_WFF1) + (size_t)l * DM * FF, FF, DM, FF, (f16*)(wl + W_FF1), DM, INP(a, I_NORM2) + l * DM}; break;
    default: t = TJob{INP(a, I_WFF2) + (size_t)l * FF * DM, DM, FF, 1024, (f16*)(wl + W_FF2), FF, nullptr}; break;
    }
    return t;
}
constexpr int NTJOBS = 12;

__device__ __forceinline__ int t5_bucket(int rel) {
    const int base = rel > 0 ? 16 : 0; const int n = rel < 0 ? -rel : rel;
    if (n < 8) return base + n;
    int lg = 8 + (n >= 12) + (n >= 16) + (n >= 23) + (n >= 32) + (n >= 46) + (n >= 64) + (n >= 91); if (lg > 15) lg = 15;
    return base + lg;
}

#ifndef PRO_PROBE_SEC
#define PRO_PROBE_SEC 0
#endif
#define PR_MARK(sec) do { if (PRO_PROBE_SEC) { const unsigned long long t_ = __builtin_amdgcn_s_memrealtime(); if (PRO_PROBE_SEC == (sec)) pp_acc += t_ - pp_t; pp_t = t_; } } while (0)
__device__ __forceinline__ unsigned long long p_prologue(const FrameU& F0, KArgs a) {
    const Frame F = relaunder(F0);
    unsigned long long pp_acc = 0ull, pp_t = PRO_PROBE_SEC ? __builtin_amdgcn_s_memrealtime() : 0ull;
    LAS float* scr = (LAS float*)(F.lds + F.wave * 16384);
    const int gw = blockIdx.x * NWAVES + F.wave, NGW = F.G * NWAVES;
    {
        constexpr int TJ_TOTAL = 16 * 77 + 16 * 3 + 16 * 112 + 32 + 512 + 256 + 256 + 512 + 2048 + 2048;
#define TJ_ITEMS(j) ((j) == 0 ? 16 * 77 : (j) <= 3 ? 16 : (j) == 4 ? 16 * 112 : (j) == 5 ? 32 : (j) == 6 ? 512 : (j) <= 8 ? 256 : (j) == 9 ? 512 : 2048)
        struct TI { const float* src; const float* gain; f16* dst; int ldsrc, ldk, nv, k0; };
#define TJ_DECODE(f, ti) do { int l_ = (f) >= TJ_TOTAL ? 1 : 0, r_ = (f) - l_ * TJ_TOTAL, j_ = 0; \
            _Pragma("unroll 1") for (; j_ < NTJOBS - 1; ++j_) { const int n_ = TJ_ITEMS(j_); if (r_ < n_) break; r_ -= n_; } \
            const TJob t_ = tjob(a, F.ws, l_, j_); const int nblk_ = (t_.ncols + 31) / 32 > 0 ? (t_.ncols + 31) / 32 : 1; const int kb_ = r_ / nblk_, nb_ = r_ - kb_ * nblk_; \
            int nv_ = t_.ncols - 32 * nb_; nv_ = nv_ > 32 ? 32 : (nv_ < 0 ? 0 : nv_); \
            (ti).src = t_.src + 32 * nb_; (ti).gain = t_.gain; (ti).dst = t_.dst + (size_t)(32 * nb_) * t_.ldk; (ti).ldsrc = t_.ldsrc; (ti).ldk = t_.ldk; (ti).nv = nv_; (ti).k0 = 64 * kb_; } while (0)
#define TJ_LOAD(ti, v, gk) do { _Pragma("unroll") for (int i = 0; i < 8; ++i) { const int kk = 8 * i + (F.lane >> 3), n = (F.lane & 7) * 4; gk[i] = (ti).gain ? (ti).gain[(ti).k0 + kk] : 1.f; \
            v[i] = (f32x4){0.f, 0.f, 0.f, 0.f}; if (n < (ti).nv) v[i] = *(const f32x4*)((ti).src + (size_t)((ti).k0 + kk) * (ti).ldsrc + n); } } while (0)
        int f = gw; TI cur, nxt; f32x4 v[8], vn[8]; float gk[8], gn[8];
        if (f < 2 * TJ_TOTAL) { TJ_DECODE(f, cur); TJ_LOAD(cur, v, gk); }
#pragma unroll 1
        while (f < 2 * TJ_TOTAL) {
            const int fn = f + NGW;
            if (fn < 2 * TJ_TOTAL) { TJ_DECODE(fn, nxt); TJ_LOAD(nxt, vn, gn); }
#pragma unroll
            for (int i = 0; i < 8; ++i) { const int kk = 8 * i + (F.lane >> 3), n = (F.lane & 7) * 4;
                scr[kk * 33 + n] = v[i].x * gk[i]; scr[kk * 33 + n + 1] = v[i].y * gk[i]; scr[kk * 33 + n + 2] = v[i].z * gk[i]; scr[kk * 33 + n + 3] = v[i].w * gk[i]; }
            LDS_WAIT(); asm volatile("" ::: "memory");
            { const int c = F.lane & 7;
#pragma unroll
              for (int j = 0; j < 4; ++j) { const int n = (F.lane >> 3) + 8 * j; const LAS float* sp = scr + (8 * c) * 33 + n;
                u32x4 o; o.x = pk2h(sp[0 * 33], sp[1 * 33]); o.y = pk2h(sp[2 * 33], sp[3 * 33]); o.z = pk2h(sp[4 * 33], sp[5 * 33]); o.w = pk2h(sp[6 * 33], sp[7 * 33]);
                *(u32x4*)(cur.dst + (size_t)n * cur.ldk + cur.k0 + 8 * c) = o; } }
            LDS_WAIT(); asm volatile("" ::: "memory");
            cur = nxt; f = fn;
#pragma unroll
            for (int i = 0; i < 8; ++i) { v[i] = vn[i]; gk[i] = gn[i]; }
        }
#undef TJ_LOAD
#undef TJ_DECODE
#undef TJ_ITEMS
    }
    PR_MARK(1);
    const int gt = blockIdx.x * NTHREADS + F.tid, NGT = F.G * NTHREADS;
    for (int l = 0; l < DEPTH; ++l) {
        unsigned char* wl = F.ws + WS_W + (size_t)l * W_LAYER;
        const float* wuq = INP(a, I_WUQ) + (size_t)l * 256 * 512; const float* wuk = INP(a, I_WUK) + (size_t)l * 128 * 512;
        f16* wdq = (f16*)(wl + W_DQ);
        for (int e = gt; e < 1024 * 256; e += NGT) {
            const int n = e >> 8, k = e & 255, h = n >> 7, r = n & 127;
            const f32x4* pa = (const f32x4*)(wuq + ((size_t)k * 8 + h) * 64); const f32x4* pb = (const f32x4*)(wuk + ((size_t)r * 8 + h) * 64); float s = 0.f;
#pragma unroll
            for (int d = 0; d < 16; ++d) { const f32x4 a4 = pa[d], b4 = pb[d]; s += (a4.x * b4.x + a4.y * b4.y) + (a4.z * b4.z + a4.w * b4.w); }
            wdq[e] = (f16)(s * 0.125f);
        }
        const float* wuv = INP(a, I_WUV) + (size_t)l * 128 * 512; const float* wdo = INP(a, I_WDSAO) + (size_t)l * 512 * DM;
        f16* wvo = (f16*)(wl + W_VO);
        for (int e = gt; e < 1024 * 8 * 16; e += NGT) {
            const int n = e & 1023, hb = e >> 10, h = hb >> 4, r0 = (hb & 15) * 8;
            float acc8[8] = {0.f, 0.f, 0.f, 0.f, 0.f, 0.f, 0.f, 0.f};
            const float* pb = wdo + (size_t)(h * 64) * DM + n;
#pragma unroll 4
            for (int d = 0; d < 64; ++d) { const float bv = pb[(size_t)d * DM];
#pragma unroll
                for (int j = 0; j < 8; ++j) acc8[j] += wuv[((size_t)(r0 + j) * 8 + h) * 64 + d] * bv; }
            u32x4 w; w.x = pk2h(acc8[0], acc8[1]); w.y = pk2h(acc8[2], acc8[3]); w.z = pk2h(acc8[4], acc8[5]); w.w = pk2h(acc8[6], acc8[7]);
            *(u32x4*)(wvo + (size_t)n * 1024 + h * 128 + r0) = w;
        }
    }
    PR_MARK(2);
    cvt_rows_f16_ss(F0, INP(a, I_X), (f16*)(F.ws + WS_X16), (f16*)(F.ws + WS_SS1), T, gw, NGW);
    norm_rows_f16(F0, INP(a, I_MEM), INP(a, I_MEMNORM), (f16*)(F.ws + WS_MEMN), BATCH * MEMLEN, gw, NGW);
    PR_MARK(3);
    float* rc = (float*)(F.ws + WS_ROPE); float* rs = rc + 4096 * 32;
    for (int e = gt; e < 4096 * 32; e += NGT) { const int pos = e >> 5, i = e & 31; const float fr = exp2f(-(float)i * (13.287712379549449f / 32.f)), ang = (float)pos * fr; rc[e] = cosf(ang); rs[e] = sinf(ang); }
    float* tb = (float*)(F.ws + WS_TB);
    for (int e = gt; e < 256 * 8; e += NGT) { const int ri = e >> 3, h = e & 7; tb[e] = INP(a, I_RELBIAS)[t5_bucket(ri - 192) * 8 + h]; }
    PR_MARK(4);
    return pp_acc;
}

__device__ __forceinline__ float dpp_sum16(float v) {
#define DS_(c) v += __int_as_float(__builtin_amdgcn_update_dpp(0, __float_as_int(v), c, 0xf, 0xf, false));
    DS_(0xB1) DS_(0x4E) DS_(0x141) DS_(0x140)
#undef DS_
    return v;
}
__device__ __forceinline__ void dsa_norms_rows(const unsigned char* wsb, const float* qn, const float* kn, const int lane_in, const int m_lo, const int nstep) {
    int lane = lane_in; asm volatile("" : "+v"(lane));
    f16* CQ = (f16*)(wsb + WS_CQ); const f16* MISC = (const f16*)(wsb + WS_MISC); f16* CKVN = (f16*)(wsb + WS_CKVN); f16* IKC = (f16*)(wsb + WS_IKC);
    const int c = lane & 15, sub = lane >> 4;
    f32x4 gq[4], gk[2];
#pragma unroll
    for (int i = 0; i < 4; ++i) gq[i] = ((const f32x4*)qn)[4 * c + i];
#pragma unroll
    for (int i = 0; i < 2; ++i) gk[i] = ((const f32x4*)kn)[2 * c + i];
#pragma unroll 1
    for (int st = 0; st < nstep; st += 2) {
        h8 q0[2], q1[2], kv[2], ik[2];
#pragma unroll
        for (int u = 0; u < 2; ++u) { const int m = m_lo + 4 * (st + u) + sub;
            if (st + u < nstep) { q0[u] = *(const h8*)(CQ + (size_t)m * 256 + 16 * c); q1[u] = *(const h8*)(CQ + (size_t)m * 256 + 16 * c + 8); kv[u] = *(const h8*)(MISC + (size_t)m * 256 + 8 * c);
                ik[u] = *(const h8*)(MISC + (size_t)m * 256 + 128 + 8 * (c & 3)); } }
#pragma unroll
        for (int u = 0; u < 2; ++u) { const int m = m_lo + 4 * (st + u) + sub;
            if (st + u < nstep) {
                float qf_[16], kf_[8]; float sq = 0.f, sk = 0.f;
#pragma unroll
                for (int j = 0; j < 8; ++j) { qf_[j] = (float)q0[u][j]; qf_[8 + j] = (float)q1[u][j]; kf_[j] = (float)kv[u][j]; sq += qf_[j] * qf_[j] + qf_[8 + j] * qf_[8 + j]; sk += kf_[j] * kf_[j]; }
                sq = dpp_sum16(sq); sk = dpp_sum16(sk);
                const float rq = 1.f / sqrtf(sq * (1.f / 256.f) + 1e-6f), rk = 1.f / sqrtf(sk * (1.f / 128.f) + 1e-6f);
                u32x4 w0_, w1_, wk_;
                w0_.x = pk2h(qf_[0] * rq * gq[0].x, qf_[1] * rq * gq[0].y); w0_.y = pk2h(qf_[2] * rq * gq[0].z, qf_[3] * rq * gq[0].w); w0_.z = pk2h(qf_[4] * rq * gq[1].x, qf_[5] * rq * gq[1].y); w0_.w = pk2h(qf_[6] * rq * gq[1].z, qf_[7] * rq * gq[1].w);
                w1_.x = pk2h(qf_[8] * rq * gq[2].x, qf_[9] * rq * gq[2].y); w1_.y = pk2h(qf_[10] * rq * gq[2].z, qf_[11] * rq * gq[2].w); w1_.z = pk2h(qf_[12] * rq * gq[3].x, qf_[13] * rq * gq[3].y); w1_.w = pk2h(qf_[14] * rq * gq[3].z, qf_[15] * rq * gq[3].w);
                wk_.x = pk2h(kf_[0] * rk * gk[0].x, kf_[1] * rk * gk[0].y); wk_.y = pk2h(kf_[2] * rk * gk[0].z, kf_[3] * rk * gk[0].w); wk_.z = pk2h(kf_[4] * rk * gk[1].x, kf_[5] * rk * gk[1].y); wk_.w = pk2h(kf_[6] * rk * gk[1].z, kf_[7] * rk * gk[1].w);
                *(u32x4*)(CQ + (size_t)m * 256 + 16 * c) = w0_; *(u32x4*)(CQ + (size_t)m * 256 + 16 * c + 8) = w1_; *(u32x4*)(CKVN + (size_t)m * 128 + 8 * c) = wk_;
                if (c < 4) *(h8*)(IKC + (size_t)m * 32 + 8 * c) = ik[u];
            } }
    }
}
__device__ __forceinline__ void p_dsa_norms(const FrameU& F0, KArgs a, int l, int w0, int wstride) {
    const Frame F = relaunder(F0);
    const float* qn = INP(a, I_QNORM) + l * 256; const float* kn = INP(a, I_KVNORM) + l * 128;
#pragma unroll 1
    for (int ch = w0; ch < T / 32; ch += wstride) dsa_norms_rows(F.ws, qn, kn, F.lane, 32 * ch, 8);
}
__device__ __forceinline__ void p_retention_simple(const FrameU& F0, int unit) {
    const Frame F = relaunder(F0);
    const int b = unit >> 3, h = unit & 7;
    LAS float* Qf = (LAS float*)F.lds; LAS float* Kf = Qf + 64 * 65; LAS float* Vf = Kf + 64 * 65; LAS float* Sf = Vf + 64 * 65; LAS float* St = Sf + 64 * 65; LAS float* Of = St + 64 * 65; LAS float* Kd = Of + 64 * 65;
    const f16* RQ = (const f16*)(F.ws + WS_RQ); const f16* RK = (const f16*)(F.ws + WS_RK); const f16* RV = (const f16*)(F.ws + WS_RV); f16* GM = (f16*)(F.dout + DO_GM);
    const float* rc = (const float*)(F.ws + WS_ROPE); const float* rs = rc + 4096 * 32;
    const float lg = log2f(1.f - exp2f(-5.f - (float)h));
    const int tid = F.tid, i = tid >> 3, cg = tid & 7;
    for (int e = tid; e < 64 * 65; e += NTHREADS) St[e] = 0.f;
    if (tid < 64) Kd[tid] = exp2f(lg * (float)(63 - tid));
    const float g64 = exp2f(lg * 64.f);
    for (int n = 0; n < 64; ++n) {
        const size_t row = (size_t)b * SEQ + 64 * n + i; const int pos = 64 * n + i;
        const h8 qv = *(const h8*)(RQ + row * 512 + h * 64 + 8 * cg), kv = *(const h8*)(RK + row * 512 + h * 64 + 8 * cg), vv = *(const h8*)(RV + row * 512 + h * 64 + 8 * cg);
        const h8 gv = *(const h8*)(GM + row * 1024 + h * 64 + 8 * cg);
        const float* cp = rc + pos * 32 + 8 * (cg & 3); const float* sp = rs + pos * 32 + 8 * (cg & 3);
#pragma unroll
        for (int j = 0; j < 8; ++j) {
            const float q = (float)qv[j], k = (float)kv[j]; const float pq = sx(q, 4, F.lane), pk = sx(k, 4, F.lane); const float c = cp[j], s = sp[j];
            const float qo = (cg < 4) ? (q * c - pq * s) : (q * c + pq * s), ko = (cg < 4) ? (k * c - pk * s) : (k * c + pk * s);
            Qf[i * 65 + 8 * cg + j] = qo; Kf[i * 65 + 8 * cg + j] = ko * 0.125f; Vf[i * 65 + 8 * cg + j] = (float)vv[j];
        }
        __syncthreads();
#pragma unroll 1
        for (int jj = 0; jj < 8; ++jj) { const int j = cg + 8 * jj; float s = 0.f;
            for (int d = 0; d < 64; ++d) s += Qf[i * 65 + d] * Kf[j * 65 + d];
            const int dd = i > j ? i - j : j - i; Sf[i * 65 + j] = s * exp2f(lg * (float)dd); }
        __syncthreads();
        float ns[8];
        const float qd = exp2f(lg * (float)(i + 1));
#pragma unroll 1
        for (int ee = 0; ee < 8; ++ee) { const int e = cg + 8 * ee; float s1 = 0.f, s2 = 0.f, s3 = 0.f;
            for (int j = 0; j < 64; ++j) s1 += Sf[i * 65 + j] * Vf[j * 65 + e];
            for (int d = 0; d < 64; ++d) s2 += Qf[i * 65 + d] * St[d * 65 + e];
            Of[i * 65 + e] = s1 + qd * s2;
            for (int j = 0; j < 64; ++j) s3 += Kf[j * 65 + i] * Kd[j] * Vf[j * 65 + e];
            ns[ee] = g64 * St[i * 65 + e] + s3; }
        __syncthreads();
#pragma unroll
        for (int ee = 0; ee < 8; ++ee) St[i * 65 + cg + 8 * ee] = ns[ee];
        float ov[8]; float s = 0.f;
#pragma unroll
        for (int j = 0; j < 8; ++j) { ov[j] = Of[i * 65 + 8 * cg + j]; s += ov[j]; }
        s += sx(s, 1, F.lane); s += sx(s, 2, F.lane); s += sx(s, 4, F.lane);
        const float mu = s * (1.f / 64.f); float q = 0.f;
#pragma unroll
        for (int j = 0; j < 8; ++j) { ov[j] -= mu; q += ov[j] * ov[j]; }
        q += sx(q, 1, F.lane); q += sx(q, 2, F.lane); q += sx(q, 4, F.lane);
        const float rstd = 1.f / sqrtf(q * (1.f / 64.f) + 1e-5f);
        float ro[8];
#pragma unroll
        for (int j = 0; j < 8; ++j) { const float g = (float)gv[j]; ro[j] = ov[j] * rstd * (g / (1.f + __expf(-g))); }
        u32x4 w; w.x = pk2h(ro[0], ro[1]); w.y = pk2h(ro[2], ro[3]); w.z = pk2h(ro[4], ro[5]); w.w = pk2h(ro[6], ro[7]);
        *(u32x4*)(GM + row * 1024 + h * 64 + 8 * cg) = w;
        __syncthreads();
    }
}


constexpr int NSEGR = 2, RSPLIT = 40;
__device__ __forceinline__ void p_retention(const FrameU& F0, int unit) {
    const Frame F = relaunder(F0);
    constexpr int LD = 72;
    LAS f16* Qs = (LAS f16*)F.lds; LAS f16* Ks = Qs + 64 * LD; LAS f16* Kdt = Ks + 64 * LD; LAS f16* Vt = Kdt + 64 * LD; LAS f16* Ss = Vt + 64 * LD; LAS f16* Stt = Ss + 64 * LD;
    LAS float* Os = (LAS float*)(Stt + 2 * 64 * LD);
    const int bh = unit / NSEGR, seg = unit - bh * NSEGR, b = bh >> 3, h = bh & 7;
    const int n_lo = seg == 0 ? 0 : RSPLIT, n_hi = seg == 0 ? RSPLIT : 64;
    const f16* RQ = (const f16*)(F.ws + WS_RQ); const f16* RK = (const f16*)(F.ws + WS_RK); const f16* RV = (const f16*)(F.ws + WS_RV); f16* GM = (f16*)(F.dout + DO_GM);
    const float* rc = (const float*)(F.ws + WS_ROPE); const float* rs = rc + 4096 * 32;
    const float lg = log2f(1.f - exp2f(-5.f - (float)h));
    const int tid = F.tid, lane = F.lane, wave = F.wave;
    const int i = tid >> 3, cg = tid & 7;
    const int r16 = lane & 15, g = lane >> 4, rb = wave & 3, cbp = wave >> 2;
    const float g64 = exp2f(lg * 64.f), kdec = exp2f(lg * (float)(63 - i)) * 0.125f;
    float dec[2][4], qd[4];
#pragma unroll
    for (int ii = 0; ii < 4; ++ii) { const int ri = 16 * rb + 4 * g + ii; qd[ii] = exp2f(lg * (float)(ri + 1));
#pragma unroll
        for (int cb = 0; cb < 2; ++cb) { const int cj = 16 * (2 * cbp + cb) + r16; dec[cb][ii] = exp2f(lg * (float)(ri > cj ? ri - cj : cj - ri)); } }
    f32x4 st[2] = {(f32x4){0.f, 0.f, 0.f, 0.f}, (f32x4){0.f, 0.f, 0.f, 0.f}};
    const size_t rowb = (size_t)b * SEQ + i; const int colh = h * 64 + 8 * cg;
    h8 qv, kv, vv, gv; f32x4 c0, c1, s0, s1;
#define RLOAD(n, full) do { const size_t row_ = rowb + 64 * (n); kv = *(const h8*)(RK + row_ * 512 + colh); vv = *(const h8*)(RV + row_ * 512 + colh); \
        if (full) { qv = *(const h8*)(RQ + row_ * 512 + colh); gv = *(const h8*)(GM + row_ * 1024 + colh); } \
        const float* cp_ = rc + (size_t)(64 * (n) + i) * 32 + 8 * (cg & 3); const float* sp_ = rs + (size_t)(64 * (n) + i) * 32 + 8 * (cg & 3); \
        c0 = *(const f32x4*)cp_; c1 = *(const f32x4*)(cp_ + 4); s0 = *(const f32x4*)sp_; s1 = *(const f32x4*)(sp_ + 4); } while (0)
#define RSTAGE(full) do { float cs_[8] = {c0.x, c0.y, c0.z, c0.w, c1.x, c1.y, c1.z, c1.w}, sn_[8] = {s0.x, s0.y, s0.z, s0.w, s1.x, s1.y, s1.z, s1.w}; float ko_[8], qo_[8]; \
        _Pragma("unroll") for (int j_ = 0; j_ < 8; ++j_) { const float k_ = (float)kv[j_], pk_ = sx(k_, 4, F.lane); ko_[j_] = (cg < 4) ? (k_ * cs_[j_] - pk_ * sn_[j_]) : (k_ * cs_[j_] + pk_ * sn_[j_]); \
            if (full) { const float q_ = (float)qv[j_], pq_ = sx(q_, 4, F.lane); qo_[j_] = (cg < 4) ? (q_ * cs_[j_] - pq_ * sn_[j_]) : (q_ * cs_[j_] + pq_ * sn_[j_]); } } \
        _Pragma("unroll") for (int j_ = 0; j_ < 8; ++j_) { Kdt[(8 * cg + j_) * LD + i] = (f16)(ko_[j_] * kdec); Vt[(8 * cg + j_) * LD + i] = vv[j_]; } \
        if (full) { u32x4 wq_, wk_; wq_.x = pk2h(qo_[0], qo_[1]); wq_.y = pk2h(qo_[2], qo_[3]); wq_.z = pk2h(qo_[4], qo_[5]); wq_.w = pk2h(qo_[6], qo_[7]); \
            wk_.x = pk2h(ko_[0] * 0.125f, ko_[1] * 0.125f); wk_.y = pk2h(ko_[2] * 0.125f, ko_[3] * 0.125f); wk_.z = pk2h(ko_[4] * 0.125f, ko_[5] * 0.125f); wk_.w = pk2h(ko_[6] * 0.125f, ko_[7] * 0.125f); \
            *(LAS u32x4*)(Qs + i * LD + 8 * cg) = wq_; *(LAS u32x4*)(Ks + i * LD + 8 * cg) = wk_; } } while (0)
#define FRAG(P, row, ks) (*(const LAS h8*)((P) + (row) * LD + 32 * (ks) + 8 * g))
    if (n_lo > 0) RLOAD(0, false);
    for (int n = 0; n < n_lo; ++n) {
        RSTAGE(false);
        if (n + 1 < n_lo) RLOAD(n + 1, false);
        __syncthreads();
#pragma unroll
        for (int cb = 0; cb < 2; ++cb) { const int colb = 16 * (2 * cbp + cb) + r16; f32x4 a = st[cb] * g64;
#pragma unroll
            for (int ks = 0; ks < 2; ++ks) a = __builtin_amdgcn_mfma_f32_16x16x32_f16(FRAG(Kdt, 16 * rb + r16, ks), FRAG(Vt, colb, ks), a, 0, 0, 0);
            st[cb] = a; }
        __syncthreads();
    }
    int cur = 0;
#pragma unroll
    for (int cb = 0; cb < 2; ++cb) { const int colb = 16 * (2 * cbp + cb) + r16; u32x2 w; w.x = pk2h(st[cb][0], st[cb][1]); w.y = pk2h(st[cb][2], st[cb][3]); *(LAS u32x2*)(Stt + colb * LD + 16 * rb + 4 * g) = w; }
    RLOAD(n_lo, true);
    for (int n = n_lo; n < n_hi; ++n) {
        RSTAGE(true);
        const h8 gcur = gv; const size_t orow = rowb + 64 * n;
        if (n + 1 < n_hi) RLOAD(n + 1, true);
        __syncthreads();
        h8 aq[2]; aq[0] = FRAG(Qs, 16 * rb + r16, 0); aq[1] = FRAG(Qs, 16 * rb + r16, 1);
#pragma unroll
        for (int cb = 0; cb < 2; ++cb) { const int colb = 16 * (2 * cbp + cb) + r16; f32x4 sacc = (f32x4){0.f, 0.f, 0.f, 0.f};
#pragma unroll
            for (int ks = 0; ks < 2; ++ks) sacc = __builtin_amdgcn_mfma_f32_16x16x32_f16(aq[ks], FRAG(Ks, colb, ks), sacc, 0, 0, 0);
#pragma unroll
            for (int ii = 0; ii < 4; ++ii) Ss[(16 * rb + 4 * g + ii) * LD + colb] = (f16)(sacc[ii] * dec[cb][ii]); }
        __syncthreads();
        LAS f16* Sc = Stt + cur * 64 * LD; LAS f16* Sn = Stt + (cur ^ 1) * 64 * LD;
        h8 as[2], akd[2]; as[0] = FRAG(Ss, 16 * rb + r16, 0); as[1] = FRAG(Ss, 16 * rb + r16, 1); akd[0] = FRAG(Kdt, 16 * rb + r16, 0); akd[1] = FRAG(Kdt, 16 * rb + r16, 1);
#pragma unroll
        for (int cb = 0; cb < 2; ++cb) { const int colb = 16 * (2 * cbp + cb) + r16;
            f32x4 ai = (f32x4){0.f, 0.f, 0.f, 0.f}, ac = (f32x4){0.f, 0.f, 0.f, 0.f}, a = st[cb] * g64;
#pragma unroll
            for (int ks = 0; ks < 2; ++ks) { const h8 bv = FRAG(Vt, colb, ks), bs = FRAG(Sc, colb, ks);
                ai = __builtin_amdgcn_mfma_f32_16x16x32_f16(as[ks], bv, ai, 0, 0, 0);
                ac = __builtin_amdgcn_mfma_f32_16x16x32_f16(aq[ks], bs, ac, 0, 0, 0);
                a = __builtin_amdgcn_mfma_f32_16x16x32_f16(akd[ks], bv, a, 0, 0, 0); }
            st[cb] = a;
#pragma unroll
            for (int ii = 0; ii < 4; ++ii) Os[(16 * rb + 4 * g + ii) * 68 + colb] = ai[ii] + qd[ii] * ac[ii];
            u32x2 w; w.x = pk2h(a[0], a[1]); w.y = pk2h(a[2], a[3]); *(LAS u32x2*)(Sn + colb * LD + 16 * rb + 4 * g) = w; }
        cur ^= 1;
        __syncthreads();
        {
            const f32x4 o0 = *(const LAS f32x4*)(Os + i * 68 + 8 * cg), o1 = *(const LAS f32x4*)(Os + i * 68 + 8 * cg + 4);
            float ov[8] = {o0.x, o0.y, o0.z, o0.w, o1.x, o1.y, o1.z, o1.w}; float s = 0.f;
#pragma unroll
            for (int j = 0; j < 8; ++j) s += ov[j];
            s += sx(s, 1, F.lane); s += sx(s, 2, F.lane); s += sx(s, 4, F.lane);
            const float mu = s * (1.f / 64.f); float q = 0.f;
#pragma unroll
            for (int j = 0; j < 8; ++j) { ov[j] -= mu; q += ov[j] * ov[j]; }
            q += sx(q, 1, F.lane); q += sx(q, 2, F.lane); q += sx(q, 4, F.lane);
            const float rstd = 1.f / sqrtf(q * (1.f / 64.f) + 1e-5f);
            float ro[8];
#pragma unroll
            for (int j = 0; j < 8; ++j) { const float gg = (float)gcur[j]; ro[j] = ov[j] * rstd * (gg / (1.f + __expf(-gg))); }
            u32x4 w; w.x = pk2h(ro[0], ro[1]); w.y = pk2h(ro[2], ro[3]); w.z = pk2h(ro[4], ro[5]); w.w = pk2h(ro[6], ro[7]);
            *(u32x4*)(GM + orow * 1024 + colh) = w;
        }
    }
    __syncthreads();
#undef RLOAD
#undef RSTAGE
#undef FRAG
}

constexpr size_t DO_KVT = 128 * MiB;
constexpr int RLD = 72;
template <int OFF> __device__ __forceinline__ h4 rtr(unsigned vb) { h4 r; asm volatile("ds_read_b64_tr_b16 %0, %1 offset:%2" : "=&v"(r) : "v"(vb), "i"(OFF) : "memory"); return r; }
#define RPK(L, H) (h8){L[0], L[1], L[2], L[3], H[0], H[1], H[2], H[3]}
__device__ __forceinline__ void rtr_settle(h4& a, h4& b, h4& c, h4& d) { asm volatile("s_waitcnt lgkmcnt(0)" : "+v"(a), "+v"(b), "+v"(c), "+v"(d) : : "memory"); }
#define RPKF(o) (u32x4){pk2h(o[0], o[1]), pk2h(o[2], o[3]), pk2h(o[4], o[5]), pk2h(o[6], o[7])}
__device__ __forceinline__ void ret_kv_item(const unsigned char* wsb, unsigned char* doutb, LAS f16* Kd, const int lane_in, const int item) {
    int lane = lane_in; asm volatile("" : "+v"(lane));
    const int r16 = lane & 15, g = lane >> 4;
    LAS f16* Vs = Kd + 64 * RLD;
    const f16* RK = (const f16*)(wsb + WS_RK); const f16* RV = (const f16*)(wsb + WS_RV); f16* KVT = (f16*)(doutb + DO_KVT);
    const float* rc = (const float*)(wsb + WS_ROPE);
    const unsigned trb = (unsigned)(((8 * g + (r16 >> 2)) * RLD + 4 * (lane & 3)) * 2);
    const unsigned kb = (unsigned)(size_t)Kd + trb, vb = (unsigned)(size_t)Vs + trb;
    const unsigned lo_v = (unsigned)(((lane >> 3) * 512 + 8 * (lane & 7)) * 2), lo_f = (unsigned)((r16 * 512 + 8 * g) * 2), lo_t = (unsigned)((r16 * 32 + 8 * g) * 4), lo_o = (unsigned)((r16 * 64 + 4 * g) * 2);
    {
        const int bh = item >> 6, n = item & 63, b = bh >> 3, h = bh & 7;
        const float lg = log2f(1.f - exp2f(-5.f - (float)h));
        const size_t row0 = (size_t)b * SEQ + 64 * n;
        const char* vbase = (const char*)(RV + row0 * 512 + h * 64); const char* kbase = (const char*)(RK + row0 * 512 + h * 64);
        const char* cbase = (const char*)(rc + (size_t)(64 * n) * 32); const char* sbase = cbase + 4096 * 32 * 4;
        h8 vv[8];
#pragma unroll
        for (int k = 0; k < 8; ++k) vv[k] = *(const h8*)(vbase + lo_v + k * 8192);
#pragma unroll
        for (int rb = 0; rb < 4; ++rb) { const int ri = 16 * rb + r16;
            const h8 k0 = *(const h8*)(kbase + lo_f + rb * 16384), k1 = *(const h8*)(kbase + lo_f + rb * 16384 + 64);
            const f32x4 c0 = *(const f32x4*)(cbase + lo_t + rb * 2048), c1 = *(const f32x4*)(cbase + lo_t + rb * 2048 + 16), s0 = *(const f32x4*)(sbase + lo_t + rb * 2048), s1 = *(const f32x4*)(sbase + lo_t + rb * 2048 + 16);
            const float cs[8] = {c0.x, c0.y, c0.z, c0.w, c1.x, c1.y, c1.z, c1.w}, sn[8] = {s0.x, s0.y, s0.z, s0.w, s1.x, s1.y, s1.z, s1.w};
            const float kd = exp2f(lg * (float)(63 - ri)) * 0.125f;
            float o0[8], o1[8];
#pragma unroll
            for (int j = 0; j < 8; ++j) { const float a = (float)k0[j], c = (float)k1[j]; o0[j] = (a * cs[j] - c * sn[j]) * kd; o1[j] = (c * cs[j] + a * sn[j]) * kd; }
            *(LAS u32x4*)(Kd + ri * RLD + 8 * g) = RPKF(o0); *(LAS u32x4*)(Kd + ri * RLD + 32 + 8 * g) = RPKF(o1); }
#pragma unroll
        for (int k = 0; k < 8; ++k) *(LAS h8*)(Vs + (8 * k + (lane >> 3)) * RLD + 8 * (lane & 7)) = vv[k];
        LDS_WAIT();
        h8 af[4][2], bf[4][2];
        {   h4 ar[4][4], br[4][4];
#pragma unroll
            for (int x = 0; x < 4; ++x) {
                ar[x][0] = rtr<0>(kb + 32 * x); ar[x][1] = rtr<4 * RLD * 2>(kb + 32 * x); ar[x][2] = rtr<32 * RLD * 2>(kb + 32 * x); ar[x][3] = rtr<36 * RLD * 2>(kb + 32 * x);
                br[x][0] = rtr<0>(vb + 32 * x); br[x][1] = rtr<4 * RLD * 2>(vb + 32 * x); br[x][2] = rtr<32 * RLD * 2>(vb + 32 * x); br[x][3] = rtr<36 * RLD * 2>(vb + 32 * x); }
#pragma unroll
            for (int x = 0; x < 4; ++x) { rtr_settle(ar[x][0], ar[x][1], ar[x][2], ar[x][3]); rtr_settle(br[x][0], br[x][1], br[x][2], br[x][3]); }
            __builtin_amdgcn_sched_barrier(0);
#pragma unroll
            for (int x = 0; x < 4; ++x) { af[x][0] = RPK(ar[x][0], ar[x][1]); af[x][1] = RPK(ar[x][2], ar[x][3]); bf[x][0] = RPK(br[x][0], br[x][1]); bf[x][1] = RPK(br[x][2], br[x][3]); } }
        char* out = (char*)(KVT + (size_t)item * 4096);
#pragma unroll
        for (int db = 0; db < 4; ++db)
#pragma unroll
            for (int eb = 0; eb < 4; ++eb) { f32x4 acc = {0.f, 0.f, 0.f, 0.f};
                acc = __builtin_amdgcn_mfma_f32_16x16x32_f16(af[db][0], bf[eb][0], acc, 0, 0, 0); acc = __builtin_amdgcn_mfma_f32_16x16x32_f16(af[db][1], bf[eb][1], acc, 0, 0, 0);
                u32x2 w; w.x = pk2h(acc[0], acc[1]); w.y = pk2h(acc[2], acc[3]); *(u32x2*)(out + lo_o + eb * 2048 + db * 32) = w; }
    }
}
__device__ __forceinline__ void p_ret_kv(const FrameU& F0, int gw, int ngw) {
    const Frame F = relaunder(F0);
    LAS f16* Kd = (LAS f16*)(F.lds + F.wave * (2 * 64 * RLD * 2));
#pragma unroll 1
    for (int item = gw; item < 8192; item += ngw) ret_kv_item(F.ws, F.dout, Kd, F.lane, item);
}
__device__ __forceinline__ void p_phase2_dyn(const FrameU& F0, KArgs a, int l, unsigned* qctr) {
    const Frame F = relaunder(F0);
    const float* qn = INP(a, I_QNORM) + l * 256; const float* kn = INP(a, I_KVNORM) + l * 128;
    LAS f16* Kd = (LAS f16*)(F.lds + F.wave * (2 * 64 * RLD * 2));
    constexpr int QN = (8192 + T / 32) / 8;
    const int qx = blockIdx.x & 7; qctr += 64 * qx;
    int item = 0, nxt = 0;
    if (F.lane == 0) item = (int)__hip_atomic_fetch_add(qctr, 1u, __ATOMIC_RELAXED, __HIP_MEMORY_SCOPE_AGENT);
    item = __builtin_amdgcn_readfirstlane(item);
#pragma unroll 1
    while (item < QN) {
        if (F.lane == 0) nxt = (int)__hip_atomic_fetch_add(qctr, 1u, __ATOMIC_RELAXED, __HIP_MEMORY_SCOPE_AGENT);
        const int id = 8 * item + qx;
        if (id < 8192) ret_kv_item(F.ws, F.dout, Kd, F.lane, id);
        else dsa_norms_rows(F.ws, qn, kn, F.lane, 32 * (id - 8192), 8);
        item = __builtin_amdgcn_readfirstlane(nxt);
    }
}
__device__ __forceinline__ void p_ret_scan(const FrameU& F0, int gw, int ngw) {
    const Frame F = relaunder(F0);
    f16* KVT = (f16*)(F.dout + DO_KVT);
#pragma unroll 1
    for (int slot = gw * 64 + F.lane; slot < 128 * 1024; slot += ngw * 64) {
        const int bh = slot >> 10, e4 = slot & 1023, h = bh & 7;
        const float g64 = exp2f(64.f * log2f(1.f - exp2f(-5.f - (float)h)));
        f16* p = KVT + (size_t)bh * (64 * 4096) + e4 * 4;
        f32x4 acc = {0.f, 0.f, 0.f, 0.f};
#pragma unroll 1
        for (int n0 = 0; n0 < 64; n0 += 16) {
            h4 v[16];
#pragma unroll
            for (int k = 0; k < 16; ++k) v[k] = *(const h4*)(p + (size_t)(n0 + k) * 4096);
#pragma unroll
            for (int k = 0; k < 16; ++k) { u32x2 w; w.x = pk2h(acc[0], acc[1]); w.y = pk2h(acc[2], acc[3]); *(u32x2*)(p + (size_t)(n0 + k) * 4096) = w;
                acc[0] = acc[0] * g64 + (float)v[k][0]; acc[1] = acc[1] * g64 + (float)v[k][1]; acc[2] = acc[2] * g64 + (float)v[k][2]; acc[3] = acc[3] * g64 + (float)v[k][3]; }
        }
    }
}
__device__ __forceinline__ void ret_out_item(const unsigned char* wsb, unsigned char* doutb, LAS f16* Vs, const int lane_in, const int item) {
    int lane = lane_in; asm volatile("" : "+v"(lane));
    const int r16 = lane & 15, g = lane >> 4;
    const f16* RQ = (const f16*)(wsb + WS_RQ); const f16* RK = (const f16*)(wsb + WS_RK); const f16* RV = (const f16*)(wsb + WS_RV); f16* GM = (f16*)(doutb + DO_GM); const f16* KVT = (const f16*)(doutb + DO_KVT);
    const float* rc = (const float*)(wsb + WS_ROPE);
    const unsigned vb = (unsigned)(size_t)Vs + (unsigned)(((4 * g + (r16 >> 2)) * RLD + 4 * (lane & 3)) * 2);
    const unsigned lo_v = (unsigned)(((lane >> 3) * 512 + 8 * (lane & 7)) * 2), lo_f = (unsigned)((r16 * 512 + 8 * g) * 2), lo_t = (unsigned)((r16 * 32 + 8 * g) * 4), lo_s = (unsigned)((r16 * 64 + 8 * g) * 2), lo_g = (unsigned)((r16 * 1024 + 4 * g) * 2);
    {
        const int bh = item >> 6, n = item & 63, b = bh >> 3, h = bh & 7;
        const float lg = log2f(1.f - exp2f(-5.f - (float)h));
        const size_t row0 = (size_t)b * SEQ + 64 * n;
        const char* vbase = (const char*)(RV + row0 * 512 + h * 64); const char* kbase = (const char*)(RK + row0 * 512 + h * 64); const char* qbase = (const char*)(RQ + row0 * 512 + h * 64);
        const char* cbase = (const char*)(rc + (size_t)(64 * n) * 32); const char* sbase = cbase + 4096 * 32 * 4;
        const char* stb = (const char*)(KVT + (size_t)item * 4096); char* gbase = (char*)(GM + row0 * 1024 + h * 64);
        h8 P[4][2], qf[4][2], sf[4][2]; h4 gq[4][4];
        {
            h8 vv[8];
#pragma unroll
            for (int k = 0; k < 8; ++k) vv[k] = *(const h8*)(vbase + lo_v + k * 8192);
            h8 kf[4][2];
#pragma unroll
            for (int rb = 0; rb < 4; ++rb) {
                const h8 k0 = *(const h8*)(kbase + lo_f + rb * 16384), k1 = *(const h8*)(kbase + lo_f + rb * 16384 + 64), q0 = *(const h8*)(qbase + lo_f + rb * 16384), q1 = *(const h8*)(qbase + lo_f + rb * 16384 + 64);
                const f32x4 c0 = *(const f32x4*)(cbase + lo_t + rb * 2048), c1 = *(const f32x4*)(cbase + lo_t + rb * 2048 + 16), s0 = *(const f32x4*)(sbase + lo_t + rb * 2048), s1 = *(const f32x4*)(sbase + lo_t + rb * 2048 + 16);
                const float cs[8] = {c0.x, c0.y, c0.z, c0.w, c1.x, c1.y, c1.z, c1.w}, sn[8] = {s0.x, s0.y, s0.z, s0.w, s1.x, s1.y, s1.z, s1.w};
                float o0[8], o1[8], p0[8], p1[8];
#pragma unroll
                for (int j = 0; j < 8; ++j) { const float a = (float)k0[j], c = (float)k1[j]; o0[j] = (a * cs[j] - c * sn[j]) * 0.125f; o1[j] = (c * cs[j] + a * sn[j]) * 0.125f;
                    const float x = (float)q0[j], y = (float)q1[j]; p0[j] = x * cs[j] - y * sn[j]; p1[j] = y * cs[j] + x * sn[j]; }
                kf[rb][0] = __builtin_bit_cast(h8, RPKF(o0)); kf[rb][1] = __builtin_bit_cast(h8, RPKF(o1)); qf[rb][0] = __builtin_bit_cast(h8, RPKF(p0)); qf[rb][1] = __builtin_bit_cast(h8, RPKF(p1)); }
#pragma unroll
            for (int k = 0; k < 8; ++k) *(LAS h8*)(Vs + (8 * k + (lane >> 3)) * RLD + 8 * (lane & 7)) = vv[k];
            asm volatile("" ::: "memory");
#pragma unroll
            for (int eb = 0; eb < 4; ++eb)
#pragma unroll
                for (int ks = 0; ks < 2; ++ks) sf[eb][ks] = *(const h8*)(stb + lo_s + eb * 2048 + ks * 64);
#pragma unroll
            for (int ib = 0; ib < 4; ++ib)
#pragma unroll
                for (int eb = 0; eb < 4; ++eb) gq[ib][eb] = *(const h4*)(gbase + lo_g + ib * 32768 + 32 * eb);
            int cdl = r16 - 4 * g; asm volatile("" : "+v"(cdl));
#pragma unroll
            for (int ib = 0; ib < 4; ++ib)
#pragma unroll
                for (int ks = 0; ks < 2; ++ks) { float pv[8];
#pragma unroll
                    for (int t = 0; t < 2; ++t) { const int jb = 2 * ks + t; f32x4 s = {0.f, 0.f, 0.f, 0.f};
                        s = __builtin_amdgcn_mfma_f32_16x16x32_f16(kf[jb][0], qf[ib][0], s, 0, 0, 0); s = __builtin_amdgcn_mfma_f32_16x16x32_f16(kf[jb][1], qf[ib][1], s, 0, 0, 0);
#pragma unroll
                        for (int ii = 0; ii < 4; ++ii) { const int dl = 16 * (ib - jb) + cdl - ii; pv[4 * t + ii] = s[ii] * exp2f(lg * (float)(dl < 0 ? -dl : dl)); } }
                    P[ib][ks] = __builtin_bit_cast(h8, RPKF(pv)); }
        }
        LDS_WAIT();
        h8 vf[4][2];
        {   h4 vr[4][4];
#pragma unroll
            for (int eb = 0; eb < 4; ++eb) { vr[eb][0] = rtr<0>(vb + 32 * eb); vr[eb][1] = rtr<16 * RLD * 2>(vb + 32 * eb); vr[eb][2] = rtr<32 * RLD * 2>(vb + 32 * eb); vr[eb][3] = rtr<48 * RLD * 2>(vb + 32 * eb); }
#pragma unroll
            for (int eb = 0; eb < 4; ++eb) rtr_settle(vr[eb][0], vr[eb][1], vr[eb][2], vr[eb][3]);
            __builtin_amdgcn_sched_barrier(0);
#pragma unroll
            for (int eb = 0; eb < 4; ++eb) { vf[eb][0] = RPK(vr[eb][0], vr[eb][1]); vf[eb][1] = RPK(vr[eb][2], vr[eb][3]); } }
#pragma unroll
        for (int ib = 0; ib < 4; ++ib) {
            char* gp = gbase + lo_g + ib * 32768;
            const float qd = exp2f(lg * (float)(16 * ib + r16 + 1));
            f32x4 O[4]; float sm = 0.f;
#pragma unroll
            for (int eb = 0; eb < 4; ++eb) { f32x4 a = {0.f, 0.f, 0.f, 0.f};
                a = __builtin_amdgcn_mfma_f32_16x16x32_f16(sf[eb][0], qf[ib][0], a, 0, 0, 0); a = __builtin_amdgcn_mfma_f32_16x16x32_f16(sf[eb][1], qf[ib][1], a, 0, 0, 0);
                a = a * qd;
                a = __builtin_amdgcn_mfma_f32_16x16x32_f16(vf[eb][0], P[ib][0], a, 0, 0, 0); a = __builtin_amdgcn_mfma_f32_16x16x32_f16(vf[eb][1], P[ib][1], a, 0, 0, 0);
                O[eb] = a; sm += (a[0] + a[1]) + (a[2] + a[3]); }
            sm += sx(sm, 16, lane); sm += sx(sm, 32, lane);
            const float mu = sm * (1.f / 64.f); float q = 0.f;
#pragma unroll
            for (int eb = 0; eb < 4; ++eb)
#pragma unroll
                for (int ii = 0; ii < 4; ++ii) { O[eb][ii] -= mu; q += O[eb][ii] * O[eb][ii]; }
            q += sx(q, 16, lane); q += sx(q, 32, lane);
            const float rstd = 1.f / sqrtf(q * (1.f / 64.f) + 1e-5f);
#pragma unroll
            for (int eb = 0; eb < 4; ++eb) { float ro[4];
#pragma unroll
                for (int ii = 0; ii < 4; ++ii) { const float gg = (float)gq[ib][eb][ii]; ro[ii] = O[eb][ii] * rstd * (gg / (1.f + __expf(-gg))); }
                u32x2 w; w.x = pk2h(ro[0], ro[1]); w.y = pk2h(ro[2], ro[3]); *(u32x2*)(gp + 32 * eb) = w; }
        }
    }
}
__device__ __forceinline__ void p_ret_out(const FrameU& F0, int gw, int ngw) {
    const Frame F = relaunder(F0);
    LAS f16* Vs = (LAS f16*)(F.lds + F.wave * (64 * RLD * 2));
#pragma unroll 1
    for (int item = gw; item < 8192; item += ngw) ret_out_item(F.ws, F.dout, Vs, F.lane, item);
}
#undef RPK
#undef RPKF

__device__ __forceinline__ unsigned wave_max_u(unsigned v) {
#define MX_(c, rm) { const unsigned t_ = (unsigned)__builtin_amdgcn_update_dpp(0, (int)v, c, rm, 0xf, false); v = v > t_ ? v : t_; }
    MX_(0x111, 0xf) MX_(0x112, 0xf) MX_(0x114, 0xf) MX_(0x118, 0xf) MX_(0x142, 0xa) MX_(0x143, 0xc)
#undef MX_
    return (unsigned)__builtin_amdgcn_readlane((int)v, 63);
}
__device__ __forceinline__ float wave_max_f(float v) {
#define MX_(c, rm) { const float t_ = __int_as_float(__builtin_amdgcn_update_dpp((int)0xFF800000, __float_as_int(v), c, rm, 0xf, false)); v = fmaxf(v, t_); }
    MX_(0x111, 0xf) MX_(0x112, 0xf) MX_(0x114, 0xf) MX_(0x118, 0xf) MX_(0x142, 0xa) MX_(0x143, 0xc)
#undef MX_
    return __int_as_float(__builtin_amdgcn_readlane(__float_as_int(v), 63));
}
__device__ __forceinline__ int lbin_clamp2(int b) { b = b < 0 ? 0 : b; return b > 2303 ? 2303 : b; }
__device__ __forceinline__ int lbin_clamp(int b) { b = b < 0 ? 0 : b; return b > 2047 ? 2047 : b; }
__device__ __forceinline__ float k2f(unsigned k) { const unsigned b = k ^ ((unsigned)((int)(~k) >> 31) | 0x80000000u); return __uint_as_float(b); }
__device__ __forceinline__ unsigned fkey(float v) { const unsigned b = __float_as_uint(v); return b ^ ((unsigned)((int)b >> 31) | 0x80000000u); }
#ifndef TK_RANK_MAX
#define TK_RANK_MAX 64
#endif
#ifndef TK_PROBE_SEC
#define TK_PROBE_SEC 0
#endif
#define TK_MARK(sec) do { if (TK_PROBE_SEC) { const unsigned long long t_ = __builtin_amdgcn_s_memrealtime(); if (TK_PROBE_SEC == (sec)) tk_acc += t_ - tk_t; tk_t = t_; } } while (0)
__device__ __forceinline__ unsigned long long p_topk(const FrameU& F0) {
    const Frame F = relaunder(F0);
    unsigned long long tk_acc = 0ull, tk_t = TK_PROBE_SEC ? __builtin_amdgcn_s_memrealtime() : 0ull;
    unsigned z0_ = 0u; asm volatile("" : "+v"(z0_)); const u32x4 zq_ = {z0_, z0_, z0_, z0_};
    LAS float* sc = (LAS float*)F.lds;
    LAS float* wqa = (LAS float*)(F.lds + 131072);
    const f16* QIDX = (const f16*)(F.dout + DO_QIDX); const f16* MISC = (const f16*)(F.ws + WS_MISC); const f16* IKC = (const f16*)(F.ws + WS_IKC); unsigned* MASK = (unsigned*)(F.dout + DO_MASK);
    const int tid = F.tid, lane = F.lane, wave = F.wave;
    const int m = lane & 31, hi = lane >> 5;
    const int am = m >> 3, ag = (m >> 2) & 1, ajj = m & 3;
    for (int cu = blockIdx.x; cu < 1024; cu += F.G) {
        const int kq = cu & 255, sel = cu >> 8, b = kq & 15, j = kq >> 4;
        const int c = sel == 0 ? j : (sel == 1 ? 31 - j : (sel == 2 ? 32 + j : 63 - j));
        const int N = 64 * (c + 1), tc0 = b * SEQ + 64 * c, NTe = c < 2 ? 4 : ((c + 2) & ~1), nb = N >> 5, ni = N >> 6;
        if (c < 4) {
#pragma unroll 1
            for (int q = wave; q < 64; q += NWAVES) { unsigned long long* mrow = (unsigned long long*)(MASK + (size_t)(tc0 + q) * 128); if (lane < NTe) mrow[lane] = lane < (c + 1) ? ~0ull : 0ull; }
            continue;
        }
        wqa[tid] = (float)MISC[(size_t)(tc0 + (tid >> 3)) * 256 + 160 + (tid & 7)];
        h8 Af[2][2];
#define TK_LOADA(sub) do { _Pragma("unroll") for (int ti = 0; ti < 2; ++ti) { const int q_ = 8 * (sub) + 4 * ti + 2 * ag + (am >> 1), hd_ = 4 * (am & 1) + ajj; \
            _Pragma("unroll") for (int ks = 0; ks < 2; ++ks) Af[ti][ks] = *(const h8*)(QIDX + (size_t)(tc0 + q_) * 256 + hd_ * 32 + 16 * ks + 8 * hi); } } while (0)
        TK_LOADA(0);
        __syncthreads();
        TK_MARK(5);
#pragma unroll 1
        for (int sub = 0; sub < 8; ++sub) {
            {
                float wv[2][16];
#pragma unroll
                for (int ti = 0; ti < 2; ++ti)
#pragma unroll
                    for (int rg = 0; rg < 16; ++rg) wv[ti][rg] = wqa[(8 * sub + 4 * ti + 2 * hi + (rg >> 3)) * 8 + (rg & 7)];
                const f16* kbase = IKC + (size_t)b * SEQ * 32 + m * 32 + 8 * hi;
                int kb = wave; h8 B0 = {}, B1 = {};
                if (kb < nb) { const f16* kp = kbase + (size_t)kb * 1024; B0 = *(const h8*)kp; B1 = *(const h8*)(kp + 16); }
                while (kb < nb) {
                    const int kn = kb + NWAVES; h8 n0 = {}, n1 = {};
                    if (kn < nb) { const f16* kp = kbase + (size_t)kn * 1024; n0 = *(const h8*)kp; n1 = *(const h8*)(kp + 16); }
                    f32x16 a0 = {}, a1 = {};
                    a0 = __builtin_amdgcn_mfma_f32_32x32x16_f16(Af[0][0], B0, a0, 0, 0, 0); a0 = __builtin_amdgcn_mfma_f32_32x32x16_f16(Af[0][1], B1, a0, 0, 0, 0);
                    a1 = __builtin_amdgcn_mfma_f32_32x32x16_f16(Af[1][0], B0, a1, 0, 0, 0); a1 = __builtin_amdgcn_mfma_f32_32x32x16_f16(Af[1][1], B1, a1, 0, 0, 0);
                    float s00 = 0.f, s01 = 0.f, s10 = 0.f, s11 = 0.f;
#pragma unroll
                    for (int rg = 0; rg < 8; ++rg) { s00 += wv[0][rg] * fmaxf(a0[rg], 0.f); s01 += wv[0][8 + rg] * fmaxf(a0[8 + rg], 0.f); s10 += wv[1][rg] * fmaxf(a1[rg], 0.f); s11 += wv[1][8 + rg] * fmaxf(a1[8 + rg], 0.f); }
                    const int key = kb * 32 + m;
                    sc[(2 * hi) * 4096 + key] = s00 + 0.f; sc[(2 * hi + 1) * 4096 + key] = s01 + 0.f; sc[(4 + 2 * hi) * 4096 + key] = s10 + 0.f; sc[(5 + 2 * hi) * 4096 + key] = s11 + 0.f;
                    B0 = n0; B1 = n1; kb = kn;
                }
            }
            if (sub < 7) TK_LOADA(sub + 1);
            TK_MARK(1);
            __syncthreads();
            {
                unsigned long long* mrow = (unsigned long long*)(MASK + (size_t)(tc0 + 8 * sub + wave) * 128);
                const LAS float* s = sc + wave * 4096;
                float f[64];
#pragma unroll
                for (int blk = 0; blk < 4; ++blk) {
                    if ((blk + 1) * 16 <= ni) {
#pragma unroll
                        for (int ii = 0; ii < 16; ++ii) f[blk * 16 + ii] = s[(blk * 16 + ii) * 64 + lane];
                    } else if (blk * 16 < ni) {
                        int rem = ni - blk * 16; asm volatile("" : "+v"(rem));
#pragma unroll
                        for (int ii = 0; ii < 16; ++ii) { const float v = s[(blk * 16 + ii) * 64 + lane]; f[blk * 16 + ii] = (ii < rem) ? v : __builtin_nanf(""); }
                    } else {
#pragma unroll
                        for (int ii = 0; ii < 16; ++ii) f[blk * 16 + ii] = __builtin_nanf("");
                    }
                }
                __syncthreads();
                TK_MARK(2);
                LAS unsigned* hist = (LAS unsigned*)F.lds + wave * 2560;
                LAS float* mlist = (LAS float*)(hist + 2304);
                float vmx = -INFINITY, vmnn = -INFINITY;
#pragma unroll
                for (int blk = 0; blk < 4; ++blk) if (blk * 16 < ni) {
#pragma unroll
                    for (int ii = 0; ii < 16; ++ii) { const float v = f[blk * 16 + ii]; vmx = fmaxf(vmx, v); vmnn = fmaxf(vmnn, -v); } }
                vmx = wave_max_f(vmx); vmnn = wave_max_f(vmnn);
                const float vlo = -vmnn, span = vmx - vlo;
                const float scl = (span > 0.f && span < 3.0e38f) ? 2301.5f / span : 0.f;
#define LBIN(x) lbin_clamp2((int)fmaf((x) - vlo, scl, 1.0f))
#pragma unroll
                for (int q_ = 0; q_ < 9; ++q_) *(LAS u32x4*)(hist + q_ * 256 + lane * 4) = zq_;
#pragma unroll
                for (int blk = 0; blk < 4; ++blk) if (blk * 16 < ni) {
#pragma unroll
                    for (int ii = 0; ii < 16; ++ii) __hip_atomic_fetch_add(hist + LBIN(f[blk * 16 + ii]), 1u, __ATOMIC_RELAXED, __HIP_MEMORY_SCOPE_WORKGROUP); }
                LDS_WAIT();
                int d1, krem;
                {
                    unsigned cb_[36];
#pragma unroll
                    for (int q_ = 0; q_ < 9; ++q_) { const u32x4 t_ = *(const LAS u32x4*)(hist + lane * 36 + q_ * 4); cb_[q_ * 4] = t_.x; cb_[q_ * 4 + 1] = t_.y; cb_[q_ * 4 + 2] = t_.z; cb_[q_ * 4 + 3] = t_.w; }
                    int tl_ = 0;
#pragma unroll
                    for (int q_ = 0; q_ < 36; ++q_) tl_ += (int)cb_[q_];
                    const int inc_ = wave_incl_scan(tl_), tot_ = __builtin_amdgcn_readlane(inc_, 63), Sx_ = tot_ - inc_;
                    const bool mine_ = (Sx_ < 256) && (256 <= Sx_ + tl_);
                    const unsigned long long bm_ = __ballot(mine_); const int src_ = bm_ ? (__ffsll((long long)bm_) - 1) : 0;
                    int acc_ = Sx_, dd_ = 0, gt_ = 0; bool fnd_ = false;
#pragma unroll
                    for (int q_ = 35; q_ >= 0; --q_) { const int c_ = (int)cb_[q_]; if (!fnd_ && acc_ + c_ >= 256) { dd_ = q_; gt_ = acc_; fnd_ = true; } acc_ += c_; }
                    dd_ += lane * 36; d1 = shfl_i(dd_, src_); krem = 256 - shfl_i(gt_, src_);
                }
                int mcnt = 0;
                const unsigned long long lt_mask = (1ull << lane) - 1ull;
                float scl2 = scl; asm volatile("" : "+v"(scl2));
#define LBINB(x) lbin_clamp2((int)fmaf((x) - vlo, scl2, 1.0f))
#pragma unroll
                for (int blk = 0; blk < 4; ++blk) if (blk * 16 < ni) {
#pragma unroll
                    for (int ii = 0; ii < 16; ++ii) { float v = f[blk * 16 + ii]; asm volatile("" : "+v"(v));
                        const bool isin = LBINB(v) == d1; const unsigned long long bm = __ballot(isin);
                        if (__builtin_expect(bm != 0ull, 0)) { const int pos = mcnt + __popcll(bm & lt_mask); if (isin && pos < 64) mlist[pos] = v; mcnt += __popcll(bm); } } }
#undef LBIN
#undef LBINB
                float thr; int need, ceq;
                if (__builtin_expect(mcnt <= TK_RANK_MAX, 1)) {
                    LDS_WAIT();
                    const float x = (lane < mcnt) ? mlist[lane] : __builtin_nanf("");
                    int cgt = 0, cge = 0;
#pragma unroll 1
                    for (int t = 0; t < mcnt; ++t) { const float y = mlist[t]; cgt += (y > x) ? 1 : 0; cge += (y >= x) ? 1 : 0; }
                    const bool holder = (lane < mcnt) && (cgt < krem) && (krem <= cge);
                    const unsigned long long bmh = __ballot(holder); const int srch = bmh ? (__ffsll((long long)bmh) - 1) : 0;
                    thr = __int_as_float(shfl_i(__float_as_int(x), srch)); need = krem - shfl_i(cgt, srch); ceq = shfl_i(cge - cgt, srch);
                } else {
                    unsigned tk = 0u;
#pragma unroll 1
                    for (int bit = 31; bit >= 0; --bit) { const unsigned cand = tk | (1u << bit); const float cf = k2f(cand); int cnt = 0;
#pragma unroll
                        for (int i = 0; i < 64; ++i) cnt += (f[i] >= cf) ? 1 : 0;
                        cnt = __builtin_amdgcn_readlane(wave_incl_scan(cnt), 63); if (cnt >= 256) tk = cand; }
                    const float tf = k2f(tk); int cg = 0, ce = 0;
#pragma unroll
                    for (int i = 0; i < 64; ++i) { cg += (f[i] > tf) ? 1 : 0; ce += (f[i] == tf) ? 1 : 0; }
                    cg = __builtin_amdgcn_readlane(wave_incl_scan(cg), 63); ce = __builtin_amdgcn_readlane(wave_incl_scan(ce), 63);
                    thr = k2f(tk); need = 256 - cg; ceq = ce;
                }
                TK_MARK(3);
                unsigned wlo = 0u, whi = 0u;
                if (need == ceq) {
#pragma unroll
                    for (int blk = 0; blk < 4; ++blk) if (blk * 16 < ni) {
#pragma unroll
                        for (int ii = 0; ii < 16; ++ii) { const int i = blk * 16 + ii; const unsigned long long bs = __ballot(f[i] >= thr);
                            asm volatile("s_nop 1\n\tv_writelane_b32 %0, %2, %4\n\tv_writelane_b32 %1, %3, %4" : "+v"(wlo), "+v"(whi) : "s"((unsigned)bs), "s"((unsigned)(bs >> 32)), "n"(i)); } }
                } else {
                    int tbf = 0;
#pragma unroll
                    for (int blk = 0; blk < 4; ++blk) if (blk * 16 < ni) {
#pragma unroll
                        for (int ii = 0; ii < 16; ++ii) { const int i = blk * 16 + ii; const float v = f[i]; const bool gtb = v > thr, eq = (v == thr);
                            const unsigned long long beq = __ballot(eq); const int rank = tbf + __popcll(beq & lt_mask);
                            const unsigned long long bs = __ballot(gtb || (eq && rank < need)); tbf += __popcll(beq);
                            asm volatile("s_nop 1\n\tv_writelane_b32 %0, %2, %4\n\tv_writelane_b32 %1, %3, %4" : "+v"(wlo), "+v"(whi) : "s"((unsigned)bs), "s"((unsigned)(bs >> 32)), "n"(i)); } }
                }
                if (lane < NTe) { u32x2 w2; w2.x = wlo; w2.y = whi; *(u32x2*)(mrow + lane) = w2; }
            }
            __syncthreads();
            TK_MARK(4);
        }
#undef TK_LOADA
    }
    return tk_acc;
}

__device__ __forceinline__ void p_dsa_attn_simple(const FrameU& F0) {
    const Frame F = relaunder(F0);
    f16* OLAT = (f16*)(F.ws + WS_H); const f16* CKVN = (const f16*)(F.ws + WS_CKVN); const unsigned* MASK = (const unsigned*)(F.dout + DO_MASK); const float* tb = (const float*)(F.ws + WS_TB);
    const int gw = blockIdx.x * NWAVES + F.wave, NGW = F.G * NWAVES, lane = F.lane;
    for (int task = gw; task < T * 8; task += NGW) {
        const int t = task >> 3, h = task & 7, b = t >> 12, tp = t & 4095, c = tp >> 6, N = 64 * (c + 1);
        h2* qp = (h2*)(OLAT + (size_t)t * 1024 + h * 128) + lane; const h2 qv = *qp; const float q0 = qv[0], q1 = qv[1];
        const unsigned* mrow = MASK + (size_t)t * 128;
        float m = -1e30f, ls = 0.f, o0 = 0.f, o1 = 0.f;
        for (int w = 0; w < N / 32; ++w) {
            unsigned bits = __builtin_amdgcn_readfirstlane(mrow[w]);
            while (bits) { const int bit = __builtin_ctz(bits); bits &= bits - 1u; const int s = 32 * w + bit;
                const h2 cv = *((const h2*)(CKVN + (size_t)(b * SEQ + s) * 128) + lane); const float c0 = cv[0], c1 = cv[1];
                const float part = wave_sum(q0 * c0 + q1 * c1, F.lane);
                const int rel = s - tp, ri = rel < -192 ? 0 : rel + 192;
                const float logit = part + tb[ri * 8 + h];
                const float mn = fmaxf(m, logit), al = __expf(m - mn), p = __expf(logit - mn);
                ls = ls * al + p; o0 = o0 * al + p * c0; o1 = o1 * al + p * c1; m = mn; }
        }
        const float inv = 1.f / ls;
        *(unsigned*)qp = pk2h(o0 * inv, o1 * inv);
    }
}


__device__ __forceinline__ void p_dsa_attn(const FrameU& F0, const float* relb) {
    const Frame F = relaunder(F0);
    f16* OLAT = (f16*)(F.ws + WS_H); const f16* CKVN = (const f16*)(F.ws + WS_CKVN); const unsigned long long* MASK = (const unsigned long long*)(F.dout + DO_MASK); const float* tb = (const float*)(F.ws + WS_TB);
    LAS float* tbl = (LAS float*)(F.lds + 69632);
    for (int e = F.tid; e < 4096; e += NTHREADS) { const int rel = (e >> 3) - 320, h = e & 7; int ri = rel + 192; ri = ri < 0 ? 0 : ri; tbl[e] = (ri < 256 ? tb[ri * 8 + h] : relb[t5_bucket(rel) * 8 + h]) - tb[h]; }
    for (int idx = blockIdx.x; idx < 2048; idx += F.G) {
        const int kq = idx & 255, r = idx >> 8, b = kq & 15, j = kq >> 4, sel = r >> 1, half = r & 1;
        const int c = sel == 0 ? j : (sel == 1 ? 31 - j : (sel == 2 ? 32 + j : 63 - j));
        const int NTe = c < 2 ? 4 : ((c + 2) & ~1), tq0 = 64 * c + 32 * half; const size_t t0 = (size_t)b * SEQ + tq0;
        __syncthreads();
        att::dsa_attn_unit(OLAT + t0 * 1024, CKVN + (size_t)b * SEQ * 128, MASK + t0 * 64, NTe, tq0, tbl, F.ldsg, F.wave);
    }
}


__device__ __forceinline__ unsigned long long p_dsa_attn_gw(const FrameU& F0, const float* relb, unsigned* ctr) {
    unsigned long long acc_ = 0ull;
    const Frame F = relaunder(F0);
    f16* OLAT = (f16*)(F.ws + WS_H); const f16* CKVN = (const f16*)(F.ws + WS_CKVN); const unsigned long long* MASK = (const unsigned long long*)(F.dout + DO_MASK);
    LAS float* tbl = (LAS float*)(F.lds + 8 * att::GW_BYTES);
    for (int e = F.tid; e < 2048; e += NTHREADS) { const int rel = (e >> 3) - 128, h = e & 7; tbl[e] = (e >> 3) == 0 ? 0.f : relb[t5_bucket(rel) * 8 + h] - relb[15 * 8 + h]; }
    __syncthreads();
    LAS unsigned char* wl = F.lds + F.wave * att::GW_BYTES;
    unsigned* qctr = ctr + 64 * (blockIdx.x & 7);
    constexpr bool RIA = RET_IN_ATTN && RET_SPLIT3 && !RET_SIMPLE;
    constexpr int NATT = ATT16 ? 4096 : 2048, PER = ATT16 ? 4 : 2, QN = NATT + (RIA ? 1024 : 0);
#define Q_PULL(v) do { if (F.lane == 0) v = (int)__hip_atomic_fetch_add(qctr, 1u, __ATOMIC_RELAXED, __HIP_MEMORY_SCOPE_AGENT); } while (0)
#define Q_DEC(it, ai, isret) do { ai = (it); isret = false; if (RIA) { const int qq_ = (it) / (PER + 1), rr_ = (it) - (PER + 1) * qq_; isret = rr_ == PER; ai = isret ? qq_ : PER * qq_ + rr_; } } while (0)
#if ATT16
    int item = 0, nxt = 0, nx2 = 0;
    Q_PULL(item); item = __builtin_amdgcn_readfirstlane(item); Q_PULL(nxt); nxt = __builtin_amdgcn_readfirstlane(nxt);
    att::Pre16 pre;
#define Q_PRE(P, an_) do { const int c2 = 63 - ((an_) >> 6), b2 = (blockIdx.x & 7) + 8 * (((an_) >> 5) & 1), tq2 = 64 * c2 + 32 * (((an_) >> 4) & 1) + 2 * ((an_) & 15); const size_t tw2 = (size_t)b2 * SEQ + tq2; \
        att::pre16_load(P, OLAT + tw2 * 1024, MASK + tw2 * 64, c2 + 1, F.lane); } while (0)
    { int a0; bool r0; Q_DEC(item, a0, r0); if (item < QN && !r0) Q_PRE(pre, a0); }
    while (item < QN) {
        Q_PULL(nx2);
        int ai, an; bool isret, nret; Q_DEC(item, ai, isret); Q_DEC(nxt, an, nret);
        const bool npre = nxt < QN && !nret;
        if (isret) {
            ret_out_item(F.ws, F.dout, (LAS f16*)wl, F.lane, (((blockIdx.x & 7) + 8 * (ai >> 9)) * 8) * 64 + (ai & 511));
            if (npre) Q_PRE(pre, an);
        } else {
            const int c = 63 - (ai >> 6), b = (blockIdx.x & 7) + 8 * ((ai >> 5) & 1), tq = 64 * c + 32 * ((ai >> 4) & 1) + 2 * (ai & 15); const size_t tw = (size_t)b * SEQ + tq;
            att::Pre16 pn = pre;
            if (npre) Q_PRE(pn, an);
            acc_ += att::dsa_attn_wave16(OLAT + tw * 1024, CKVN + (size_t)b * SEQ * 128, pre, c + 1, tq, tbl, wl, F.lane);
            pre = pn;
        }
        item = nxt; nxt = __builtin_amdgcn_readfirstlane(nx2);
    }
#undef Q_PRE
#else
    int item = 0, nxt = 0;
    Q_PULL(item); item = __builtin_amdgcn_readfirstlane(item);
    while (item < QN) {
        Q_PULL(nxt);
        int ai; bool isret; Q_DEC(item, ai, isret);
        if (isret) {
            ret_out_item(F.ws, F.dout, (LAS f16*)wl, F.lane, (((blockIdx.x & 7) + 8 * (ai >> 9)) * 8) * 64 + (ai & 511));
        } else {
            const int c = 63 - (ai >> 5), b = (blockIdx.x & 7) + 8 * ((ai >> 4) & 1), half = (ai >> 3) & 1, wg = ai & 7;
            const int tq = 64 * c + 32 * half + 4 * wg; const size_t tw = (size_t)b * SEQ + tq;
            acc_ += att::dsa_attn_wave32(OLAT + tw * 1024, CKVN + (size_t)b * SEQ * 128, MASK + tw * 64, c + 1, tq, tbl, wl, F.lane);
        }
        item = __builtin_amdgcn_readfirstlane(nxt);
    }
#endif
#undef Q_PULL
#undef Q_DEC
    __syncthreads();
    return acc_;
}

constexpr int PH_PRO = 0, PH_PER_LAYER = 11, PH_FINAL = 1 + DEPTH * PH_PER_LAYER, NPHASES = PH_FINAL + 1;
#ifndef PG8_SP2
#define PG8_SP2 true
#endif
#ifndef PG8_ALIGN
#define PG8_ALIGN true
#endif

__global__ void __launch_bounds__(NTHREADS, 2) mega_fwd(Args args) {
    extern __shared__ __attribute__((aligned(16))) unsigned char lds[];
    KArgs kp = (KArgs)__builtin_amdgcn_kernarg_segment_ptr();
    asm volatile("" : "+s"(kp));
    FrameU F;
    F.lds = (LAS unsigned char*)lds; F.ldsg = (char*)lds; F.ws = args.ws; F.dout = (unsigned char*)args.out; F.G = gridDim.x; F.wave0 = __builtin_amdgcn_readfirstlane(threadIdx.x >> 6);
    volatile LAS unsigned* MISCW = (volatile LAS unsigned*)(F.lds + LDSCTL_OFF);
    if (threadIdx.x < 64) MISCW[threadIdx.x] = 0u;
    __syncthreads();
    unsigned* ctl = (unsigned*)(args.ws + WS_CTL);
    XcdBarrier bar; bar.bar = ctl + CW_BAR; bar.x = 0; bar.st = MISCW + 8; bar.wave = F.wave0;
    const int lo = args.ph_lo, hi = args.ph_hi;
    if (hi - lo > 1) bar = xcd_barrier_post(ctl + CW_BAR, MISCW + 8, F.wave0);
#ifndef PHMASK
#define PHMASK 0xFFFF
#endif
#define HAS(p) ((PHMASK >> (p)) & 1)
#define IN(k) (lo <= (k) && (k) < hi)
#ifndef PROBE_MASK
#define PROBE_MASK 0
#endif
#ifndef PROBE_MULT
#define PROBE_MULT 8
#endif
    unsigned long long pr_acc = 0ull, pr_prev = PROBE_MASK ? __builtin_amdgcn_s_memrealtime() : 0ull;
#define SEAM_T(k, bit) do { if (IN(k) && IN((k) + 1)) xcd_barrier(bar); if (PROBE_MASK) { const unsigned long long t_ = __builtin_amdgcn_s_memrealtime(); if ((PROBE_MASK >> (bit)) & 1) pr_acc += t_ - pr_prev; pr_prev = t_; } } while (0)
#define SEAM(k) SEAM_T(k, (k) == PH_PRO ? 11 : ((k) - 1) % PH_PER_LAYER)
    const int NGW = F.G * NWAVES;
#define GW (blockIdx.x * NWAVES + F.wave0)
    unsigned char* ws0 = args.ws;
    float* xout0 = args.out;
#define PHASE_PTRS GAS unsigned char* wsg_ = (GAS unsigned char*)ws0; GAS float* xog_ = (GAS float*)xout0; asm volatile("" : "+s"(wsg_), "+s"(xog_)); unsigned char* ws = (unsigned char*)wsg_; float* xout = (float*)xog_; unsigned char* dob = (unsigned char*)xog_; (void)dob; unsigned char* wl = ws + WS_W + (size_t)l * W_LAYER; (void)wl; (void)xout; int bx_ = blockIdx.x, gg_ = F.G; asm volatile("" : "+s"(bx_), "+s"(gg_)); (void)bx_; (void)gg_;

    if (HAS(11) && IN(PH_PRO)) { const unsigned long long p_ = p_prologue(F, kp); if (PRO_PROBE_SEC) pr_acc += p_; }
    SEAM(PH_PRO);

    for (int l = 0; l < DEPTH; ++l) {
        const int P0 = 1 + l * PH_PER_LAYER;

        if (HAS(1) && IN(P0 + 1)) { PHASE_PTRS
            {
              pg8::Order<1> S; S.init(T, NZ, gg_, bx_);
              pg8::EpiF16<0> E{};
              E.base[0] = (f16*)(ws + WS_RQ); E.ld[0] = 512; E.lo[0] = 0;
              E.base[1] = (f16*)(ws + WS_RK); E.ld[1] = 512; E.lo[1] = 2;
              E.base[2] = (f16*)(ws + WS_RV); E.ld[2] = 512; E.lo[2] = 4;
              E.base[3] = (f16*)(dob + DO_GM); E.ld[3] = 1024; E.lo[3] = 6;
              E.base[4] = (f16*)(ws + WS_CQ); E.ld[4] = 256; E.lo[4] = 8;
              E.base[5] = (f16*)(ws + WS_MISC); E.ld[5] = 256; E.lo[5] = 9;
              E.base[6] = (f16*)(dob + DO_GM) + 512; E.ld[6] = 1024; E.lo[6] = 10;
              E.base[7] = (f16*)(ws + WS_GATES); E.ld[7] = 3072; E.lo[7] = 12; E.nd = 8; E.ss = (const f16*)(ws + WS_SS1);
              pg8::gemm_phase<pg8::EpiF16<0>, 1, PG8_ALIGN, PG8_SP2>(F.lds, (const f16*)(ws + WS_X16), nullptr, nullptr, (const f16*)(wl + W_IN), nullptr, nullptr, DM, 0, 0, DM, DM, S, E, F.wave0); }
#if !(P2_DYN && RET_SPLIT3 && !RET_SIMPLE)
            {
              pg8::Order<1> S; S.init(BATCH * MEMLEN, 1024, gg_, bx_);
              pg8::EpiF16<0> E{}; E.base[0] = (f16*)(ws + WS_MKV); E.ld[0] = 1024; E.lo[0] = 0; E.nd = 1;
              pg8::gemm_phase<pg8::EpiF16<0>, 1, PG8_ALIGN, PG8_SP2>(F.lds, (const f16*)(ws + WS_MEMN), nullptr, nullptr, (const f16*)(wl + W_MKV), nullptr, nullptr, DM, 0, 0, DM, DM, S, E, F.wave0); }
#endif
        }
        SEAM(P0 + 1);
        if (HAS(2) && IN(P0 + 2)) { PHASE_PTRS
#if RET_SIMPLE
            if (F.G >= 256) { if (blockIdx.x >= 128) p_dsa_norms(F, kp, l, GW - 128 * NWAVES, (F.G - 128) * NWAVES); }
            else p_dsa_norms(F, kp, l, GW, NGW);
            for (int u = blockIdx.x; u < 128; u += F.G) p_retention_simple(F, u);
#elif RET_SPLIT3 && P2_DYN
            {
              pg8::Order<1> S; S.init(BATCH * MEMLEN, 1024, gg_, bx_);
              pg8::EpiF16<0> E{}; E.base[0] = (f16*)(ws + WS_MKV); E.ld[0] = 1024; E.lo[0] = 0; E.nd = 1;
              pg8::gemm_phase<pg8::EpiF16<0>, 1, PG8_ALIGN, PG8_SP2>(F.lds, (const f16*)(ws + WS_MEMN), nullptr, nullptr, (const f16*)(wl + W_MKV), nullptr, nullptr, DM, 0, 0, DM, DM, S, E, F.wave0); }
            asm volatile("s_waitcnt vmcnt(0)" ::: "memory"); __syncthreads();
            p_phase2_dyn(F, kp, l, (unsigned*)(ws + WS_CTL) + CW_P2Q + 512 * l);
#elif RET_SPLIT3
            p_ret_kv(F, GW, NGW);
            p_dsa_norms(F, kp, l, GW, NGW);
#else
            p_dsa_norms(F, kp, l, GW, NGW);
            for (int u = blockIdx.x; u < 128 * NSEGR; u += F.G) p_retention(F, u);
#endif
        }
        SEAM(P0 + 2);
        if (HAS(3) && IN(P0 + 3)) { PHASE_PTRS
#if RET_SPLIT3 && !RET_SIMPLE
            p_ret_scan(F, GW, NGW);
#endif
            pg8::Order<1> S; S.init(T, 1280, gg_, bx_);
            pg8::EpiF16<0> E{}; E.base[0] = (f16*)(ws + WS_H); E.ld[0] = 1024; E.lo[0] = 0; E.base[1] = (f16*)(dob + DO_QIDX); E.ld[1] = 256; E.lo[1] = 4; E.nd = 2;
            pg8::gemm_phase<pg8::EpiF16<0>, 1, PG8_ALIGN, PG8_SP2>(F.lds, (const f16*)(ws + WS_CQ), nullptr, nullptr, (const f16*)(wl + W_DQ), nullptr, nullptr, 256, 0, 0, 256, 256, S, E, F.wave0);
        }
        SEAM(P0 + 3);
        if (HAS(4) && IN(P0 + 4)) {
#if RET_SPLIT3 && !RET_SIMPLE && !RET_IN_ATTN
            p_ret_out(F, GW, NGW); __syncthreads();
#endif
            const unsigned long long tk_ = p_topk(F); if (TK_PROBE_SEC) pr_acc += tk_; }
        SEAM(P0 + 4);
        if (HAS(5) && IN(P0 + 5)) { PHASE_PTRS
#if DSA_SIMPLE
            p_dsa_attn_simple(F);
#else
#if DSA_GATHER
            { const unsigned long long a_ = p_dsa_attn_gw(F, INP(kp, I_RELBIAS), (unsigned*)(ws + WS_CTL) + CW_ATTQ + 512 * l); if (ATT_PROBE_SEC) pr_acc += a_; }
#else
            p_dsa_attn(F, INP(kp, I_RELBIAS));
#endif
#endif
            f16* GM = (f16*)(dob + DO_GM); const f16* MKV = (const f16*)(ws + WS_MKV);
            for (int u = blockIdx.x; u < BATCH * 4 * 16; u += F.G) {
                const int b = u >> 6, h = (u >> 4) & 3, qb = u & 15;
                f16* q = GM + (size_t)(b * SEQ + qb * 256) * 1024 + 512 + h * 128; const f16* k = MKV + (size_t)(b * MEMLEN) * 1024 + h * 128;
                __syncthreads();
                att::attn_dense_body<1024, 1024, 1024>(q, k, k + 512, q, MEMLEN, F.ldsg, 0.088388347648318440f, F.wave0);
            }
        }
        SEAM(P0 + 5);
        if (HAS(6) && IN(P0 + 6)) { PHASE_PTRS
            const f16* GM = (const f16*)(dob + DO_GM); const f16* WRM = (const f16*)(wl + W_RM);

            pg8::Order<3> S; S.init(T, 1024, gg_, bx_);
            pg8::EpiMerge E{(const f16*)(ws + WS_GATES), (f16*)(dob + DO_MERGED)};
            pg8::gemm_phase<pg8::EpiMerge, 3, PG8_ALIGN, PG8_SP2>(F.lds, GM, (const f16*)(ws + WS_H), GM + 512, WRM, (const f16*)(wl + W_VO), WRM + 512, 512, 1024, 512, 1024, 1024, S, E, F.wave0);
        }
        SEAM(P0 + 6);
        if (HAS(7) && IN(P0 + 7)) { PHASE_PTRS

            pg8::Order<1> S; S.init(T, DM, gg_, bx_);
            pg8::EpiRes E{(f16*)(ws + WS_X16), (f16*)(ws + WS_SS2), (LAS float*)(F.lds + 131072)};
            pg8::gemm_phase<pg8::EpiRes, 1, PG8_ALIGN, PG8_SP2>(F.lds, (const f16*)(dob + DO_MERGED), nullptr, nullptr, (const f16*)(wl + W_OUT), nullptr, nullptr, DM, 0, 0, DM, DM, S, E, F.wave0);
        }
        SEAM(P0 + 7);
        if (HAS(9) && IN(P0 + 9)) { PHASE_PTRS

            pg8::Order<1> S; S.init(T, FF, gg_, bx_);
            pg8::EpiF16<1, true> E{}; E.base[0] = (f16*)(ws + WS_HID); E.ld[0] = FF; E.lo[0] = 0; E.nd = 1; E.ss = (const f16*)(ws + WS_SS2);
            pg8::gemm_phase<pg8::EpiF16<1, true>, 1, PG8_ALIGN, PG8_SP2>(F.lds, (const f16*)(ws + WS_X16), nullptr, nullptr, (const f16*)(wl + W_FF1), nullptr, nullptr, DM, 0, 0, DM, DM, S, E, F.wave0);
        }
        SEAM(P0 + 9);
        if (HAS(10) && IN(P0 + 10)) { PHASE_PTRS

            pg8::Order<1> S; S.init(T, DM, gg_, bx_);
            if (l + 1 < DEPTH) norm_rows_f16(F, INP(kp, I_MEM), INP(kp, I_MEMNORM) + (l + 1) * DM, (f16*)(ws + WS_MEMN), BATCH * MEMLEN, GW, NGW);
            pg8::EpiRes E{(f16*)(ws + WS_X16), (l + 1 < DEPTH) ? (f16*)(ws + WS_SS1) : (f16*)nullptr, (LAS float*)(F.lds + 131072)};
            pg8::gemm_phase<pg8::EpiRes, 1, PG8_ALIGN, PG8_SP2>(F.lds, (const f16*)(ws + WS_HID), nullptr, nullptr, (const f16*)(wl + W_FF2), nullptr, nullptr, FF, 0, 0, FF, FF, S, E, F.wave0);
        }
        SEAM(P0 + 10);
    }
    if ((PROBE_MASK || TK_PROBE_SEC || ATT_PROBE_SEC || PRO_PROBE_SEC) && blockIdx.x == 0 && F.wave0 == 0) { const unsigned long long t0_ = __builtin_amdgcn_s_memrealtime(); while (__builtin_amdgcn_s_memrealtime() - t0_ < pr_acc * PROBE_MULT) __builtin_amdgcn_s_sleep(8); }
    if (HAS(12) && IN(PH_FINAL)) { const int l = 0; PHASE_PTRS norm_rows_final(F, (const f16*)(ws + WS_X16), xout, INP(kp, I_FINALNORM), T, GW, NGW); }
#undef IN
#undef SEAM
}

extern "C" void kernel_launch(void* const* d_in, const int* in_sizes, int n_in, void* d_out, int out_size, void* d_ws, size_t ws_size, hipStream_t stream) {
    static int grid = 0;
    if (grid == 0) {
        if (n_in != 21 || in_sizes[0] != T * DM || out_size != T * DM || ws_size < WS_END) {
            fprintf(stderr, "kernel_launch: shape mismatch (n_in %d, in0 %d, out %d, ws %zu < %zu); nothing launched\n", n_in, n_in > 0 ? in_sizes[0] : -1, out_size, ws_size, (size_t)WS_END); grid = -1; return; }
        int dev = 0, cus = 0;
        if (hipGetDevice(&dev) != hipSuccess || hipDeviceGetAttribute(&cus, hipDeviceAttributeMultiprocessorCount, dev) != hipSuccess) { grid = -1; return; }
        if (hipFuncSetAttribute((const void*)mega_fwd, hipFuncAttributeMaxDynamicSharedMemorySize, LDS_BYTES) != hipSuccess) { fprintf(stderr, "kernel_launch: hipFuncSetAttribute failed\n"); grid = -1; return; }
        int per_cu = 0;
        if (hipOccupancyMaxActiveBlocksPerMultiprocessor(&per_cu, (const void*)mega_fwd, NTHREADS, LDS_BYTES) != hipSuccess || per_cu < 1)
            fprintf(stderr, "kernel_launch: note: occupancy query reports %d workgroups per CU\n", per_cu);
        (void)hipGetLastError();
        grid = cus;
    }
    if (grid < 0) return;
    (void)hipMemsetAsync((char*)d_ws + WS_CTL, 0, CTL_ZERO_BYTES, stream);
    Args a{};
    for (int i = 0; i < 21; ++i) a.in[i] = (const float*)d_in[i];
    a.out = (float*)d_out; a.ws = (unsigned char*)d_ws;
#if MK_SPLIT
    for (int p = 0; p < NPHASES; ++p) { a.ph_lo = p; a.ph_hi = p + 1; hipLaunchKernelGGL(mega_fwd, dim3(grid), dim3(NTHREADS), LDS_BYTES, stream, a); }
#else
    a.ph_lo = 0; a.ph_hi = NPHASES; hipLaunchKernelGGL(mega_fwd, dim3(grid), dim3(NTHREADS), LDS_BYTES, stream, a);
#endif
    const hipError_t le = hipPeekAtLastError();
    if (le != hipSuccess) fprintf(stderr, "kernel_launch: launch failed: %s\n", hipGetErrorName(le));
}
```
